# Optimizing an MI355X kernel written in HIP

```python
import math
import jax, jax.numpy as jnp
from jax import lax
import numpy as np

D_MODEL = 4096
BATCH = 1
SEQ = 8192
DEPTH = 2

HEAD_DIM = 128
MIX_WIDTH = D_MODEL
MEM_WIDTH = MIX_WIDTH // 4
SELF_WIDTH = MIX_WIDTH - MEM_WIDTH
MOBA_HEADS = SELF_WIDTH // HEAD_DIM
DIFF_HEADS = SELF_WIDTH // (2 * HEAD_DIM)
MEM_HEADS = 4
MEM_HEAD_DIM = MEM_WIDTH // MEM_HEADS
MEM_LEN = 256
PROJ_WIDTH = 3 * SELF_WIDTH + MEM_WIDTH
ROT_DIM = HEAD_DIM // 4
ROPE_THETA = 500000.0
MOBA_BLOCK = 256
MOBA_TOPK = 3
MOBA_Q_CHUNK = 32
ATTN_Q_BLOCK = 128
_FF_RAW = (8 * D_MODEL + 2) // 3
D_FF = ((_FF_RAW + 255) // 256) * 256
N_DIFF = DEPTH // 2
NORM_EPS = 1e-6
SUBLN_EPS = 1e-5

kernel_name = 'hybrid_moba_diffattn_memory_block'

f32 = jnp.float32


def _rms(x, g, eps=NORM_EPS):
    xf = x.astype(f32)
    y = xf * lax.rsqrt(jnp.mean(xf * xf, axis=-1, keepdims=True) + eps)
    return (y * g.astype(f32)).astype(x.dtype)


def _rope_tables(positions):
    inv = ROPE_THETA ** (-jnp.arange(0, ROT_DIM, 2, dtype=f32) / ROT_DIM)
    ang = positions.astype(f32)[..., None] * inv
    return jnp.cos(ang), jnp.sin(ang)


def _partial_rope(x, cos, sin):
    c = cos[:, :, None, :].astype(x.dtype)
    s = sin[:, :, None, :].astype(x.dtype)
    half = ROT_DIM // 2
    x1 = x[..., :half]
    x2 = x[..., half:ROT_DIM]
    return jnp.concatenate([x1 * c - x2 * s, x2 * c + x1 * s, x[..., ROT_DIM:]], axis=-1)


def _moba_attention(q, k, v):
    B, S, H, D = q.shape
    n_blk = -(-S // MOBA_BLOCK)
    pad = n_blk * MOBA_BLOCK - S
    n_sel = min(MOBA_TOPK, max(n_blk - 1, 1))
    scale = HEAD_DIM ** -0.5
    widths = ((0, 0), (0, pad), (0, 0), (0, 0))
    kb = jnp.pad(k, widths).reshape(B, n_blk, MOBA_BLOCK, H, D).transpose(0, 3, 1, 2, 4)
    vb = jnp.pad(v, widths).reshape(B, n_blk, MOBA_BLOCK, H, D).transpose(0, 3, 1, 2, 4)
    counts = jnp.clip(S - jnp.arange(n_blk) * MOBA_BLOCK, 1, MOBA_BLOCK).astype(f32)
    k_mean = (kb.astype(f32).sum(axis=3) / counts[None, None, :, None]).astype(q.dtype)
    n_chunk = S // MOBA_Q_CHUNK
    q_chunks = jnp.moveaxis(q.transpose(0, 2, 1, 3).reshape(B, H, n_chunk, MOBA_Q_CHUNK, D), 2, 0)
    b_idx = jnp.arange(B)[:, None, None, None]
    h_idx = jnp.arange(H)[None, :, None, None]
    blk_ids = jnp.arange(n_blk)

    def chunk(args):
        qc, c = args
        start = c * MOBA_Q_CHUNK
        b0 = start // MOBA_BLOCK
        t = start + jnp.arange(MOBA_Q_CHUNK)
        gate = jnp.einsum('bhqd,bhnd->bhqn', qc, k_mean).astype(f32)
        gate = jnp.where(blk_ids < b0, gate, -jnp.inf)
        _, sel = lax.top_k(gate, n_sel)
        valid = sel < b0
        k_sel = kb[b_idx, h_idx, sel]
        v_sel = vb[b_idx, h_idx, sel]
        s_sel = jnp.einsum('bhqd,bhqnkd->bhqnk', qc, k_sel).astype(f32) * scale
        s_sel = jnp.where(valid[..., None], s_sel, -jnp.inf).reshape(B, H, MOBA_Q_CHUNK, n_sel * MOBA_BLOCK)
        k_own = lax.dynamic_index_in_dim(kb, b0, axis=2, keepdims=False)
        v_own = lax.dynamic_index_in_dim(vb, b0, axis=2, keepdims=False)
        s_own = jnp.einsum('bhqd,bhkd->bhqk', qc, k_own).astype(f32) * scale
        key_pos = b0 * MOBA_BLOCK + jnp.arange(MOBA_BLOCK)
        s_own = jnp.where(key_pos[None, :] <= t[:, None], s_own, -jnp.inf)
        p = jax.nn.softmax(jnp.concatenate([s_sel, s_own], axis=-1), axis=-1).astype(v.dtype)
        p_sel = p[..., :n_sel * MOBA_BLOCK].reshape(B, H, MOBA_Q_CHUNK, n_sel, MOBA_BLOCK)
        p_own = p[..., n_sel * MOBA_BLOCK:]
        return (jnp.einsum('bhqnk,bhqnkd->bhqd', p_sel, v_sel)
                + jnp.einsum('bhqk,bhkd->bhqd', p_own, v_own))

    out = lax.map(chunk, (q_chunks, jnp.arange(n_chunk)))
    out = jnp.moveaxis(out, 0, 2).reshape(B, H, S, D).transpose(0, 2, 1, 3)
    return out.reshape(B, S, H * D)


def _diff_attention(q, k, v, lam):
    B, S, H, _, D = q.shape
    scale = D ** -0.5
    n_blk = S // ATTN_Q_BLOCK
    q_blocks = jnp.moveaxis(q.reshape(B, n_blk, ATTN_Q_BLOCK, H, 2, D), 1, 0)
    key_pos = jnp.arange(S)

    def block(args):
        qb, c = args
        t = c * ATTN_Q_BLOCK + jnp.arange(ATTN_Q_BLOCK)
        s = jnp.einsum('bqhcd,bkhcd->bhcqk', qb, k).astype(f32) * scale
        s = jnp.where(key_pos[None, :] <= t[:, None], s, -jnp.inf)
        p = jax.nn.softmax(s, axis=-1)
        a = p[:, :, 0] - lam * p[:, :, 1]
        return jnp.einsum('bhqk,bkhe->bqhe', a.astype(v.dtype), v)

    out = lax.map(block, (q_blocks, jnp.arange(n_blk)))
    return jnp.moveaxis(out, 0, 1).reshape(B, S, H, 2 * D)


def _mem_attention(qm, km, vm):
    B, S = qm.shape[:2]
    s = jnp.einsum('bqhd,bmhd->bhqm', qm, km).astype(f32) * (MEM_HEAD_DIM ** -0.5)
    p = jax.nn.softmax(s, axis=-1).astype(vm.dtype)
    return jnp.einsum('bhqm,bmhd->bqhd', p, vm).reshape(B, S, MEM_WIDTH)


def setup_inputs(seed: int = 0) -> dict:
    key = jax.random.key(seed)
    ks = jax.random.split(key, 24)

    def nrm(k, shape, scale):
        return jax.random.normal(k, shape, f32) * scale

    def gain(k, shape):
        return 1.0 + 0.02 * jax.random.normal(k, shape, f32)

    return {
        'x': nrm(ks[0], (BATCH, SEQ, D_MODEL), 1.0),
        'mem': nrm(ks[1], (BATCH, MEM_LEN, D_MODEL), 1.0),
        'positions': jnp.broadcast_to(jnp.arange(SEQ, dtype=jnp.int32)[None, :], (BATCH, SEQ)),
        'g_attn_norm': gain(ks[2], (DEPTH, D_MODEL)),
        'w_in': nrm(ks[3], (DEPTH, D_MODEL, PROJ_WIDTH), D_MODEL ** -0.5),
        'w_out': nrm(ks[4], (DEPTH, MIX_WIDTH, D_MODEL), MIX_WIDTH ** -0.5),
        'g_qnorm': gain(ks[5], (DEPTH, HEAD_DIM)),
        'g_knorm': gain(ks[6], (DEPTH, HEAD_DIM)),
        'g_mem_qnorm': gain(ks[7], (DEPTH, MEM_HEAD_DIM)),
        'g_mem_knorm': gain(ks[8], (DEPTH, MEM_HEAD_DIM)),
        'g_mem_norm': gain(ks[9], (D_MODEL,)),
        'w_mem_kv': nrm(ks[10], (D_MODEL, 2 * MEM_WIDTH), D_MODEL ** -0.5),
        'lambda_q1': nrm(ks[11], (N_DIFF, HEAD_DIM), 0.1),
        'lambda_k1': nrm(ks[12], (N_DIFF, HEAD_DIM), 0.1),
        'lambda_q2': nrm(ks[13], (N_DIFF, HEAD_DIM), 0.1),
        'lambda_k2': nrm(ks[14], (N_DIFF, HEAD_DIM), 0.1),
        'g_subln': gain(ks[15], (N_DIFF, 2 * HEAD_DIM)),
        'g_ffn_norm': gain(ks[16], (DEPTH, D_MODEL)),
        'w_gate': nrm(ks[17], (DEPTH, D_MODEL, D_FF), D_MODEL ** -0.5),
        'w_up': nrm(ks[18], (DEPTH, D_MODEL, D_FF), D_MODEL ** -0.5),
        'w_down': nrm(ks[19], (DEPTH, D_FF, D_MODEL), D_FF ** -0.5),
    }


def reference(x, mem, positions, g_attn_norm, w_in, w_out, g_qnorm, g_knorm,
              g_mem_qnorm, g_mem_knorm, g_mem_norm, w_mem_kv, lambda_q1, lambda_k1,
              lambda_q2, lambda_k2, g_subln, g_ffn_norm, w_gate, w_up, w_down):
    B, S, _ = x.shape
    M = mem.shape[1]
    cos, sin = _rope_tables(positions)
    mkv = _rms(mem, g_mem_norm) @ w_mem_kv
    mk_raw = mkv[..., :MEM_WIDTH].reshape(B, M, MEM_HEADS, MEM_HEAD_DIM)
    mv = mkv[..., MEM_WIDTH:].reshape(B, M, MEM_HEADS, MEM_HEAD_DIM)

    for i in range(DEPTH):
        h = _rms(x, g_attn_norm[i])
        proj = h @ w_in[i]
        qs = proj[..., :SELF_WIDTH]
        ks_ = proj[..., SELF_WIDTH:2 * SELF_WIDTH]
        vs = proj[..., 2 * SELF_WIDTH:3 * SELF_WIDTH]
        qm = proj[..., 3 * SELF_WIDTH:]
        if i % 2 == 0:
            q = _partial_rope(_rms(qs.reshape(B, S, MOBA_HEADS, HEAD_DIM), g_qnorm[i]), cos, sin)
            k = _partial_rope(_rms(ks_.reshape(B, S, MOBA_HEADS, HEAD_DIM), g_knorm[i]), cos, sin)
            v = vs.reshape(B, S, MOBA_HEADS, HEAD_DIM)
            self_out = _moba_attention(q, k, v)
        else:
            j = i // 2
            q = _partial_rope(_rms(qs.reshape(B, S, 2 * DIFF_HEADS, HEAD_DIM), g_qnorm[i]), cos, sin)
            k = _partial_rope(_rms(ks_.reshape(B, S, 2 * DIFF_HEADS, HEAD_DIM), g_knorm[i]), cos, sin)
            q = q.reshape(B, S, DIFF_HEADS, 2, HEAD_DIM)
            k = k.reshape(B, S, DIFF_HEADS, 2, HEAD_DIM)
            v = vs.reshape(B, S, DIFF_HEADS, 2 * HEAD_DIM)
            lam_init = 0.8 - 0.6 * math.exp(-0.3 * i)
            lam = (jnp.exp(jnp.sum(lambda_q1[j].astype(f32) * lambda_k1[j].astype(f32)))
                   - jnp.exp(jnp.sum(lambda_q2[j].astype(f32) * lambda_k2[j].astype(f32)))
                   + lam_init)
            o = _diff_attention(q, k, v, lam)
            o = _rms(o, g_subln[j], SUBLN_EPS) * (1.0 - lam_init)
            self_out = o.reshape(B, S, SELF_WIDTH)
        qmh = _rms(qm.reshape(B, S, MEM_HEADS, MEM_HEAD_DIM), g_mem_qnorm[i])
        kmh = _rms(mk_raw, g_mem_knorm[i])
        mem_out = _mem_attention(qmh, kmh, mv)
        x = x + jnp.concatenate([self_out, mem_out], axis=-1) @ w_out[i]
        f = _rms(x, g_ffn_norm[i])
        x = x + (jax.nn.silu(f @ w_gate[i]) * (f @ w_up[i])) @ w_down[i]
    return x
```

```cpp
#include <hip/hip_runtime.h>
#include <cstdio>
#include <cstdint>

#ifndef MK_ONE_LAUNCH
#define MK_ONE_LAUNCH 0
#endif

constexpr int SEQ = 8192, DM = 4096, PW = 10240, SELF_W = 3072, MEM_W = 1024, DFF = 11008, NGU = 2 * DFF, MEML = 256, HD = 128;
constexpr int NHEAD = 24;
constexpr int NBLK = SEQ / 256;
constexpr int OPW = 48 * HD;
constexpr float NORM_EPS = 1e-6f, SUBLN_EPS = 1e-5f;
constexpr float LAM_INIT = 0.35550906759096934f;

enum { IN_X = 0, IN_MEM, IN_POS, IN_GATTN, IN_WIN, IN_WOUT, IN_GQ, IN_GK, IN_GMQ, IN_GMK, IN_GMEM, IN_WMEMKV, IN_LQ1, IN_LK1, IN_LQ2, IN_LK2, IN_GSUB, IN_GFFN, IN_WGATE, IN_WUP, IN_WDOWN, N_IN };

constexpr size_t MiB = 1u << 20;
constexpr size_t SZ_WIN = (size_t)PW * DM * 2, SZ_WOUT = (size_t)DM * DM * 2, SZ_WGU = (size_t)NGU * DM * 2, SZ_WDN = (size_t)DM * DFF * 2;
constexpr size_t WS_CTL = 0, CTL_ZERO_BYTES = 64 * 1024;
constexpr size_t WS_WIN = 1 * MiB;
constexpr size_t WS_WOUT = WS_WIN + 2 * SZ_WIN;
constexpr size_t WS_WGU = WS_WOUT + 2 * SZ_WOUT;
constexpr size_t WS_WDN = WS_WGU + 2 * SZ_WGU;
constexpr size_t WS_XB = WS_WDN + 2 * SZ_WDN;
constexpr size_t WS_PROJ = WS_XB + (size_t)SEQ * DM * 2;
constexpr size_t WS_ATT = WS_PROJ + (size_t)SEQ * PW * 2;
constexpr size_t WS_HID = WS_ATT + (size_t)SEQ * OPW * 2;
constexpr size_t WS_OP = WS_HID + (size_t)SEQ * DFF * 2;
constexpr size_t WS_PM = WS_OP + (size_t)SEQ * OPW * 2;
constexpr size_t WS_SSA = WS_PM + (size_t)SEQ * MEM_W * 2;
constexpr size_t WS_SSB = WS_SSA + 1 * MiB;
constexpr size_t WS_CS = WS_SSB + 1 * MiB;
constexpr size_t WS_MKV = WS_CS + 1 * MiB;
constexpr size_t WS_KMN = WS_MKV + 2 * MiB;
constexpr size_t WS_VT = WS_KMN + 1 * MiB;
constexpr size_t WS_KSUM = WS_VT + 1 * MiB;
constexpr size_t WS_SEL = WS_KSUM + 2 * MiB;
constexpr size_t WS_PS = WS_SEL + 1 * MiB;
constexpr size_t WS_END = WS_PS + 1 * MiB;
constexpr int CW_TMO = 0, CW_BAR = 4096;

constexpr int RING_BYTES = 131072;
constexpr int EXCH_OFF = RING_BYTES;
constexpr int MISC_OFF = EXCH_OFF + 4096;
constexpr int LDS_BYTES = 147456;
static_assert(MISC_OFF + 256 <= LDS_BYTES, "LDS map");

#define GAS __attribute__((address_space(1)))
#define LAS __attribute__((address_space(3)))
typedef unsigned short bf16;
typedef unsigned v4u __attribute__((ext_vector_type(4)));
typedef unsigned v2u __attribute__((ext_vector_type(2)));
typedef float f32x4 __attribute__((ext_vector_type(4)));
typedef float f32x2 __attribute__((ext_vector_type(2)));
typedef float f32x16 __attribute__((ext_vector_type(16)));
typedef short bf16x8 __attribute__((ext_vector_type(8)));
typedef short s16x4 __attribute__((ext_vector_type(4)));
typedef GAS unsigned gu32;
#define RLX_AGENT __ATOMIC_RELAXED, __HIP_MEMORY_SCOPE_AGENT
#define LDS_WAIT() asm volatile("s_waitcnt lgkmcnt(0)" ::: "memory")
#define VM_WAIT() asm volatile("s_waitcnt vmcnt(0)" ::: "memory")

__device__ __forceinline__ unsigned cvt_pk_bf16(float lo, float hi) { unsigned r; asm volatile("v_cvt_pk_bf16_f32 %0, %1, %2" : "=v"(r) : "v"(lo), "v"(hi)); return r; }
__device__ __forceinline__ float bf_lo(unsigned w) { return __uint_as_float(w << 16); }
__device__ __forceinline__ float bf_hi(unsigned w) { return __uint_as_float(w & 0xffff0000u); }
__device__ __forceinline__ float wave_sum(float v) {
#pragma unroll
    for (int o = 1; o < 64; o <<= 1) v += __shfl_xor(v, o);
    return v;
}

namespace pg8 {
#define PG8_LAS __attribute__((address_space(3)))
typedef unsigned short bf16_t;
typedef unsigned u32x4 __attribute__((ext_vector_type(4)));
constexpr int BM = 256, BK = 64, HALF = 128, HTB = HALF * BK * 2, STAGE_BYTES = 8 * HTB, NXCD = 8, WGM = 8;

__host__ __device__ __forceinline__ int lds_byte(int r, int c) { const int st = (r >> 4) * 2 + (c >> 5), rr = r & 15, cc = c & 31, ob = rr * 64 + cc * 2; return st * 1024 + (ob ^ (((ob >> 9) & 1) << 5)); }
__host__ __device__ __forceinline__ void stage_rc(int b, int& R, int& C) { const int st = b / 1024, sb = b % 1024, swz = sb ^ (((sb >> 9) & 1) << 5); R = (st >> 1) * 16 + swz / 64; C = (st & 1) * 32 + (swz % 64) / 2; }
__host__ __device__ __forceinline__ int perm32(int rho) { const int n = rho >> 4, i = rho & 15; return 8 * (i >> 2) + 4 * n + (i & 3); }

struct Unit { int pm, pn; };
struct Gemm { const bf16_t* A; const bf16_t* Bt; int M, N, K, lda, ldb, a_pn_step; };

struct StaticOrder {
    int nM, nN, nwg, G, c;
    __host__ __device__ void init(int M, int N, int G_, int c_) { nM = M / BM; nN = N / BM; nwg = nM * nN; G = G_; c = c_; }
    __host__ __device__ bool next(int i, Unit& u) const {
        const long L = (long)i * G + c; if (L >= nwg) return false;
        int wgid = (int)L; { const int q = nwg / NXCD, r = nwg % NXCD, xcd = wgid % NXCD, off = wgid / NXCD; wgid = (xcd < r ? xcd * (q + 1) : r * (q + 1) + (xcd - r) * q) + off; }
        const int nig = WGM * nN, gid = wgid / nig, fm = gid * WGM, gsz = (nM - fm) < WGM ? (nM - fm) : WGM;
        u.pm = fm + ((wgid % nig) % gsz); u.pn = (wgid % nig) / gsz; return true;
    }
    __device__ __forceinline__ void a_ready(const Unit&) const {}
    __device__ __forceinline__ void done(const Unit&) const {}
};

__device__ __forceinline__ float row_rstd(const float* ss, int row, float inv_d, float eps) {
    const f32x4* sp = (const f32x4*)(ss + (size_t)row * 16);
    const f32x4 a = sp[0], b = sp[1], c = sp[2], d = sp[3];
    const float t = ((a[0] + a[1]) + (a[2] + a[3])) + ((b[0] + b[1]) + (b[2] + b[3])) + ((c[0] + c[1]) + (c[2] + c[3])) + ((d[0] + d[1]) + (d[2] + d[3]));
    return __builtin_amdgcn_rsqf(t * inv_d + eps);
}
struct EpiProj {
    static constexpr bool PERM = true, AFTER_DRAIN = false;
    bf16_t* O; int ldc; const float* ss; float inv_d, eps;
    __device__ __forceinline__ void operator()(const f32x4 (&acc)[2][2][4][2], const Unit& u, int wr, int wc, int fr, int fq) const {
        const int row0 = u.pm * BM + wr * 64 + fr, col0 = u.pn * BM + wc * 32 + 8 * fq;
#pragma unroll
        for (int ai = 0; ai < 2; ++ai)
#pragma unroll
            for (int m = 0; m < 4; ++m) { const int row = row0 + ai * HALF + m * 16; const float rs = row_rstd(ss, row, inv_d, eps);
                bf16_t* rowp = O + (size_t)row * ldc + col0;
#pragma unroll
                for (int bj = 0; bj < 2; ++bj) { const f32x4 v0 = acc[ai][bj][m][0] * rs, v1 = acc[ai][bj][m][1] * rs;
                    u32x4 w; w.x = cvt_pk_bf16(v0[0], v0[1]); w.y = cvt_pk_bf16(v0[2], v0[3]); w.z = cvt_pk_bf16(v1[0], v1[1]); w.w = cvt_pk_bf16(v1[2], v1[3]);
                    *(u32x4*)(rowp + bj * HALF) = w; } }
    }
};
__device__ __forceinline__ float silu_mul(float g, float u) { const float e = __builtin_amdgcn_exp2f(-1.4426950408889634f * g); return g * __builtin_amdgcn_rcpf(1.0f + e) * u; }
struct EpiGU {
    static constexpr bool PERM = true, AFTER_DRAIN = false;
    bf16_t* O; int ldc; const float* ss; float inv_d, eps;
    __device__ __forceinline__ void operator()(const f32x4 (&acc)[2][2][4][2], const Unit& u, int wr, int wc, int fr, int fq) const {
        const int row0 = u.pm * BM + wr * 64 + fr, col0 = u.pn * HALF + wc * 32 + 8 * fq;
#pragma unroll
        for (int ai = 0; ai < 2; ++ai)
#pragma unroll
            for (int m = 0; m < 4; ++m) { const int row = row0 + ai * HALF + m * 16; const float rs = row_rstd(ss, row, inv_d, eps);
                const f32x4 g0 = acc[ai][0][m][0] * rs, g1 = acc[ai][0][m][1] * rs, u0 = acc[ai][1][m][0] * rs, u1 = acc[ai][1][m][1] * rs;
                u32x4 w; w.x = cvt_pk_bf16(silu_mul(g0[0], u0[0]), silu_mul(g0[1], u0[1])); w.y = cvt_pk_bf16(silu_mul(g0[2], u0[2]), silu_mul(g0[3], u0[3]));
                w.z = cvt_pk_bf16(silu_mul(g1[0], u1[0]), silu_mul(g1[1], u1[1])); w.w = cvt_pk_bf16(silu_mul(g1[2], u1[2]), silu_mul(g1[3], u1[3]));
                *(u32x4*)(O + (size_t)row * ldc + col0) = w; }
    }
};
template <bool STATS> struct EpiRes {
    static constexpr bool PERM = true, AFTER_DRAIN = false;
    const float* base; float* out; bf16_t* xb; float* ss; int ldc; PG8_LAS float* exch;
    __device__ __forceinline__ void operator()(const f32x4 (&acc)[2][2][4][2], const Unit& u, int wr, int wc, int fr, int fq) const {
        const int row0 = u.pm * BM + wr * 64 + fr, col0 = u.pn * BM + wc * 32 + 8 * fq;
#pragma unroll
        for (int ai = 0; ai < 2; ++ai)
#pragma unroll
            for (int m = 0; m < 4; ++m) { const int row = row0 + ai * HALF + m * 16; const size_t off = (size_t)row * ldc + col0; float q = 0.f;
#pragma unroll
                for (int bj = 0; bj < 2; ++bj) { const f32x4 b0 = *(const f32x4*)(base + off + bj * HALF), b1 = *(const f32x4*)(base + off + bj * HALF + 4);
                    const f32x4 o0 = b0 + acc[ai][bj][m][0], o1 = b1 + acc[ai][bj][m][1];
                    *(f32x4*)(out + off + bj * HALF) = o0; *(f32x4*)(out + off + bj * HALF + 4) = o1;
                    if (STATS) { q += (o0[0] * o0[0] + o0[1] * o0[1]) + (o0[2] * o0[2] + o0[3] * o0[3]) + (o1[0] * o1[0] + o1[1] * o1[1]) + (o1[2] * o1[2] + o1[3] * o1[3]);
                        u32x4 w; w.x = cvt_pk_bf16(o0[0], o0[1]); w.y = cvt_pk_bf16(o0[2], o0[3]); w.z = cvt_pk_bf16(o1[0], o1[1]); w.w = cvt_pk_bf16(o1[2], o1[3]);
                        *(u32x4*)(xb + off + bj * HALF) = w; } }
                if (STATS) { q += __shfl_xor(q, 16); q += __shfl_xor(q, 32); if (fq == 0) exch[(ai * HALF + wr * 64 + m * 16 + fr) * 4 + wc] = q; }
                asm volatile("" ::: "memory"); }
        if (STATS) {
            asm volatile("s_waitcnt lgkmcnt(0)" ::: "memory"); __builtin_amdgcn_s_barrier(); asm volatile("" ::: "memory");
            const int t = threadIdx.x;
            if (t < 256) { const f32x4 p = *(const PG8_LAS f32x4*)(exch + t * 4); ss[(size_t)(u.pm * BM + t) * 16 + u.pn] = (p[0] + p[1]) + (p[2] + p[3]); }
        }
    }
};
struct EpiMemS {
    static constexpr bool PERM = true, AFTER_DRAIN = false;
    bf16_t* P; float* ps;
    __device__ __forceinline__ void operator()(const f32x4 (&acc)[2][2][4][2], const Unit& u, int wr, int wc, int fr, int fq) const {
        const int row0 = u.pm * BM + wr * 64 + fr, col0 = u.pn * BM + wc * 32 + 8 * fq; constexpr float C = 0.0625f * 1.4426950408889634f;
#pragma unroll
        for (int ai = 0; ai < 2; ++ai)
#pragma unroll
            for (int m = 0; m < 4; ++m) { const int row = row0 + ai * HALF + m * 16;
#pragma unroll
                for (int bj = 0; bj < 2; ++bj) { const f32x4 a0 = acc[ai][bj][m][0], a1 = acc[ai][bj][m][1];
                    u32x4 w; w.x = cvt_pk_bf16(__builtin_amdgcn_exp2f(a0[0] * C), __builtin_amdgcn_exp2f(a0[1] * C)); w.y = cvt_pk_bf16(__builtin_amdgcn_exp2f(a0[2] * C), __builtin_amdgcn_exp2f(a0[3] * C));
                    w.z = cvt_pk_bf16(__builtin_amdgcn_exp2f(a1[0] * C), __builtin_amdgcn_exp2f(a1[1] * C)); w.w = cvt_pk_bf16(__builtin_amdgcn_exp2f(a1[2] * C), __builtin_amdgcn_exp2f(a1[3] * C));
                    *(u32x4*)(P + (size_t)row * MEM_W + col0 + bj * HALF) = w;
                    float q = ((bf_lo(w.x) + bf_hi(w.x)) + (bf_lo(w.y) + bf_hi(w.y))) + ((bf_lo(w.z) + bf_hi(w.z)) + (bf_lo(w.w) + bf_hi(w.w)));
                    q += __shfl_xor(q, 16); q += __shfl_xor(q, 32);
                    if (fq == 0) ps[((size_t)row * 4 + u.pn) * 8 + bj * 4 + wc] = q; } }
    }
};
struct EpiMemO {
    static constexpr bool PERM = true, AFTER_DRAIN = false;
    bf16_t* O; const float* ps;
    __device__ __forceinline__ void operator()(const f32x4 (&acc)[2][2][4][2], const Unit& u, int wr, int wc, int fr, int fq) const {
        const int row0 = u.pm * BM + wr * 64 + fr, col0 = SELF_W + u.pn * BM + wc * 32 + 8 * fq;
#pragma unroll
        for (int ai = 0; ai < 2; ++ai)
#pragma unroll
            for (int m = 0; m < 4; ++m) { const int row = row0 + ai * HALF + m * 16;
                const f32x4* lp = (const f32x4*)(ps + ((size_t)row * 4 + u.pn) * 8); const f32x4 la = lp[0], lb = lp[1];
                const float rl = 1.0f / (((la[0] + la[1]) + (la[2] + la[3])) + ((lb[0] + lb[1]) + (lb[2] + lb[3])));
#pragma unroll
                for (int bj = 0; bj < 2; ++bj) { const f32x4 v0 = acc[ai][bj][m][0] * rl, v1 = acc[ai][bj][m][1] * rl;
                    u32x4 w; w.x = cvt_pk_bf16(v0[0], v0[1]); w.y = cvt_pk_bf16(v0[2], v0[3]); w.z = cvt_pk_bf16(v1[0], v1[1]); w.w = cvt_pk_bf16(v1[2], v1[3]);
                    *(u32x4*)(O + (size_t)row * OPW + col0 + bj * HALF) = w; } }
    }
};

template <class Epi, class Sched, bool ALIGN_EPI = true>
__device__ __forceinline__ void gemm_phase(PG8_LAS unsigned char* lds, const Gemm g, const Sched& S, const Epi& E) {
    int tid_ = threadIdx.x; asm volatile("" : "+v"(tid_));
    const int tid = tid_, wid = __builtin_amdgcn_readfirstlane(tid >> 6), lane = tid & 63, wr = wid >> 2, wc = wid & 3, fr = lane & 15, fq = lane >> 4;
    const int K = g.K, nt = K / BK;
    unsigned voffA[2], voffB[2];
#pragma unroll
    for (int i = 0; i < 2; ++i) { int R, C; stage_rc(tid * 16 + i * 8192, R, C); const int Rb = Epi::PERM ? ((R & ~31) + perm32(R & 31)) : R;
        voffA[i] = (unsigned)(R * g.lda + C) * 2u; voffB[i] = (unsigned)(Rb * g.ldb + C) * 2u; }
    const size_t kstep = (size_t)(BK * 2);
    const size_t hstepA = (size_t)HALF * g.lda * 2, hstepB = (size_t)HALF * g.ldb * 2;
    const size_t tstepA = 2 * hstepA, tstepB = 2 * hstepB, pnstepA = (size_t)g.a_pn_step * 2;
    const unsigned ldsw = (unsigned)wid * 1024u;
    const int aoff = lds_byte(wr * 64 + fr, fq * 8), boff = lds_byte(wc * 32 + fr, fq * 8);
#define PG8_SA(b, h) (((b) * 2 + (h)) * HTB)
#define PG8_SB(b, h) ((4 + (b) * 2 + (h)) * HTB)
#define PG8_STAGE(bufoff, gbase, voff) do { _Pragma("unroll") for (int _i = 0; _i < 2; ++_i) \
        __builtin_amdgcn_global_load_lds((const unsigned*)((const char*)(gbase) + (voff)[_i]), (PG8_LAS unsigned*)(lds + (bufoff) + ldsw + _i * 8192), 16, 0, 0); } while (0)
#define PG8_LDA(dst, b, h) do { _Pragma("unroll") for (int m = 0; m < 4; ++m) _Pragma("unroll") for (int k = 0; k < 2; ++k) dst[m][k] = *(const PG8_LAS bf16x8*)(lds + PG8_SA(b, h) + aoff + m * 2048 + k * 1024); } while (0)
#define PG8_LDB(dst, b, h) do { _Pragma("unroll") for (int n = 0; n < 2; ++n) _Pragma("unroll") for (int k = 0; k < 2; ++k) dst[n][k] = *(const PG8_LAS bf16x8*)(lds + PG8_SB(b, h) + boff + n * 2048 + k * 1024); } while (0)
#define PG8_MMA(ai, bj, At, Bt) do { __builtin_amdgcn_s_setprio(1); _Pragma("unroll") for (int m = 0; m < 4; ++m) _Pragma("unroll") for (int n = 0; n < 2; ++n) _Pragma("unroll") for (int k = 0; k < 2; ++k) \
        acc[ai][bj][m][n] = __builtin_amdgcn_mfma_f32_16x16x32_bf16(Bt[n][k], At[m][k], acc[ai][bj][m][n], 0, 0, 0); __builtin_amdgcn_s_setprio(0); } while (0)
#define PG8_WAIT_V(n) asm volatile("s_waitcnt vmcnt(" #n ")" ::: "memory")
#define PG8_WAIT_L(n) asm volatile("s_waitcnt lgkmcnt(" #n ")" ::: "memory")
#define PG8_BAR __builtin_amdgcn_s_barrier()
#define PG8_SCHED __builtin_amdgcn_sched_barrier(0)
    __builtin_amdgcn_s_waitcnt(0);
    Unit cur, nxt; int ui = 0;
    if (!S.next(0, cur)) return;
    f32x4 acc[2][2][4][2];
#pragma unroll
    for (int a = 0; a < 2; ++a)
#pragma unroll
        for (int b = 0; b < 2; ++b)
#pragma unroll
            for (int m = 0; m < 4; ++m)
#pragma unroll
                for (int n = 0; n < 2; ++n) acc[a][b][m][n] = (f32x4){0.f, 0.f, 0.f, 0.f};
    bf16x8 At[4][2], B0[2][2], B1[2][2];
    const char* cA = (const char*)g.A + (size_t)cur.pm * tstepA + (size_t)cur.pn * pnstepA; const char* cB = (const char*)g.Bt + (size_t)cur.pn * tstepB;
    S.a_ready(cur);
    PG8_STAGE(PG8_SB(0, 0), cB, voffB); PG8_STAGE(PG8_SB(0, 1), cB + hstepB, voffB); PG8_STAGE(PG8_SA(0, 0), cA, voffA); PG8_STAGE(PG8_SA(0, 1), cA + hstepA, voffA);
    if (wr == 1) PG8_BAR;
    PG8_WAIT_V(2); PG8_BAR;
    PG8_STAGE(PG8_SB(1, 0), cB + kstep, voffB); PG8_STAGE(PG8_SA(1, 0), cA + kstep, voffA); PG8_STAGE(PG8_SB(1, 1), cB + hstepB + kstep, voffB);
    PG8_WAIT_V(6); PG8_BAR;
    for (;;) {
        const bool has_next = S.next(ui + 1, nxt);
        const char* nA = has_next ? (const char*)g.A + (size_t)nxt.pm * tstepA + (size_t)nxt.pn * pnstepA : cA; const char* nB = has_next ? (const char*)g.Bt + (size_t)nxt.pn * tstepB : cB;
#pragma unroll 1
        for (int t = 0; t < nt; t += 2) {
            const bool last = (t == nt - 2);
            const char* a1 = cA + (size_t)(t + 1) * kstep;
            const char* a2 = last ? nA : cA + (size_t)(t + 2) * kstep; const char* b2 = last ? nB : cB + (size_t)(t + 2) * kstep;
            const char* a3 = a2 + kstep; const char* b3 = b2 + kstep;
            if (last && has_next) S.a_ready(nxt);
            PG8_LDB(B0, 0, 0); PG8_LDB(B1, 0, 1); PG8_SCHED; PG8_LDA(At, 0, 0); PG8_STAGE(PG8_SA(1, 1), a1 + hstepA, voffA);
            PG8_WAIT_V(8); PG8_WAIT_L(0); PG8_BAR; PG8_MMA(0, 0, At, B0); PG8_MMA(0, 1, At, B1); PG8_BAR; PG8_SCHED;
            PG8_LDA(At, 0, 1); PG8_STAGE(PG8_SB(0, 0), b2, voffB); PG8_STAGE(PG8_SB(0, 1), b2 + hstepB, voffB); PG8_STAGE(PG8_SA(0, 0), a2, voffA);
            PG8_WAIT_V(8); PG8_WAIT_L(0); PG8_BAR; PG8_MMA(1, 0, At, B0); PG8_MMA(1, 1, At, B1); PG8_BAR; PG8_SCHED;
            PG8_LDB(B0, 1, 0); PG8_LDB(B1, 1, 1); PG8_SCHED; PG8_LDA(At, 1, 0); PG8_STAGE(PG8_SA(0, 1), a2 + hstepA, voffA);
            PG8_WAIT_V(8); PG8_WAIT_L(0); PG8_BAR; PG8_MMA(0, 0, At, B0); PG8_MMA(0, 1, At, B1); PG8_BAR; PG8_SCHED;
            PG8_LDA(At, 1, 1); PG8_STAGE(PG8_SB(1, 0), b3, voffB); PG8_STAGE(PG8_SB(1, 1), b3 + hstepB, voffB); PG8_STAGE(PG8_SA(1, 0), a3, voffA);
            PG8_WAIT_V(8); PG8_WAIT_L(0); PG8_BAR; PG8_MMA(1, 0, At, B0); PG8_MMA(1, 1, At, B1); PG8_BAR; PG8_SCHED;
        }
        if constexpr (ALIGN_EPI) { if (wr == 0) PG8_BAR; }
        E(acc, cur, wr, wc, fr, fq); S.done(cur);
        if (!has_next) break;
#pragma unroll
        for (int a = 0; a < 2; ++a)
#pragma unroll
            for (int b = 0; b < 2; ++b)
#pragma unroll
                for (int m = 0; m < 4; ++m)
#pragma unroll
                    for (int n = 0; n < 2; ++n) acc[a][b][m][n] = (f32x4){0.f, 0.f, 0.f, 0.f};
        cur = nxt; cA = nA; cB = nB; ++ui;
        if constexpr (ALIGN_EPI) { if (wr == 1) PG8_BAR; }
    }
    PG8_WAIT_V(0); __builtin_amdgcn_s_waitcnt(0);
    if constexpr (!ALIGN_EPI) { if (wr == 0) PG8_BAR; }
    PG8_BAR;
#undef PG8_SA
#undef PG8_SB
#undef PG8_STAGE
#undef PG8_LDA
#undef PG8_LDB
#undef PG8_MMA
#undef PG8_WAIT_V
#undef PG8_WAIT_L
#undef PG8_BAR
#undef PG8_SCHED
}
}

namespace att {
constexpr float SCALE = 0.08838834764831845f;
constexpr int NW = 8, QBLK = 32, KVBLK = 64, QB = NW * QBLK, D = 128;
constexpr int SHM_V = KVBLK * D * 2, SHM_K = KVBLK * D * 2;
constexpr int ATT_LDS_BYTES = 2 * SHM_V + 2 * SHM_K + NW * 64 * 4;
constexpr float THR = 8.f;
#define KSWZ(row, colB) ((row) * 256 + ((colB) ^ (((row) & 7) << 4)))
#define SBAR() __builtin_amdgcn_sched_barrier(0)
__device__ __forceinline__ int v_st(int k, int c) { const int kk = (k & ~0xC) | ((k & 4) << 1) | ((k & 8) >> 1); return ((kk >> 3) * 4 + (c >> 5)) * 512 + ((kk & 7) * 32 + (c & 31)) * 2; }
__device__ __forceinline__ int v_rd_base(int lane) { return ((lane & 3) << 3) | (((lane >> 2) & 3) << 6) | (((lane >> 4) & 1) << 5) | (((lane >> 5) & 1) << 8); }
constexpr int v_rd_off(int d0, int ks, int half) { return d0 * 512 + ks * 4096 + half * 2048; }
__device__ __forceinline__ int crow(int r, int hi) { return (r & 3) + 8 * (r >> 2) + 4 * hi; }
__device__ __forceinline__ unsigned cvtpk(float lo, float hi) { unsigned r; asm volatile("v_cvt_pk_bf16_f32 %0, %1, %2" : "=v"(r) : "v"(lo), "v"(hi)); return r; }
__device__ __forceinline__ bf16x8 load8(const bf16* p) { return *reinterpret_cast<const bf16x8*>(p); }
__device__ __forceinline__ void mask_tile(f32x16& p0, f32x16& p1, int dq) {
    const float NEG = -__builtin_inff();
#pragma unroll
    for (int r = 0; r < 16; ++r) {
        const int c = (r & 3) + 8 * (r >> 2);
        if (dq - c < 0) p0[r] = NEG;
        if (dq - c - 32 < 0) p1[r] = NEG;
    }
}
__device__ __forceinline__ void mask_sel(f32x16& p0, f32x16& p1, unsigned keep) {
    const float NEG = -__builtin_inff();
#pragma unroll
    for (int r = 0; r < 16; ++r) { p0[r] = keep ? p0[r] : NEG; p1[r] = keep ? p1[r] : NEG; }
}
__device__ __forceinline__ void partialSM(f32x16& p0, f32x16& p1, float& m_reg, float& mn, float& alpha) {
    float pmax = p0[0]; for (int r = 1; r < 16; ++r) pmax = fmaxf(pmax, p0[r]); for (int r = 0; r < 16; ++r) pmax = fmaxf(pmax, p1[r]);
    { auto rr = __builtin_amdgcn_permlane32_swap(__float_as_uint(pmax), __float_as_uint(pmax), false, false);
      pmax = fmaxf(__uint_as_float(rr[0]), __uint_as_float(rr[1])); }
    constexpr float C2 = 1.4426950408889634f * SCALE;
    if (__builtin_expect(__all((pmax - m_reg) * SCALE <= THR), 1)) { mn = m_reg; alpha = 1.f; }
    else { mn = fmaxf(m_reg, pmax); alpha = __builtin_amdgcn_exp2f((m_reg - mn) * C2); m_reg = mn; }
    const float mnL = -mn * C2;
    for (int r = 0; r < 16; ++r) p0[r] = fmaf(p0[r], C2, mnL); for (int r = 0; r < 16; ++r) p1[r] = fmaf(p1[r], C2, mnL);
    for (int r = 0; r < 16; ++r) p0[r] = __builtin_amdgcn_exp2f(p0[r]);
}
__device__ __forceinline__ void finishSM(f32x16& p0, f32x16& p1, float alpha, float& l_reg, bf16x8& pa0, bf16x8& pa1, bf16x8& pa2, bf16x8& pa3) {
    for (int r = 0; r < 16; ++r) p1[r] = __builtin_amdgcn_exp2f(p1[r]);
    float ps = 0; for (int r = 0; r < 16; ++r) ps += p0[r]; for (int r = 0; r < 16; ++r) ps += p1[r];
    { auto rr = __builtin_amdgcn_permlane32_swap(__float_as_uint(ps), __float_as_uint(ps), false, false);
      ps = __uint_as_float(rr[0]) + __uint_as_float(rr[1]); }
    l_reg = l_reg * alpha + ps;
#define PK4(P, B_, OUT) do { unsigned a0 = cvtpk(P[B_+0], P[B_+1]), a1 = cvtpk(P[B_+2], P[B_+3]);                          \
        unsigned b0 = cvtpk(P[B_+4], P[B_+5]), b1 = cvtpk(P[B_+6], P[B_+7]);                                             \
        auto r0 = __builtin_amdgcn_permlane32_swap(a0, b0, false, false); auto r1 = __builtin_amdgcn_permlane32_swap(a1, b1, false, false); \
        v4u w = {r0[0], r1[0], r0[1], r1[1]}; OUT = *reinterpret_cast<bf16x8*>(&w); } while (0)
    PK4(p0, 0, pa0); PK4(p0, 8, pa1); PK4(p1, 0, pa2); PK4(p1, 8, pa3);
#undef PK4
}
template <int KB>
__device__ __forceinline__ void qkt(f32x16& p0, f32x16& p1, const char* K_lds, int r32, int hi, const bf16x8* qr) {
    p0 = f32x16{}; p1 = f32x16{};
    const char* kb[4];
#pragma unroll
    for (int dd = 0; dd < 4; ++dd) kb[dd] = K_lds + KB * SHM_K + KSWZ(r32, (dd * 16 + hi * 8) * 2);
#pragma unroll
    for (int d0 = 0; d0 < 8; ++d0) { const char* a = kb[d0 & 3] + (d0 >> 2) * 128;
        bf16x8 b0 = *reinterpret_cast<const bf16x8*>(a);
        bf16x8 b1 = *reinterpret_cast<const bf16x8*>(a + 32 * 256);
        p0 = __builtin_amdgcn_mfma_f32_32x32x16_bf16(b0, qr[d0], p0, 0, 0, 0);
        p1 = __builtin_amdgcn_mfma_f32_32x32x16_bf16(b1, qr[d0], p1, 0, 0, 0); }
}
template <int VB>
__device__ __forceinline__ void pv_tile(f32x16* o, int vb0, bf16x8 pa0, bf16x8 pa1, bf16x8 pa2, bf16x8 pa3) {
#define TRRD(dst, off) asm volatile("ds_read_b64_tr_b16 %0, %1 offset:%2" : "=&v"(dst) : "v"(vb0), "i"(off) : "memory")
#define PV_D0(d0) do { s16x4 l0, l1, l2, l3, h0, h1, h2, h3; constexpr int b_ = VB * SHM_V + v_rd_off(d0, 0, 0); \
        TRRD(l0, b_); TRRD(h0, b_ + 2048); TRRD(l1, b_ + 4096); TRRD(h1, b_ + 6144); TRRD(l2, b_ + 8192); TRRD(h2, b_ + 10240); TRRD(l3, b_ + 12288); TRRD(h3, b_ + 14336); \
        asm volatile("s_waitcnt lgkmcnt(0)" ::: "memory"); SBAR();   \
        o[d0] = __builtin_amdgcn_mfma_f32_32x32x16_bf16(pa0, (bf16x8){l0[0], l0[1], l0[2], l0[3], h0[0], h0[1], h0[2], h0[3]}, o[d0], 0, 0, 0);   \
        o[d0] = __builtin_amdgcn_mfma_f32_32x32x16_bf16(pa1, (bf16x8){l1[0], l1[1], l1[2], l1[3], h1[0], h1[1], h1[2], h1[3]}, o[d0], 0, 0, 0);   \
        o[d0] = __builtin_amdgcn_mfma_f32_32x32x16_bf16(pa2, (bf16x8){l2[0], l2[1], l2[2], l2[3], h2[0], h2[1], h2[2], h2[3]}, o[d0], 0, 0, 0);   \
        o[d0] = __builtin_amdgcn_mfma_f32_32x32x16_bf16(pa3, (bf16x8){l3[0], l3[1], l3[2], l3[3], h3[0], h3[1], h3[2], h3[3]}, o[d0], 0, 0, 0); } while (0)
    PV_D0(0); PV_D0(1); PV_D0(2); PV_D0(3);
#undef PV_D0
#undef TRRD
}

struct BlockRef { const bf16* Q; const bf16* K; const bf16* V; bf16* O; const unsigned* sel; int P0; };
struct Seam { bf16x8 qr[8]; bf16x8 st_v0, st_v1, st_k0, st_k1; };
#define KVP(p, k0, half) ((const char*)(p) + (size_t)((k0) + 32 * (half)) * (ldkv * 2))
__device__ __forceinline__ bf16x8 ld16(const char* base, unsigned off) { return *reinterpret_cast<const bf16x8*>(base + off); }
#define VMW() asm volatile("s_waitcnt vmcnt(0)" ::: "memory")
#define VMWN(n) asm volatile("s_waitcnt vmcnt(%0)" :: "i"(n) : "memory")
#define SLOAD_H(Kp, Vp, k0) do { S.st_v0 = ld16(KVP(Vp, k0, 0), kvoff); S.st_v1 = ld16(KVP(Vp, k0, 1), kvoff);              \
                         S.st_k0 = ld16(KVP(Kp, k0, 0), kvoff); S.st_k1 = ld16(KVP(Kp, k0, 1), kvoff); } while (0)
#define SWRITE_HK(bf) do { *(bf16x8*)(K_lds + (bf) * SHM_K + kws) = S.st_k0; *(bf16x8*)(K_lds + (bf) * SHM_K + kws + 32 * 256) = S.st_k1; } while (0)
#define SWRITE_HV(bf) do { *(bf16x8*)(V_lds + (bf) * SHM_V + vst0) = S.st_v0; *(bf16x8*)(V_lds + (bf) * SHM_V + vst1) = S.st_v1; } while (0)
#define SWRITE_H(bf) do { SWRITE_HV(bf); SWRITE_HK(bf); } while (0)
constexpr int ldq = PW, ldkv = PW, ldo = OPW;
__device__ __forceinline__ void attn_prime(const BlockRef& cur, char* lds, Seam& S, const int tid) {
    const int wid = __builtin_amdgcn_readfirstlane(tid >> 6), lane = tid & 63, r32 = lane & 31, hi = lane >> 5;
    const int sr = tid >> 4, sc = (tid & 15) * 8, kws = KSWZ(sr, sc * 2); char* K_lds = lds + 2 * SHM_V;
    const unsigned kvoff = (unsigned)(sr * ldkv + sc) * 2u, qoff = (unsigned)((wid * QBLK + r32) * ldq + hi * 8) * 2u;
    for (int d0 = 0; d0 < 8; ++d0) S.qr[d0] = ld16((const char*)cur.Q + d0 * 32, qoff);
    SLOAD_H(cur.K, cur.V, 0); VMW(); SWRITE_HK(0);
    __syncthreads();
}
__device__ __forceinline__ void attn_block(const BlockRef& cur, const BlockRef& nxt, char* lds, Seam& S, const int tid) {
    const int wid = __builtin_amdgcn_readfirstlane(tid >> 6), lane = tid & 63, r32 = lane & 31, hi = lane >> 5;
    const int NT = (cur.P0 + QB - 1) / KVBLK + 1;
    const int qlo = cur.P0 + wid * QBLK, qm = qlo + r32 - 4 * hi;
    const bool moba = cur.sel != nullptr;
    unsigned selmask = 0u; if (moba) selmask = *(const unsigned*)((const char*)cur.sel + (unsigned)(wid * QBLK + r32) * 4u);
    char* V_lds = lds; char* K_lds = lds + 2 * SHM_V;
    float* ws = (float*)(lds + 2 * SHM_V + 2 * SHM_K) + wid * 64; float* li_l = ws, * al_l = ws + 32;
    float m_reg = -1e30f, l_reg = 0; f32x16 o[4] = {};
    const int sr = tid >> 4, sc = (tid & 15) * 8, vst0 = v_st(sr, sc), vst1 = v_st(32 + sr, sc), kws = KSWZ(sr, sc * 2);
    const unsigned kvoff = (unsigned)(sr * ldkv + sc) * 2u, qoff = (unsigned)((wid * QBLK + r32) * ldq + hi * 8) * 2u;
    const int vb0 = (int)(uintptr_t)V_lds + v_rd_base(lane);
    const bf16* Kh = cur.K; const bf16* Vh = cur.V;
#define RESC(a) do { if (__any((a) < 1.f)) { if (hi == 0) al_l[r32] = (a); asm volatile("s_waitcnt lgkmcnt(0)" ::: "memory");              \
                     for (int d_ = 0; d_ < 4; ++d_) for (int r = 0; r < 16; ++r) o[d_][r] *= al_l[crow(r, hi)]; } } while (0)
#define KBASE(t) ((t) * KVBLK)
#define MASKT(P0_, P1_, t) do { const int kb_ = KBASE(t); if (kb_ + KVBLK - 1 > qlo) mask_tile(P0_, P1_, qm - kb_); \
        else if (moba && kb_ < cur.P0) mask_sel(P0_, P1_, (selmask >> (kb_ >> 8)) & 1u); } while (0)
    constexpr int NQL = 8;
#define SEAM_K0() do { VMWN(NQL); SWRITE_HK(0); SBAR(); } while (0)
    f32x16 pA0, pA1, pB0, pB1; float mnA, mnB, alA, alB; bf16x8 pa0, pa1, pa2, pa3;
    SWRITE_HV(0); SBAR();
    if (NT > 1) { SLOAD_H(Kh, Vh, KBASE(1)); }
    SBAR(); qkt<0>(pA0, pA1, K_lds, r32, hi, S.qr);
    MASKT(pA0, pA1, 0); partialSM(pA0, pA1, m_reg, mnA, alA);
    if (NT > 1) { VMW(); SWRITE_H(1); }
    __syncthreads();
#define HALF_STEP(PX0, PX1, mnX, alX, PY0, PY1, alY, t, KB, VB, SB) do {                                                      \
        SBAR(); qkt<KB>(PX0, PX1, K_lds, r32, hi, S.qr);                                                         \
        finishSM(PY0, PY1, alY, l_reg, pa0, pa1, pa2, pa3); SBAR();                                                           \
        if ((t) + 1 < NT) { SLOAD_H(Kh, Vh, KBASE((t) + 1)); SBAR(); }                                               \
        pv_tile<VB>(o, vb0, pa0, pa1, pa2, pa3); MASKT(PX0, PX1, (t)); partialSM(PX0, PX1, m_reg, mnX, alX);                                        \
        __syncthreads();                                                                                                      \
        if ((t) + 1 < NT) { VMW(); SWRITE_H(SB); }                                                                          \
        RESC(alX); __syncthreads(); } while (0)
    for (int t = 1; t + 1 < NT; t += 2) {
        HALF_STEP(pB0, pB1, mnB, alB, pA0, pA1, alA, t, 1, 0, 0);
        HALF_STEP(pA0, pA1, mnA, alA, pB0, pB1, alB, t + 1, 0, 1, 1);
    }
    const bool even = (NT & 1) == 0;
    if (even) { SBAR(); qkt<1>(pB0, pB1, K_lds, r32, hi, S.qr); SBAR(); }
    { const bf16* Kn = nxt.K; const bf16* Vn = nxt.V; SLOAD_H(Kn, Vn, 0); SBAR(); }
#pragma unroll
    for (int d0 = 0; d0 < 8; ++d0) S.qr[d0] = ld16((const char*)nxt.Q + d0 * 32, qoff);
    SBAR();
    finishSM(pA0, pA1, alA, l_reg, pa0, pa1, pa2, pa3); SBAR();
    pv_tile<0>(o, vb0, pa0, pa1, pa2, pa3);
    if (even) { MASKT(pB0, pB1, NT - 1); partialSM(pB0, pB1, m_reg, mnB, alB); __syncthreads(); RESC(alB);
        finishSM(pB0, pB1, alB, l_reg, pa0, pa1, pa2, pa3); SBAR(); pv_tile<1>(o, vb0, pa0, pa1, pa2, pa3); }
    SBAR(); SEAM_K0();
    if (hi == 0) li_l[r32] = l_reg; asm volatile("s_waitcnt lgkmcnt(0)" ::: "memory");
    float rli[16];
#pragma unroll
    for (int r = 0; r < 16; ++r) rli[r] = __builtin_amdgcn_rcpf(li_l[crow(r, hi)]);
    unsigned ooff = (unsigned)((wid * QBLK + 4 * hi) * ldo + r32) * 2u;
    asm volatile("" : "+v"(ooff));
    char* Ob = (char*)cur.O;
#pragma unroll
    for (int r = 0; r < 16; ++r) { const unsigned orow_b = (unsigned)(((r & 3) + 8 * (r >> 2)) * ldo) * 2u;
#pragma unroll
        for (int d0 = 0; d0 < 4; ++d0) { const float v = o[d0][r] * rli[r];
            const float vn = __shfl_xor(v, 1);
            if ((r32 & 1) == 0) *(unsigned*)(Ob + (ooff + orow_b + d0 * 64)) = cvtpk(v, vn); } }
    __syncthreads();
#undef RESC
#undef KBASE
#undef MASKT
#undef SEAM_K0
#undef HALF_STEP
}
#undef KVP
#undef VMW
#undef VMWN
#undef SLOAD_H
#undef SWRITE_HK
#undef SWRITE_HV
#undef SWRITE_H
}

#define XB_TMO      128
#define XB_XCNT(j)  (256  + 64 * (j))
#define XB_XSUB(j)  (1280 + 64 * (j))
#define XB_XGEN(j)  (2304 + 64 * (j))
#define XB_TOP      3328
#define XB_TOPGEN   3392
#define XCD_BAR_WORDS 3456
#define XB_SPIN_CAP (1u << 18)
__device__ __forceinline__ unsigned xb_ld(unsigned* p)              { return __hip_atomic_load(p, __ATOMIC_RELAXED, __HIP_MEMORY_SCOPE_AGENT); }
__device__ __forceinline__ unsigned xb_add(unsigned* p, unsigned v) { return __hip_atomic_fetch_add(p, v, __ATOMIC_RELAXED, __HIP_MEMORY_SCOPE_AGENT); }
__device__ __forceinline__ unsigned xb_xcc_id() { return (unsigned)__builtin_amdgcn_s_getreg((3 << 11) | 20) & 0xFu; }
#define XB_SPIN(cond, bar) do { unsigned _sp = 0; while (cond) { __builtin_amdgcn_s_sleep(1); \
    if ((++_sp & 255u) == 0u) { if (xb_ld(&(bar)[XB_TMO])) break; if (_sp > XB_SPIN_CAP) { atomicAdd(&(bar)[XB_TMO], 1u); break; } } } } while (0)
struct XcdBarrier { unsigned* bar; unsigned x; volatile LAS unsigned* st; };
__device__ __forceinline__ XcdBarrier xcd_barrier_post(unsigned* bar, volatile LAS unsigned* st) {
    XcdBarrier b; b.bar = bar; b.x = xb_xcc_id(); b.st = st;
    if (threadIdx.x == 0) (void)xb_add(&bar[XB_XCNT(b.x)], 1u);
    return b;
}
__device__ __forceinline__ void xcd_barrier_complete(unsigned* bar, unsigned x, unsigned& nloc, unsigned& nx) {
    const unsigned G = gridDim.x * gridDim.y * gridDim.z;
    unsigned sum, cnt, mine, sp = 0u;
    for (;;) {
        sum = 0u; cnt = 0u; mine = 0u;
#pragma unroll
        for (unsigned j = 0; j < 16; ++j) { const unsigned c = xb_ld(&bar[XB_XCNT(j)]); sum += c; cnt += (c > 0u) ? 1u : 0u; mine = (j == x) ? c : mine; }
        if (sum == G) break;
        __builtin_amdgcn_s_sleep(1);
        if ((++sp & 255u) == 0u) { if (xb_ld(&bar[XB_TMO])) break; if (sp > XB_SPIN_CAP) { atomicAdd(&bar[XB_TMO], 1u); break; } }
    }
    nloc = mine > 0u ? mine : 1u; nx = cnt > 0u ? cnt : 1u;
}
__device__ __forceinline__ void xcd_barrier(const XcdBarrier& b) {
    asm volatile("s_waitcnt vmcnt(0)" ::: "memory");
    __syncthreads();
    if (threadIdx.x == 0) {
        unsigned* bar = b.bar;
        __builtin_amdgcn_s_waitcnt(0);
        unsigned nloc = b.st[0], nx = b.st[1];
        if (nloc == 0u) { xcd_barrier_complete(bar, b.x, nloc, nx); b.st[0] = nloc; b.st[1] = nx; }
        const unsigned old = xb_add(&bar[XB_XSUB(b.x)], 1u);
        const unsigned gen = old / nloc;
        if (old + 1u == (gen + 1u) * nloc) {
            __builtin_amdgcn_fence(__ATOMIC_RELEASE, "agent");
            asm volatile("s_waitcnt vmcnt(0)" ::: "memory");
            const unsigned og = xb_add(&bar[XB_TOP], 1u);
            const unsigned tg = og / nx;
            if (og + 1u == (tg + 1u) * nx) xb_add(&bar[XB_TOPGEN], 1u);
            else XB_SPIN(xb_ld(&bar[XB_TOPGEN]) == tg, bar);
            __builtin_amdgcn_fence(__ATOMIC_ACQUIRE, "agent");
            xb_add(&bar[XB_XGEN(b.x)], 1u);
            asm volatile("s_waitcnt vmcnt(0)" ::: "memory");
        } else {
            XB_SPIN(xb_ld(&bar[XB_XGEN(b.x)]) == gen, bar);
            __builtin_amdgcn_fence(__ATOMIC_ACQUIRE, "agent");
            asm volatile("s_waitcnt vmcnt(0)" ::: "memory");
        }
    }
    __syncthreads();
}

constexpr int NWAVES = 8;
struct Args { const void* in[N_IN]; float* out; unsigned char* ws; int ph_lo, ph_hi; };
static_assert(sizeof(Args) == (N_IN + 2) * 8 + 8, "Args has no padding");

struct Frame {
    LAS unsigned char* lds; char* ldsg; unsigned char* ws; int tid, lane, wave, vcu, G;
};
__device__ __forceinline__ Frame phase_frame(const Frame& F0) {
    Frame F = F0; int t = threadIdx.x; asm volatile("" : "+v"(t)); size_t z = 0; asm volatile("" : "+s"(z));
    F.tid = t; F.lane = t & 63; F.wave = __builtin_amdgcn_readfirstlane(t >> 6); F.ws = F0.ws + z; return F;
}

__device__ __forceinline__ void p0_transpose_item(const float* W, const float* gk, int K, int N, bf16* WT, int rowmode, LAS float* scr, int item, int lane) {
    const int nblk = N / 32, kb = item / nblk, nb = item - kb * nblk, k0 = 64 * kb, n0 = 32 * nb;
#pragma unroll 8
    for (int i = 0; i < 32; ++i) { const int kk = 2 * i + (lane >> 5); float w = W[(size_t)(k0 + kk) * N + n0 + (lane & 31)]; if (gk) w *= gk[k0 + kk]; scr[kk * 33 + (lane & 31)] = w; }
    LDS_WAIT(); asm volatile("" ::: "memory");
    const int c = lane & 7;
    const int rbase = rowmode == 0 ? n0 : ((n0 >> 7) * 256 + (n0 & 127) + (rowmode == 2 ? 128 : 0));
#pragma unroll
    for (int j = 0; j < 4; ++j) { const int n = (lane >> 3) + 8 * j; const LAS float* s = scr + (8 * c) * 33 + n;
        v4u o; o.x = cvt_pk_bf16(s[0 * 33], s[1 * 33]); o.y = cvt_pk_bf16(s[2 * 33], s[3 * 33]); o.z = cvt_pk_bf16(s[4 * 33], s[5 * 33]); o.w = cvt_pk_bf16(s[6 * 33], s[7 * 33]);
        *(GAS v4u*)(WT + (size_t)(rbase + n) * K + k0 + 8 * c) = o; }
    LDS_WAIT(); asm volatile("" ::: "memory");
}

__device__ __forceinline__ void p0_prologue(const Frame& F0, const Args& a) {
    const Frame F = phase_frame(F0);
    LAS float* scr = (LAS float*)(F.lds + F.wave * 16384);
    const int gw = F.vcu * NWAVES + F.wave, NGW = F.G * NWAVES;
    constexpr int I_IN = (DM / 64) * (PW / 32), I_OUT = (DM / 64) * (DM / 32), I_G = (DM / 64) * (DFF / 32), I_D = (DFF / 64) * (DM / 32);
    constexpr int I_LAYER = I_IN + I_OUT + 2 * I_G + I_D;
    for (int it = gw; it < 2 * I_LAYER; it += NGW) {
        const int l = it >= I_LAYER ? 1 : 0; int r = it - l * I_LAYER;
        if (r < I_IN) { p0_transpose_item((const float*)a.in[IN_WIN] + (size_t)l * DM * PW, (const float*)a.in[IN_GATTN] + l * DM, DM, PW, (bf16*)(F.ws + WS_WIN + l * SZ_WIN), 0, scr, r, F.lane); continue; } r -= I_IN;
        if (r < I_OUT) { p0_transpose_item((const float*)a.in[IN_WOUT] + (size_t)l * DM * DM, nullptr, DM, DM, (bf16*)(F.ws + WS_WOUT + l * SZ_WOUT), 0, scr, r, F.lane); continue; } r -= I_OUT;
        if (r < I_G) { p0_transpose_item((const float*)a.in[IN_WGATE] + (size_t)l * DM * DFF, (const float*)a.in[IN_GFFN] + l * DM, DM, DFF, (bf16*)(F.ws + WS_WGU + l * SZ_WGU), 1, scr, r, F.lane); continue; } r -= I_G;
        if (r < I_G) { p0_transpose_item((const float*)a.in[IN_WUP] + (size_t)l * DM * DFF, (const float*)a.in[IN_GFFN] + l * DM, DM, DFF, (bf16*)(F.ws + WS_WGU + l * SZ_WGU), 2, scr, r, F.lane); continue; } r -= I_G;
        p0_transpose_item((const float*)a.in[IN_WDOWN] + (size_t)l * DFF * DM, nullptr, DFF, DM, (bf16*)(F.ws + WS_WDN + l * SZ_WDN), 0, scr, r, F.lane);
    }
    { const float* x = (const float*)a.in[IN_X]; bf16* xb = (bf16*)(F.ws + WS_XB); float* ssb = (float*)(F.ws + WS_SSB);
      for (int m = gw; m < SEQ; m += NGW) {
          const GAS f32x4* xr = (const GAS f32x4*)(x + (size_t)m * DM) + F.lane; GAS v2u* o8 = (GAS v2u*)(xb + (size_t)m * DM) + F.lane; float s = 0.f;
#pragma unroll 4
          for (int j = 0; j < 16; ++j) { const f32x4 v = xr[64 * j]; s += (v[0] * v[0] + v[1] * v[1]) + (v[2] * v[2] + v[3] * v[3]); v2u w; w.x = cvt_pk_bf16(v[0], v[1]); w.y = cvt_pk_bf16(v[2], v[3]); o8[64 * j] = w; }
          s = wave_sum(s);
          if (F.lane < 16) ssb[(size_t)m * 16 + F.lane] = F.lane == 0 ? s : 0.f; } }
    { const int* pos = (const int*)a.in[IN_POS]; float* cs = (float*)(F.ws + WS_CS);
      const float INV[16] = {1.000000000e+00f, 4.403665960e-01f, 1.939227432e-01f, 8.539710194e-02f, 3.760603070e-02f, 1.656043902e-02f, 7.292664610e-03f, 3.211445874e-03f,
                             1.414213562e-03f, 6.227723788e-04f, 2.742481884e-04f, 1.207697351e-04f, 5.318296098e-05f, 2.341999971e-05f, 1.031338616e-05f, 4.541670478e-06f};
      for (int idx = F.vcu * 512 + F.tid; idx < SEQ * 16; idx += F.G * 512) {
          const int row = idx >> 4, i = idx & 15; float inv = INV[0];
#pragma unroll
          for (int k = 1; k < 16; ++k) inv = (i == k) ? INV[k] : inv;
          const float angf = (float)pos[row] * inv; const double ang = (double)angf;
          const double qd = __builtin_rint(ang * 0.63661977236758134308); const int qi = (int)qd;
          double r = __builtin_fma(-qd, 1.57079632679489655800e+00, ang); r = __builtin_fma(-qd, 6.12323399573676603587e-17, r);
          const double r2 = r * r;
          double sp = -2.5052108385441718775e-08; sp = sp * r2 + 2.7557319223985890653e-06; sp = sp * r2 - 1.9841269841269841253e-04; sp = sp * r2 + 8.3333333333333332177e-03; sp = sp * r2 - 1.6666666666666665741e-01;
          const double sn = r + r * r2 * sp;
          double cp = 2.0876756987868098979e-09; cp = cp * r2 - 2.7557319223985888276e-07; cp = cp * r2 + 2.4801587301587301566e-05; cp = cp * r2 - 1.3888888888888889419e-03; cp = cp * r2 + 4.1666666666666664354e-02; cp = cp * r2 - 0.5;
          const double cn = 1.0 + r2 * cp;
          const int q4 = qi & 3;
          const double c = (q4 == 0) ? cn : (q4 == 1) ? -sn : (q4 == 2) ? -cn : sn;
          const double s = (q4 == 0) ? sn : (q4 == 1) ? cn : (q4 == 2) ? -sn : -cn;
          cs[(size_t)row * 32 + i] = (float)c; cs[(size_t)row * 32 + 16 + i] = (float)s; } }
    { const float* mem = (const float*)a.in[IN_MEM]; const float* gm = (const float*)a.in[IN_GMEM]; const float* W = (const float*)a.in[IN_WMEMKV]; float* mkv = (float*)(F.ws + WS_MKV);
      LAS float* am = (LAS float*)(F.lds);
      LAS float* rsd = (LAS float*)(F.lds + 8192);
      for (int it = F.vcu; it < (MEML / 16) * (2 * MEM_W / 128); it += F.G) {
          const int mb = it / (2 * MEM_W / 128), nb = it - mb * (2 * MEM_W / 128), m0 = mb * 16, n0 = nb * 128;
          __syncthreads();
          for (int rr = F.wave; rr < 16; rr += NWAVES) { const GAS f32x4* xr = (const GAS f32x4*)(mem + (size_t)(m0 + rr) * DM) + F.lane; float s = 0.f;
              for (int j = 0; j < 16; ++j) { const f32x4 v = xr[64 * j]; s += (v[0] * v[0] + v[1] * v[1]) + (v[2] * v[2] + v[3] * v[3]); }
              s = wave_sum(s); if (F.lane == 0) rsd[rr] = __builtin_amdgcn_rsqf(s * (1.0f / DM) + NORM_EPS); }
          const int n = F.tid & 127, mg = F.tid >> 7;
          f32x4 acc = {0.f, 0.f, 0.f, 0.f};
          for (int k0 = 0; k0 < DM; k0 += 64) {
              __syncthreads();
              { const int kk = F.tid & 63, r0 = F.tid >> 6;
                const float gg = gm[k0 + kk];
                am[kk * 16 + r0] = mem[(size_t)(m0 + r0) * DM + k0 + kk] * gg; am[kk * 16 + r0 + 8] = mem[(size_t)(m0 + r0 + 8) * DM + k0 + kk] * gg; }
              __syncthreads();
#pragma unroll 8
              for (int kk = 0; kk < 64; ++kk) { const float w = W[(size_t)(k0 + kk) * (2 * MEM_W) + n0 + n]; const f32x4 av = *(const LAS f32x4*)(am + kk * 16 + mg * 4); acc += av * w; }
          }
#pragma unroll
          for (int i = 0; i < 4; ++i) mkv[(size_t)(m0 + mg * 4 + i) * (2 * MEM_W) + n0 + n] = acc[i] * rsd[mg * 4 + i];
      }
      __syncthreads(); }
}

__device__ __forceinline__ void norm_phase(const Frame& F0, const Args& a, int layer) {
    const Frame F = phase_frame(F0);
    bf16* proj = (bf16*)(F.ws + WS_PROJ); const float* cs = (const float*)(F.ws + WS_CS); float* ksum = (float*)(F.ws + WS_KSUM);
    const bool moba = (layer == 0);
    LAS float* red = (LAS float*)F.lds;
    const int l15 = F.lane & 15;
    for (int it = F.vcu; it < 128 * 14; it += F.G) {
        const int cg = it % 14, rb = it / 14;
        const bool is_q = cg < 6, is_k = cg >= 6 && cg < 12, is_m = cg >= 12;
        const int colbase = is_q ? 512 * cg : is_k ? SELF_W + 512 * (cg - 6) : 3 * SELF_W + 512 * (cg - 12);
        float g8[8];
        { const float* gp = is_q ? (const float*)a.in[IN_GQ] + layer * HD : (const float*)a.in[IN_GK] + layer * HD;
#pragma unroll
          for (int j = 0; j < 8; ++j) g8[j] = is_m ? 1.0f : gp[l15 * 8 + j]; }
        float ks8[8];
#pragma unroll
        for (int j = 0; j < 8; ++j) ks8[j] = 0.f;
        for (int i = 0; i < 8; ++i) {
            const int row = rb * 64 + F.wave * 8 + i;
            GAS v4u* p = (GAS v4u*)(proj + (size_t)row * PW + colbase + F.lane * 8);
            const v4u w = *p; float y[8];
            y[0] = bf_lo(w.x); y[1] = bf_hi(w.x); y[2] = bf_lo(w.y); y[3] = bf_hi(w.y); y[4] = bf_lo(w.z); y[5] = bf_hi(w.z); y[6] = bf_lo(w.w); y[7] = bf_hi(w.w);
            float s = 0.f;
#pragma unroll
            for (int j = 0; j < 8; ++j) s += y[j] * y[j];
            s += __shfl_xor(s, 1); s += __shfl_xor(s, 2); s += __shfl_xor(s, 4); s += __shfl_xor(s, 8);
            float rs;
            if (is_m) { s += __shfl_xor(s, 16); rs = __builtin_amdgcn_rsqf(s * (1.0f / 256.0f) + NORM_EPS); }
            else rs = __builtin_amdgcn_rsqf(s * (1.0f / 128.0f) + NORM_EPS);
#pragma unroll
            for (int j = 0; j < 8; ++j) y[j] = y[j] * rs * g8[j];
            if (!is_m) {
                const int ci = (l15 & 1) * 8;
                const f32x4 c0 = *(const f32x4*)(cs + (size_t)row * 32 + ci), c1 = *(const f32x4*)(cs + (size_t)row * 32 + ci + 4);
                const f32x4 s0 = *(const f32x4*)(cs + (size_t)row * 32 + 16 + ci), s1 = *(const f32x4*)(cs + (size_t)row * 32 + 16 + ci + 4);
                const float cc[8] = {c0[0], c0[1], c0[2], c0[3], c1[0], c1[1], c1[2], c1[3]}, sn[8] = {s0[0], s0[1], s0[2], s0[3], s1[0], s1[1], s1[2], s1[3]};
#pragma unroll
                for (int j = 0; j < 8; ++j) { const float other = __shfl_xor(y[j], 2);
                    const float r1 = y[j] * cc[j] - other * sn[j], r2 = y[j] * cc[j] + other * sn[j];
                    y[j] = (l15 < 2) ? r1 : (l15 < 4) ? r2 : y[j]; }
            }
            v4u o; o.x = cvt_pk_bf16(y[0], y[1]); o.y = cvt_pk_bf16(y[2], y[3]); o.z = cvt_pk_bf16(y[4], y[5]); o.w = cvt_pk_bf16(y[6], y[7]);
            *p = o;
#pragma unroll
            for (int j = 0; j < 8; ++j) ks8[j] += y[j];
        }
        if (moba && is_k) {
            __syncthreads();
#pragma unroll
            for (int j = 0; j < 8; ++j) red[F.wave * 512 + F.lane * 8 + j] = ks8[j];
            __syncthreads();
            float t = 0.f;
#pragma unroll
            for (int w = 0; w < 8; ++w) t += red[w * 512 + F.tid];
            const int head = 4 * (cg - 6) + (F.tid >> 7), dim = F.tid & 127, blk = rb >> 2, sub = rb & 3;
            ksum[((size_t)(head * NBLK + blk) * 4 + sub) * HD + dim] = t;
        }
    }
    { const float* mkv = (const float*)(F.ws + WS_MKV); bf16* kmn = (bf16*)(F.ws + WS_KMN); bf16* vt = (bf16*)(F.ws + WS_VT);
      const float* gk = (const float*)a.in[IN_GMK] + layer * 256; const float* gq = (const float*)a.in[IN_GMQ] + layer * 256;
      const int gw = F.vcu * NWAVES + F.wave, NGW = F.G * NWAVES;
      for (int t = gw; t < 4 * MEML; t += NGW) { const int h = t >> 8, key = t & 255;
          const f32x4 v = *(const f32x4*)(mkv + (size_t)key * 2048 + h * 256 + F.lane * 4);
          float s = (v[0] * v[0] + v[1] * v[1]) + (v[2] * v[2] + v[3] * v[3]); s = wave_sum(s);
          const float rs = __builtin_amdgcn_rsqf(s * (1.0f / 256.0f) + NORM_EPS);
          const f32x4 g1 = *(const f32x4*)(gk + F.lane * 4), g2 = *(const f32x4*)(gq + F.lane * 4);
          v2u o; o.x = cvt_pk_bf16(v[0] * rs * g1[0] * g2[0], v[1] * rs * g1[1] * g2[1]); o.y = cvt_pk_bf16(v[2] * rs * g1[2] * g2[2], v[3] * rs * g1[3] * g2[3]);
          *(v2u*)(kmn + (size_t)t * 256 + F.lane * 4) = o; }
      for (int idx = F.vcu * 512 + F.tid; idx < 4 * 256 * 256; idx += F.G * 512) { const int hd = idx >> 8, key = idx & 255;
          const float v = mkv[(size_t)key * 2048 + 1024 + hd]; vt[idx] = (bf16)(cvt_pk_bf16(v, 0.f) & 0xffffu); } }
}

__device__ __forceinline__ void gate_phase(const Frame& F0) {
    const Frame F = phase_frame(F0);
    const bf16* proj = (const bf16*)(F.ws + WS_PROJ); const float* ksum = (const float*)(F.ws + WS_KSUM); unsigned* sel = (unsigned*)(F.ws + WS_SEL);
    LAS float* km = (LAS float*)F.lds;
    for (int it = F.vcu; it < NHEAD * NBLK; it += F.G) {
        const int h = it / NBLK, b0 = it % NBLK;
        __syncthreads();
        for (int e = F.tid; e < b0 * HD; e += 512) { const int blk = e >> 7, dim = e & 127; const float* kp = ksum + ((size_t)(h * NBLK + blk) * 4) * HD + dim;
            km[e] = ((kp[0] + kp[HD]) + (kp[2 * HD] + kp[3 * HD])) * (1.0f / 256.0f); }
        __syncthreads();
        if (F.tid < 256) {
            const int row = b0 * 256 + F.tid;
            const v4u* qp = (const v4u*)(proj + (size_t)row * PW + h * HD);
            v4u q[16];
#pragma unroll
            for (int j = 0; j < 16; ++j) q[j] = qp[j];
            float v1 = -__builtin_inff(), v2 = v1, v3 = v1; int i1 = 32, i2 = 32, i3 = 32;
            for (int blk = 0; blk < b0; ++blk) {
                const LAS f32x4* kr = (const LAS f32x4*)(km + blk * HD); float g0 = 0.f, g1 = 0.f;
#pragma unroll
                for (int j = 0; j < 16; ++j) { const f32x4 ka = kr[2 * j], kb = kr[2 * j + 1];
                    g0 += bf_lo(q[j].x) * ka[0] + bf_hi(q[j].x) * ka[1] + bf_lo(q[j].y) * ka[2] + bf_hi(q[j].y) * ka[3];
                    g1 += bf_lo(q[j].z) * kb[0] + bf_hi(q[j].z) * kb[1] + bf_lo(q[j].w) * kb[2] + bf_hi(q[j].w) * kb[3]; }
                const float gt = g0 + g1;
                if (gt > v1) { v3 = v2; i3 = i2; v2 = v1; i2 = i1; v1 = gt; i1 = blk; }
                else if (gt > v2) { v3 = v2; i3 = i2; v2 = gt; i2 = blk; }
                else if (gt > v3) { v3 = gt; i3 = blk; }
            }
            unsigned m = 0u; if (i1 < 32) m |= 1u << i1; if (i2 < 32) m |= 1u << i2; if (i3 < 32) m |= 1u << i3;
            sel[(size_t)h * SEQ + row] = m;
        }
    }
    __syncthreads();
}

__device__ __forceinline__ att::BlockRef attn_ref(const Frame& F, int layer, int i) {
    const bf16* proj = (const bf16*)(F.ws + WS_PROJ); att::BlockRef r;
    if (layer == 0) {
        const int g = F.vcu >> 5, k = F.vcu & 31;
        const int head = 3 * g + i, qb = (i == 0) ? k : (i == 1) ? ((k + 16) & 31) : (k < 16 ? 31 - 2 * k : 62 - 2 * k);
        r.Q = proj + (size_t)(qb * 256) * PW + head * HD; r.K = proj + SELF_W + head * HD; r.V = proj + 2 * SELF_W + head * HD;
        r.O = (bf16*)(F.ws + WS_ATT) + (size_t)(qb * 256) * OPW + head * HD; r.sel = (const unsigned*)(F.ws + WS_SEL) + (size_t)head * SEQ + qb * 256; r.P0 = qb * 256;
    } else {
        const int item = F.vcu * 3 + (i >> 1), sp = item >> 4, pr = item & 15, qb = (i & 1) ? 31 - pr : pr;
        const int h = sp >> 2, c = (sp >> 1) & 1, e = sp & 1;
        r.Q = proj + (size_t)(qb * 256) * PW + (h * 2 + c) * HD; r.K = proj + SELF_W + (h * 2 + c) * HD; r.V = proj + 2 * SELF_W + h * 256 + e * HD;
        r.O = (bf16*)(F.ws + WS_OP) + (size_t)(qb * 256) * OPW + sp * HD; r.sel = nullptr; r.P0 = qb * 256;
    }
    return r;
}
__device__ __forceinline__ void attn_phase(const Frame& F0, int layer) {
    if (F0.G != 256) return;
    const Frame F = phase_frame(F0);
    char* lds = F.ldsg;
    const int nb = layer == 0 ? 3 : 6;
    att::Seam S;
    att::BlockRef cur = attn_ref(F, layer, 0);
    const int tid_ = F.tid;
    att::attn_prime(cur, lds, S, tid_);
    for (int i = 0; i < nb; ++i) {
        const att::BlockRef nxt = (i + 1 < nb) ? attn_ref(F, layer, i + 1) : cur;
        att::attn_block(cur, nxt, lds, S, tid_);
        cur = nxt;
    }
    VM_WAIT(); __builtin_amdgcn_s_waitcnt(0); __syncthreads();
}

__device__ __forceinline__ void diff_combine_phase(const Frame& F0, const Args& a) {
    const Frame F = phase_frame(F0);
    const bf16* op = (const bf16*)(F.ws + WS_OP); bf16* att_o = (bf16*)(F.ws + WS_ATT);
    float d1 = 0.f, d2 = 0.f;
    { const float* q1 = (const float*)a.in[IN_LQ1]; const float* k1 = (const float*)a.in[IN_LK1]; const float* q2 = (const float*)a.in[IN_LQ2]; const float* k2 = (const float*)a.in[IN_LK2];
      d1 = q1[F.lane] * k1[F.lane] + q1[F.lane + 64] * k1[F.lane + 64]; d2 = q2[F.lane] * k2[F.lane] + q2[F.lane + 64] * k2[F.lane + 64];
      d1 = wave_sum(d1); d2 = wave_sum(d2); }
    const float lam = __expf(d1) - __expf(d2) + LAM_INIT;
    const f32x4 gs = *(const f32x4*)((const float*)a.in[IN_GSUB] + F.lane * 4);
    const int gw = F.vcu * NWAVES + F.wave, NGW = F.G * NWAVES;
    for (int row = gw; row < SEQ; row += NGW) {
        for (int h = 0; h < 12; ++h) {
            const int e = F.lane >> 5, d = (F.lane & 31) * 4;
            const v2u w0 = *(const v2u*)(op + (size_t)row * OPW + ((h * 2 + 0) * 2 + e) * HD + d), w1 = *(const v2u*)(op + (size_t)row * OPW + ((h * 2 + 1) * 2 + e) * HD + d);
            float o[4] = {bf_lo(w0.x) - lam * bf_lo(w1.x), bf_hi(w0.x) - lam * bf_hi(w1.x), bf_lo(w0.y) - lam * bf_lo(w1.y), bf_hi(w0.y) - lam * bf_hi(w1.y)};
            float s = (o[0] * o[0] + o[1] * o[1]) + (o[2] * o[2] + o[3] * o[3]); s = wave_sum(s);
            const float rs = __builtin_amdgcn_rsqf(s * (1.0f / 256.0f) + SUBLN_EPS) * (1.0f - LAM_INIT);
            v2u r; r.x = cvt_pk_bf16(o[0] * rs * gs[0], o[1] * rs * gs[1]); r.y = cvt_pk_bf16(o[2] * rs * gs[2], o[3] * rs * gs[3]);
            *(v2u*)(att_o + (size_t)row * OPW + h * 256 + F.lane * 4) = r;
        }
    }
}

constexpr int N_PHASES = 1 + 2 * 8;
__global__ void __launch_bounds__(NWAVES * 64, 2) hybrid_fwd(Args args) {
    extern __shared__ __attribute__((aligned(16))) unsigned char lds[];
    Frame F;
    F.lds = (LAS unsigned char*)lds; F.ldsg = (char*)lds; F.ws = args.ws;
    F.tid = threadIdx.x; F.lane = F.tid & 63; F.wave = __builtin_amdgcn_readfirstlane(F.tid >> 6);
    F.G = gridDim.x; { const int bx = blockIdx.x; F.vcu = (F.G % 8 == 0) ? (bx % 8) * (F.G / 8) + bx / 8 : bx; }
    volatile LAS unsigned* MISC = (volatile LAS unsigned*)(F.lds + MISC_OFF);
    for (int u = F.tid; u < 64; u += NWAVES * 64) MISC[u] = 0u;
    __syncthreads();
    const int lo = args.ph_lo, hi = args.ph_hi;
    const bool one = (hi - lo) > 1;
    gu32* ctl = (gu32*)(args.ws + WS_CTL);
    XcdBarrier bar; bar.bar = (unsigned*)(ctl + CW_BAR); bar.x = 0; bar.st = nullptr;
    if (one) bar = xcd_barrier_post((unsigned*)(ctl + CW_BAR), MISC + 8);
#ifndef PH_MASK
#define PH_MASK 0xffff
#endif
#define IN(k) (lo <= (k) && (k) < hi)
#define EN(b) ((PH_MASK >> (b)) & 1)
#define SEAM(k) do { if (IN(k) && IN((k) + 1)) { XcdBarrier b2_ = bar; size_t bz_ = 0; asm volatile("" : "+s"(bz_)); b2_.bar = bar.bar + bz_; xcd_barrier(b2_); } } while (0)
    float* xout = args.out;
    PG8_LAS float* exch = (PG8_LAS float*)(F.lds + EXCH_OFF);
#define WSP(T, off) ((T*)(wsl + (off)))
#define WS_LOCAL() size_t wz_ = 0; asm volatile("" : "+s"(wz_)); unsigned char* wsl = args.ws + wz_

    if (EN(0) && IN(0)) { p0_prologue(F, args); }
    SEAM(0);
#pragma unroll 1
    for (int l = 0; l < 2; ++l) {
        const int pb = 1 + 8 * l;
        if (EN(1) && IN(pb + 0)) {
            WS_LOCAL();
            pg8::Gemm g{WSP(bf16, WS_XB), WSP(const bf16, WS_WIN + l * SZ_WIN), SEQ, PW, DM, DM, DM, 0}; pg8::StaticOrder S; S.init(SEQ, PW, F.G, (int)blockIdx.x);
            pg8::EpiProj E{WSP(bf16, WS_PROJ), PW, WSP(float, WS_SSB), 1.0f / DM, NORM_EPS};
            pg8::gemm_phase<pg8::EpiProj, pg8::StaticOrder>(F.lds, g, S, E);
        }
        SEAM(pb + 0);
        if (EN(2) && IN(pb + 1)) { norm_phase(F, args, l); }
        SEAM(pb + 1);
        if (EN(3) && IN(pb + 2)) { if (l == 0) gate_phase(F); }
        SEAM(pb + 2);
        if (IN(pb + 3)) {
            if (EN(4)) { WS_LOCAL();
              pg8::Gemm g{WSP(bf16, WS_PROJ) + 3 * SELF_W, WSP(const bf16, WS_KMN), SEQ, MEM_W, 256, PW, 256, 256}; pg8::StaticOrder S; S.init(SEQ, MEM_W, F.G, (int)blockIdx.x);
              pg8::EpiMemS E{WSP(bf16, WS_PM), WSP(float, WS_PS)};
              pg8::gemm_phase<pg8::EpiMemS, pg8::StaticOrder>(F.lds, g, S, E); }
            __syncthreads();
            if (EN(5)) attn_phase(F, l);
        }
        SEAM(pb + 3);
        if (IN(pb + 4)) {
            if (EN(6)) { WS_LOCAL();
              pg8::Gemm g{WSP(bf16, WS_PM), WSP(const bf16, WS_VT), SEQ, MEM_W, 256, MEM_W, 256, 256}; pg8::StaticOrder S; S.init(SEQ, MEM_W, F.G, (int)blockIdx.x);
              pg8::EpiMemO E{WSP(bf16, WS_ATT), WSP(float, WS_PS)};
              pg8::gemm_phase<pg8::EpiMemO, pg8::StaticOrder>(F.lds, g, S, E); }
            if (EN(7) && l == 1) diff_combine_phase(F, args);
        }
        SEAM(pb + 4);
        if (EN(8) && IN(pb + 5)) {
            WS_LOCAL();
            pg8::Gemm g{WSP(bf16, WS_ATT), WSP(const bf16, WS_WOUT + l * SZ_WOUT), SEQ, DM, DM, OPW, DM, 0}; pg8::StaticOrder S; S.init(SEQ, DM, F.G, (int)blockIdx.x);
            pg8::EpiRes<true> E{l == 0 ? (const float*)args.in[IN_X] : xout, xout, WSP(bf16, WS_XB), WSP(float, WS_SSA), DM, exch};
            pg8::gemm_phase<pg8::EpiRes<true>, pg8::StaticOrder>(F.lds, g, S, E);
        }
        SEAM(pb + 5);
        if (EN(9) && IN(pb + 6)) {
            WS_LOCAL();
            pg8::Gemm g{WSP(bf16, WS_XB), WSP(const bf16, WS_WGU + l * SZ_WGU), SEQ, NGU, DM, DM, DM, 0}; pg8::StaticOrder S; S.init(SEQ, NGU, F.G, (int)blockIdx.x);
            pg8::EpiGU E{WSP(bf16, WS_HID), DFF, WSP(float, WS_SSA), 1.0f / DM, NORM_EPS};
            pg8::gemm_phase<pg8::EpiGU, pg8::StaticOrder>(F.lds, g, S, E);
        }
        SEAM(pb + 6);
        if (EN(10) && IN(pb + 7)) {
            WS_LOCAL();
            pg8::Gemm g{WSP(bf16, WS_HID), WSP(const bf16, WS_WDN + l * SZ_WDN), SEQ, DM, DFF, DFF, DFF, 0}; pg8::StaticOrder S; S.init(SEQ, DM, F.G, (int)blockIdx.x);
            pg8::EpiRes<true> E{xout, xout, WSP(bf16, WS_XB), WSP(float, WS_SSB), DM, exch};
            pg8::gemm_phase<pg8::EpiRes<true>, pg8::StaticOrder>(F.lds, g, S, E);
        }
        SEAM(pb + 7);
    }
#undef IN
#undef SEAM
}

extern "C" void kernel_launch(void* const* d_in, const int* in_sizes, int n_in, void* d_out, int out_size, void* d_ws, size_t ws_size, hipStream_t stream) {
    static int grid = 0;
    if (grid == 0) {
        if (n_in != N_IN || in_sizes[0] != SEQ * DM || out_size != SEQ * DM || ws_size < WS_END) {
            fprintf(stderr, "kernel_launch: unexpected shapes (n_in %d, in0 %d, out %d, ws %zu < %zu); nothing launched\n", n_in, n_in > 0 ? in_sizes[0] : -1, out_size, ws_size, (size_t)WS_END); grid = -1; return; }
        int dev = 0, cus = 0, per_cu = 0;
        if (hipGetDevice(&dev) != hipSuccess || hipDeviceGetAttribute(&cus, hipDeviceAttributeMultiprocessorCount, dev) != hipSuccess) { grid = -1; return; }
        if (hipFuncSetAttribute((const void*)hybrid_fwd, hipFuncAttributeMaxDynamicSharedMemorySize, LDS_BYTES) != hipSuccess) { fprintf(stderr, "kernel_launch: hipFuncSetAttribute failed\n"); grid = -1; return; }
        if (hipOccupancyMaxActiveBlocksPerMultiprocessor(&per_cu, (const void*)hybrid_fwd, NWAVES * 64, LDS_BYTES) != hipSuccess || per_cu < 1)
            fprintf(stderr, "kernel_launch: note: occupancy query reports %d workgroups per CU\n", per_cu);
        (void)hipGetLastError();
        grid = cus;
        if (grid != 256) fprintf(stderr, "kernel_launch: %d CUs; the attention phase is dealt for 256\n", grid);
    }
    if (grid < 0) return;
    if (hipMemsetAsync((char*)d_ws + WS_CTL, 0, CTL_ZERO_BYTES, stream) != hipSuccess) return;
    Args a{};
    for (int i = 0; i < N_IN; ++i) a.in[i] = d_in[i];
    a.out = (float*)d_out; a.ws = (unsigned char*)d_ws;
#if MK_ONE_LAUNCH
    a.ph_lo = 0; a.ph_hi = N_PHASES;
    hipLaunchKernelGGL(hybrid_fwd, dim3(grid), dim3(NWAVES * 64), LDS_BYTES, stream, a);
#else
    for (int p = 0; p < N_PHASES; ++p) {
        if (p == 1 + 8 + 2) continue;
        a.ph_lo = p; a.ph_hi = p + 1;
        hipLaunchKernelGGL(hybrid_fwd, dim3(grid), dim3(NWAVES * 64), LDS_BYTES, stream, a);
    }
#endif
}
```

```cpp
#include <hip/hip_runtime.h>
#include <cstdio>
#include <cstdint>

#ifndef MK_ONE_LAUNCH
#define MK_ONE_LAUNCH 1
#endif

constexpr int SEQ = 8192, DM = 4096, PW = 10240, SELF_W = 3072, MEM_W = 1024, DFF = 11008, NGU = 2 * DFF, MEML = 256, HD = 128;
constexpr int NHEAD = 24;
constexpr int NBLK = SEQ / 256;
constexpr int OPW = 48 * HD;
constexpr float NORM_EPS = 1e-6f, SUBLN_EPS = 1e-5f;
constexpr float LAM_INIT = 0.35550906759096934f;

enum { IN_X = 0, IN_MEM, IN_POS, IN_GATTN, IN_WIN, IN_WOUT, IN_GQ, IN_GK, IN_GMQ, IN_GMK, IN_GMEM, IN_WMEMKV, IN_LQ1, IN_LK1, IN_LQ2, IN_LK2, IN_GSUB, IN_GFFN, IN_WGATE, IN_WUP, IN_WDOWN, N_IN };

constexpr size_t MiB = 1u << 20;
constexpr size_t SZ_WIN = (size_t)PW * DM * 2, SZ_WOUT = (size_t)DM * DM * 2, SZ_WGU = (size_t)NGU * DM * 2, SZ_WDN = (size_t)DM * DFF * 2;
constexpr size_t WS_CTL = 0, CTL_ZERO_BYTES = 64 * 1024;
constexpr size_t WS_WIN = 1 * MiB;
constexpr size_t WS_WOUT = WS_WIN + 2 * SZ_WIN;
constexpr size_t WS_WGU = WS_WOUT + 2 * SZ_WOUT;
constexpr size_t WS_WDN = WS_WGU + 2 * SZ_WGU;
constexpr size_t WS_XB = WS_WDN + 2 * SZ_WDN;
constexpr size_t WS_PROJ = WS_XB + (size_t)SEQ * DM * 2;
constexpr size_t WS_ATT = WS_PROJ + (size_t)SEQ * PW * 2;
constexpr size_t WS_HID = WS_ATT + (size_t)SEQ * OPW * 2;
constexpr size_t WS_OP = WS_HID + (size_t)SEQ * DFF * 2;
constexpr size_t WS_PM = WS_OP + (size_t)SEQ * OPW * 2;
constexpr size_t WS_SSA = WS_PM + (size_t)SEQ * MEM_W * 2;
constexpr size_t WS_SSB = WS_SSA + 1 * MiB;
constexpr size_t WS_CS = WS_SSB + 1 * MiB;
constexpr size_t WS_MKV = WS_CS + 1 * MiB;
constexpr size_t WS_KMN = WS_MKV + 2 * MiB;
constexpr size_t WS_VT = WS_KMN + 1 * MiB;
constexpr size_t WS_KSUM = WS_VT + 1 * MiB;
constexpr size_t WS_SEL = WS_KSUM + 2 * MiB;
constexpr size_t WS_PS = WS_SEL + 1 * MiB;
constexpr size_t WS_END = WS_PS + 1 * MiB;
constexpr int CW_TMO = 0, CW_BAR = 4096;

constexpr int RING_BYTES = 131072;
constexpr int EXCH_OFF = RING_BYTES;
constexpr int MISC_OFF = EXCH_OFF + 4096;
constexpr int LDS_BYTES = 147456;
static_assert(MISC_OFF + 256 <= LDS_BYTES, "LDS map");

#define GAS __attribute__((address_space(1)))
#define LAS __attribute__((address_space(3)))
typedef unsigned short bf16;
typedef unsigned v4u __attribute__((ext_vector_type(4)));
typedef unsigned v2u __attribute__((ext_vector_type(2)));
typedef float f32x4 __attribute__((ext_vector_type(4)));
typedef float f32x2 __attribute__((ext_vector_type(2)));
typedef float f32x16 __attribute__((ext_vector_type(16)));
typedef short bf16x8 __attribute__((ext_vector_type(8)));
typedef short s16x4 __attribute__((ext_vector_type(4)));
typedef GAS unsigned gu32;
#define RLX_AGENT __ATOMIC_RELAXED, __HIP_MEMORY_SCOPE_AGENT
#define LDS_WAIT() asm volatile("s_waitcnt lgkmcnt(0)" ::: "memory")
#define VM_WAIT() asm volatile("s_waitcnt vmcnt(0)" ::: "memory")

__device__ __forceinline__ unsigned cvt_pk_bf16(float lo, float hi) { unsigned r; asm volatile("v_cvt_pk_bf16_f32 %0, %1, %2" : "=v"(r) : "v"(lo), "v"(hi)); return r; }
__device__ __forceinline__ float bf_lo(unsigned w) { return __uint_as_float(w << 16); }
__device__ __forceinline__ float bf_hi(unsigned w) { return __uint_as_float(w & 0xffff0000u); }
__device__ __forceinline__ float wave_sum(float v) {
#pragma unroll
    for (int o = 1; o < 64; o <<= 1) v += __shfl_xor(v, o);
    return v;
}

namespace pg8 {
#define PG8_LAS __attribute__((address_space(3)))
typedef unsigned short bf16_t;
typedef unsigned u32x4 __attribute__((ext_vector_type(4)));
constexpr int BM = 256, BK = 64, HALF = 128, HTB = HALF * BK * 2, STAGE_BYTES = 8 * HTB, NXCD = 8, WGM = 8;

__host__ __device__ __forceinline__ int lds_byte(int r, int c) { const int st = (r >> 4) * 2 + (c >> 5), rr = r & 15, cc = c & 31, ob = rr * 64 + cc * 2; return st * 1024 + (ob ^ (((ob >> 9) & 1) << 5)); }
__host__ __device__ __forceinline__ void stage_rc(int b, int& R, int& C) { const int st = b / 1024, sb = b % 1024, swz = sb ^ (((sb >> 9) & 1) << 5); R = (st >> 1) * 16 + swz / 64; C = (st & 1) * 32 + (swz % 64) / 2; }
__host__ __device__ __forceinline__ int perm32(int rho) { const int n = rho >> 4, i = rho & 15; return 8 * (i >> 2) + 4 * n + (i & 3); }

struct Unit { int pm, pn; };
struct Gemm { const bf16_t* A; const bf16_t* Bt; int M, N, K, lda, ldb, a_pn_step; };

struct StaticOrder {
    int nM, nN, nwg, G, c;
    __host__ __device__ void init(int M, int N, int G_, int c_) { nM = M / BM; nN = N / BM; nwg = nM * nN; G = G_; c = c_; }
    __host__ __device__ bool next(int i, Unit& u) const {
        const long L = (long)i * G + c; if (L >= nwg) return false;
        int wgid = (int)L; { const int q = nwg / NXCD, r = nwg % NXCD, xcd = wgid % NXCD, off = wgid / NXCD; wgid = (xcd < r ? xcd * (q + 1) : r * (q + 1) + (xcd - r) * q) + off; }
        const int nig = WGM * nN, gid = wgid / nig, fm = gid * WGM, gsz = (nM - fm) < WGM ? (nM - fm) : WGM;
        u.pm = fm + ((wgid % nig) % gsz); u.pn = (wgid % nig) / gsz; return true;
    }
    __device__ __forceinline__ void a_ready(const Unit&) const {}
    __device__ __forceinline__ void done(const Unit&) const {}
};

__device__ __forceinline__ float row_rstd(const float* ss, int row, float inv_d, float eps) {
    const f32x4* sp = (const f32x4*)(ss + (size_t)row * 16);
    const f32x4 a = sp[0], b = sp[1], c = sp[2], d = sp[3];
    const float t = ((a[0] + a[1]) + (a[2] + a[3])) + ((b[0] + b[1]) + (b[2] + b[3])) + ((c[0] + c[1]) + (c[2] + c[3])) + ((d[0] + d[1]) + (d[2] + d[3]));
    return __builtin_amdgcn_rsqf(t * inv_d + eps);
}
struct EpiProj {
    static constexpr bool PERM = true, AFTER_DRAIN = false;
    bf16_t* O; int ldc; const float* ss; float inv_d, eps;
    __device__ __forceinline__ void operator()(const f32x4 (&acc)[2][2][4][2], const Unit& u, int wr, int wc, int fr, int fq) const {
        const int row0 = u.pm * BM + wr * 64 + fr, col0 = u.pn * BM + wc * 32 + 8 * fq;
#pragma unroll
        for (int ai = 0; ai < 2; ++ai)
#pragma unroll
            for (int m = 0; m < 4; ++m) { const int row = row0 + ai * HALF + m * 16; const float rs = row_rstd(ss, row, inv_d, eps);
                bf16_t* rowp = O + (size_t)row * ldc + col0;
#pragma unroll
                for (int bj = 0; bj < 2; ++bj) { const f32x4 v0 = acc[ai][bj][m][0] * rs, v1 = acc[ai][bj][m][1] * rs;
                    u32x4 w; w.x = cvt_pk_bf16(v0[0], v0[1]); w.y = cvt_pk_bf16(v0[2], v0[3]); w.z = cvt_pk_bf16(v1[0], v1[1]); w.w = cvt_pk_bf16(v1[2], v1[3]);
                    *(u32x4*)(rowp + bj * HALF) = w; } }
    }
};
__device__ __forceinline__ float silu_mul(float g, float u) { const float e = __builtin_amdgcn_exp2f(-1.4426950408889634f * g); return g * __builtin_amdgcn_rcpf(1.0f + e) * u; }
struct EpiGU {
    static constexpr bool PERM = true, AFTER_DRAIN = false;
    bf16_t* O; int ldc; const float* ss; float inv_d, eps;
    __device__ __forceinline__ void operator()(const f32x4 (&acc)[2][2][4][2], const Unit& u, int wr, int wc, int fr, int fq) const {
        const int row0 = u.pm * BM + wr * 64 + fr, col0 = u.pn * HALF + wc * 32 + 8 * fq;
#pragma unroll
        for (int ai = 0; ai < 2; ++ai)
#pragma unroll
            for (int m = 0; m < 4; ++m) { const int row = row0 + ai * HALF + m * 16; const float rs = row_rstd(ss, row, inv_d, eps);
                const f32x4 g0 = acc[ai][0][m][0] * rs, g1 = acc[ai][0][m][1] * rs, u0 = acc[ai][1][m][0] * rs, u1 = acc[ai][1][m][1] * rs;
                u32x4 w; w.x = cvt_pk_bf16(silu_mul(g0[0], u0[0]), silu_mul(g0[1], u0[1])); w.y = cvt_pk_bf16(silu_mul(g0[2], u0[2]), silu_mul(g0[3], u0[3]));
                w.z = cvt_pk_bf16(silu_mul(g1[0], u1[0]), silu_mul(g1[1], u1[1])); w.w = cvt_pk_bf16(silu_mul(g1[2], u1[2]), silu_mul(g1[3], u1[3]));
                *(u32x4*)(O + (size_t)row * ldc + col0) = w; }
    }
};
template <bool STATS> struct EpiRes {
    static constexpr bool PERM = true, AFTER_DRAIN = false;
    const float* base; float* out; bf16_t* xb; float* ss; int ldc; PG8_LAS float* exch;
    __device__ __forceinline__ void operator()(const f32x4 (&acc)[2][2][4][2], const Unit& u, int wr, int wc, int fr, int fq) const {
        const int row0 = u.pm * BM + wr * 64 + fr, col0 = u.pn * BM + wc * 32 + 8 * fq;
#pragma unroll
        for (int ai = 0; ai < 2; ++ai)
#pragma unroll
            for (int m = 0; m < 4; ++m) { const int row = row0 + ai * HALF + m * 16; const size_t off = (size_t)row * ldc + col0; float q = 0.f;
#pragma unroll
                for (int bj = 0; bj < 2; ++bj) { const f32x4 b0 = *(const f32x4*)(base + off + bj * HALF), b1 = *(const f32x4*)(base + off + bj * HALF + 4);
                    const f32x4 o0 = b0 + acc[ai][bj][m][0], o1 = b1 + acc[ai][bj][m][1];
                    *(f32x4*)(out + off + bj * HALF) = o0; *(f32x4*)(out + off + bj * HALF + 4) = o1;
                    if (STATS) { q += (o0[0] * o0[0] + o0[1] * o0[1]) + (o0[2] * o0[2] + o0[3] * o0[3]) + (o1[0] * o1[0] + o1[1] * o1[1]) + (o1[2] * o1[2] + o1[3] * o1[3]);
                        u32x4 w; w.x = cvt_pk_bf16(o0[0], o0[1]); w.y = cvt_pk_bf16(o0[2], o0[3]); w.z = cvt_pk_bf16(o1[0], o1[1]); w.w = cvt_pk_bf16(o1[2], o1[3]);
                        *(u32x4*)(xb + off + bj * HALF) = w; } }
                if (STATS) { q += __shfl_xor(q, 16); q += __shfl_xor(q, 32); if (fq == 0) exch[(ai * HALF + wr * 64 + m * 16 + fr) * 4 + wc] = q; }
                asm volatile("" ::: "memory"); }
        if (STATS) {
            asm volatile("s_waitcnt lgkmcnt(0)" ::: "memory"); __builtin_amdgcn_s_barrier(); asm volatile("" ::: "memory");
            const int t = threadIdx.x;
            if (t < 256) { const f32x4 p = *(const PG8_LAS f32x4*)(exch + t * 4); ss[(size_t)(u.pm * BM + t) * 16 + u.pn] = (p[0] + p[1]) + (p[2] + p[3]); }
        }
    }
};
struct EpiMemS {
    static constexpr bool PERM = true, AFTER_DRAIN = false;
    bf16_t* P; float* ps;
    __device__ __forceinline__ void operator()(const f32x4 (&acc)[2][2][4][2], const Unit& u, int wr, int wc, int fr, int fq) const {
        const int row0 = u.pm * BM + wr * 64 + fr, col0 = u.pn * BM + wc * 32 + 8 * fq; constexpr float C = 0.0625f * 1.4426950408889634f;
#pragma unroll
        for (int ai = 0; ai < 2; ++ai)
#pragma unroll
            for (int m = 0; m < 4; ++m) { const int row = row0 + ai * HALF + m * 16;
#pragma unroll
                for (int bj = 0; bj < 2; ++bj) { const f32x4 a0 = acc[ai][bj][m][0], a1 = acc[ai][bj][m][1];
                    u32x4 w; w.x = cvt_pk_bf16(__builtin_amdgcn_exp2f(a0[0] * C), __builtin_amdgcn_exp2f(a0[1] * C)); w.y = cvt_pk_bf16(__builtin_amdgcn_exp2f(a0[2] * C), __builtin_amdgcn_exp2f(a0[3] * C));
                    w.z = cvt_pk_bf16(__builtin_amdgcn_exp2f(a1[0] * C), __builtin_amdgcn_exp2f(a1[1] * C)); w.w = cvt_pk_bf16(__builtin_amdgcn_exp2f(a1[2] * C), __builtin_amdgcn_exp2f(a1[3] * C));
                    *(u32x4*)(P + (size_t)row * MEM_W + col0 + bj * HALF) = w;
                    float q = ((bf_lo(w.x) + bf_hi(w.x)) + (bf_lo(w.y) + bf_hi(w.y))) + ((bf_lo(w.z) + bf_hi(w.z)) + (bf_lo(w.w) + bf_hi(w.w)));
                    q += __shfl_xor(q, 16); q += __shfl_xor(q, 32);
                    if (fq == 0) ps[((size_t)row * 4 + u.pn) * 8 + bj * 4 + wc] = q; } }
    }
};
struct EpiMemO {
    static constexpr bool PERM = true, AFTER_DRAIN = false;
    bf16_t* O; const float* ps;
    __device__ __forceinline__ void operator()(const f32x4 (&acc)[2][2][4][2], const Unit& u, int wr, int wc, int fr, int fq) const {
        const int row0 = u.pm * BM + wr * 64 + fr, col0 = SELF_W + u.pn * BM + wc * 32 + 8 * fq;
#pragma unroll
        for (int ai = 0; ai < 2; ++ai)
#pragma unroll
            for (int m = 0; m < 4; ++m) { const int row = row0 + ai * HALF + m * 16;
                const f32x4* lp = (const f32x4*)(ps + ((size_t)row * 4 + u.pn) * 8); const f32x4 la = lp[0], lb = lp[1];
                const float rl = 1.0f / (((la[0] + la[1]) + (la[2] + la[3])) + ((lb[0] + lb[1]) + (lb[2] + lb[3])));
#pragma unroll
                for (int bj = 0; bj < 2; ++bj) { const f32x4 v0 = acc[ai][bj][m][0] * rl, v1 = acc[ai][bj][m][1] * rl;
                    u32x4 w; w.x = cvt_pk_bf16(v0[0], v0[1]); w.y = cvt_pk_bf16(v0[2], v0[3]); w.z = cvt_pk_bf16(v1[0], v1[1]); w.w = cvt_pk_bf16(v1[2], v1[3]);
                    *(u32x4*)(O + (size_t)row * OPW + col0 + bj * HALF) = w; } }
    }
};

template <class Epi, class Sched, bool ALIGN_EPI = true>
__device__ __forceinline__ void gemm_phase(PG8_LAS unsigned char* lds, const Gemm g, const Sched& S, const Epi& E) {
    int tid_ = threadIdx.x; asm volatile("" : "+v"(tid_));
    const int tid = tid_, wid = __builtin_amdgcn_readfirstlane(tid >> 6), lane = tid & 63, wr = wid >> 2, wc = wid & 3, fr = lane & 15, fq = lane >> 4;
    const int K = g.K, nt = K / BK;
    unsigned voffA[2], voffB[2];
#pragma unroll
    for (int i = 0; i < 2; ++i) { int R, C; stage_rc(tid * 16 + i * 8192, R, C); const int Rb = Epi::PERM ? ((R & ~31) + perm32(R & 31)) : R;
        voffA[i] = (unsigned)(R * g.lda + C) * 2u; voffB[i] = (unsigned)(Rb * g.ldb + C) * 2u; }
    const size_t kstep = (size_t)(BK * 2);
    const size_t hstepA = (size_t)HALF * g.lda * 2, hstepB = (size_t)HALF * g.ldb * 2;
    const size_t tstepA = 2 * hstepA, tstepB = 2 * hstepB, pnstepA = (size_t)g.a_pn_step * 2;
    const unsigned ldsw = (unsigned)wid * 1024u;
    const int aoff = lds_byte(wr * 64 + fr, fq * 8), boff = lds_byte(wc * 32 + fr, fq * 8);
#define PG8_SA(b, h) (((b) * 2 + (h)) * HTB)
#define PG8_SB(b, h) ((4 + (b) * 2 + (h)) * HTB)
#define PG8_STAGE(bufoff, gbase, voff) do { _Pragma("unroll") for (int _i = 0; _i < 2; ++_i) \
        __builtin_amdgcn_global_load_lds((const unsigned*)((const char*)(gbase) + (voff)[_i]), (PG8_LAS unsigned*)(lds + (bufoff) + ldsw + _i * 8192), 16, 0, 0); } while (0)
#define PG8_LDA(dst, b, h) do { _Pragma("unroll") for (int m = 0; m < 4; ++m) _Pragma("unroll") for (int k = 0; k < 2; ++k) dst[m][k] = *(const PG8_LAS bf16x8*)(lds + PG8_SA(b, h) + aoff + m * 2048 + k * 1024); } while (0)
#define PG8_LDB(dst, b, h) do { _Pragma("unroll") for (int n = 0; n < 2; ++n) _Pragma("unroll") for (int k = 0; k < 2; ++k) dst[n][k] = *(const PG8_LAS bf16x8*)(lds + PG8_SB(b, h) + boff + n * 2048 + k * 1024); } while (0)
#define PG8_MMA(ai, bj, At, Bt) do { __builtin_amdgcn_s_setprio(1); _Pragma("unroll") for (int m = 0; m < 4; ++m) _Pragma("unroll") for (int n = 0; n < 2; ++n) _Pragma("unroll") for (int k = 0; k < 2; ++k) \
        acc[ai][bj][m][n] = __builtin_amdgcn_mfma_f32_16x16x32_bf16(Bt[n][k], At[m][k], acc[ai][bj][m][n], 0, 0, 0); __builtin_amdgcn_s_setprio(0); } while (0)
#define PG8_WAIT_V(n) asm volatile("s_waitcnt vmcnt(" #n ")" ::: "memory")
#define PG8_WAIT_L(n) asm volatile("s_waitcnt lgkmcnt(" #n ")" ::: "memory")
#define PG8_BAR __builtin_amdgcn_s_barrier()
#define PG8_SCHED __builtin_amdgcn_sched_barrier(0)
    __builtin_amdgcn_s_waitcnt(0);
    Unit cur, nxt; int ui = 0;
    if (!S.next(0, cur)) return;
    f32x4 acc[2][2][4][2];
#pragma unroll
    for (int a = 0; a < 2; ++a)
#pragma unroll
        for (int b = 0; b < 2; ++b)
#pragma unroll
            for (int m = 0; m < 4; ++m)
#pragma unroll
                for (int n = 0; n < 2; ++n) acc[a][b][m][n] = (f32x4){0.f, 0.f, 0.f, 0.f};
    bf16x8 At[4][2], B0[2][2], B1[2][2];
    const char* cA = (const char*)g.A + (size_t)cur.pm * tstepA + (size_t)cur.pn * pnstepA; const char* cB = (const char*)g.Bt + (size_t)cur.pn * tstepB;
    S.a_ready(cur);
    PG8_STAGE(PG8_SB(0, 0), cB, voffB); PG8_STAGE(PG8_SB(0, 1), cB + hstepB, voffB); PG8_STAGE(PG8_SA(0, 0), cA, voffA); PG8_STAGE(PG8_SA(0, 1), cA + hstepA, voffA);
    if (wr == 1) PG8_BAR;
    PG8_WAIT_V(2); PG8_BAR;
    PG8_STAGE(PG8_SB(1, 0), cB + kstep, voffB); PG8_STAGE(PG8_SA(1, 0), cA + kstep, voffA); PG8_STAGE(PG8_SB(1, 1), cB + hstepB + kstep, voffB);
    PG8_WAIT_V(6); PG8_BAR;
    for (;;) {
        const bool has_next = S.next(ui + 1, nxt);
        const char* nA = has_next ? (const char*)g.A + (size_t)nxt.pm * tstepA + (size_t)nxt.pn * pnstepA : cA; const char* nB = has_next ? (const char*)g.Bt + (size_t)nxt.pn * tstepB : cB;
#pragma unroll 1
        for (int t = 0; t < nt; t += 2) {
            const bool last = (t == nt - 2);
            const char* a1 = cA + (size_t)(t + 1) * kstep;
            const char* a2 = last ? nA : cA + (size_t)(t + 2) * kstep; const char* b2 = last ? nB : cB + (size_t)(t + 2) * kstep;
            const char* a3 = a2 + kstep; const char* b3 = b2 + kstep;
            if (last && has_next) S.a_ready(nxt);
            PG8_LDB(B0, 0, 0); PG8_LDB(B1, 0, 1); PG8_SCHED; PG8_LDA(At, 0, 0); PG8_STAGE(PG8_SA(1, 1), a1 + hstepA, voffA);
            PG8_WAIT_V(8); PG8_WAIT_L(0); PG8_BAR; PG8_MMA(0, 0, At, B0); PG8_MMA(0, 1, At, B1); PG8_BAR; PG8_SCHED;
            PG8_LDA(At, 0, 1); PG8_STAGE(PG8_SB(0, 0), b2, voffB); PG8_STAGE(PG8_SB(0, 1), b2 + hstepB, voffB); PG8_STAGE(PG8_SA(0, 0), a2, voffA);
            PG8_WAIT_V(8); PG8_WAIT_L(0); PG8_BAR; PG8_MMA(1, 0, At, B0); PG8_MMA(1, 1, At, B1); PG8_BAR; PG8_SCHED;
            PG8_LDB(B0, 1, 0); PG8_LDB(B1, 1, 1); PG8_SCHED; PG8_LDA(At, 1, 0); PG8_STAGE(PG8_SA(0, 1), a2 + hstepA, voffA);
            PG8_WAIT_V(8); PG8_WAIT_L(0); PG8_BAR; PG8_MMA(0, 0, At, B0); PG8_MMA(0, 1, At, B1); PG8_BAR; PG8_SCHED;
            PG8_LDA(At, 1, 1); PG8_STAGE(PG8_SB(1, 0), b3, voffB); PG8_STAGE(PG8_SB(1, 1), b3 + hstepB, voffB); PG8_STAGE(PG8_SA(1, 0), a3, voffA);
            PG8_WAIT_V(8); PG8_WAIT_L(0); PG8_BAR; PG8_MMA(1, 0, At, B0); PG8_MMA(1, 1, At, B1); PG8_BAR; PG8_SCHED;
        }
        if constexpr (ALIGN_EPI) { if (wr == 0) PG8_BAR; }
        E(acc, cur, wr, wc, fr, fq); S.done(cur);
        if (!has_next) break;
#pragma unroll
        for (int a = 0; a < 2; ++a)
#pragma unroll
            for (int b = 0; b < 2; ++b)
#pragma unroll
                for (int m = 0; m < 4; ++m)
#pragma unroll
                    for (int n = 0; n < 2; ++n) acc[a][b][m][n] = (f32x4){0.f, 0.f, 0.f, 0.f};
        cur = nxt; cA = nA; cB = nB; ++ui;
        if constexpr (ALIGN_EPI) { if (wr == 1) PG8_BAR; }
    }
    PG8_WAIT_V(0); __builtin_amdgcn_s_waitcnt(0);
    if constexpr (!ALIGN_EPI) { if (wr == 0) PG8_BAR; }
    PG8_BAR;
#undef PG8_SA
#undef PG8_SB
#undef PG8_STAGE
#undef PG8_LDA
#undef PG8_LDB
#undef PG8_MMA
#undef PG8_WAIT_V
#undef PG8_WAIT_L
#undef PG8_BAR
#undef PG8_SCHED
}
}

namespace att {
constexpr float SCALE = 0.08838834764831845f;
constexpr int NW = 8, QBLK = 32, KVBLK = 64, QB = NW * QBLK, D = 128;
constexpr int SHM_V = KVBLK * D * 2, SHM_K = KVBLK * D * 2;
constexpr int ATT_LDS_BYTES = 2 * SHM_V + 2 * SHM_K + NW * 64 * 4;
constexpr float THR = 8.f;
#define KSWZ(row, colB) ((row) * 256 + ((colB) ^ (((row) & 7) << 4)))
#define SBAR() __builtin_amdgcn_sched_barrier(0)
__device__ __forceinline__ int v_st(int k, int c) { const int kk = (k & ~0xC) | ((k & 4) << 1) | ((k & 8) >> 1); return ((kk >> 3) * 4 + (c >> 5)) * 512 + ((kk & 7) * 32 + (c & 31)) * 2; }
__device__ __forceinline__ int v_rd_base(int lane) { return ((lane & 3) << 3) | (((lane >> 2) & 3) << 6) | (((lane >> 4) & 1) << 5) | (((lane >> 5) & 1) << 8); }
constexpr int v_rd_off(int d0, int ks, int half) { return d0 * 512 + ks * 4096 + half * 2048; }
__device__ __forceinline__ int crow(int r, int hi) { return (r & 3) + 8 * (r >> 2) + 4 * hi; }
__device__ __forceinline__ unsigned cvtpk(float lo, float hi) { unsigned r; asm volatile("v_cvt_pk_bf16_f32 %0, %1, %2" : "=v"(r) : "v"(lo), "v"(hi)); return r; }
__device__ __forceinline__ bf16x8 load8(const bf16* p) { return *reinterpret_cast<const bf16x8*>(p); }
__device__ __forceinline__ void mask_tile(f32x16& p0, f32x16& p1, int dq) {
    const float NEG = -__builtin_inff();
#pragma unroll
    for (int r = 0; r < 16; ++r) {
        const int c = (r & 3) + 8 * (r >> 2);
        if (dq - c < 0) p0[r] = NEG;
        if (dq - c - 32 < 0) p1[r] = NEG;
    }
}
__device__ __forceinline__ void mask_sel(f32x16& p0, f32x16& p1, unsigned keep) {
    const float NEG = -__builtin_inff();
#pragma unroll
    for (int r = 0; r < 16; ++r) { p0[r] = keep ? p0[r] : NEG; p1[r] = keep ? p1[r] : NEG; }
}
__device__ __forceinline__ void partialSM(f32x16& p0, f32x16& p1, float& m_reg, float& mn, float& alpha) {
    float pmax = p0[0]; for (int r = 1; r < 16; ++r) pmax = fmaxf(pmax, p0[r]); for (int r = 0; r < 16; ++r) pmax = fmaxf(pmax, p1[r]);
    { auto rr = __builtin_amdgcn_permlane32_swap(__float_as_uint(pmax), __float_as_uint(pmax), false, false);
      pmax = fmaxf(__uint_as_float(rr[0]), __uint_as_float(rr[1])); }
    constexpr float C2 = 1.4426950408889634f * SCALE;
    if (__builtin_expect(__all((pmax - m_reg) * SCALE <= THR), 1)) { mn = m_reg; alpha = 1.f; }
    else { mn = fmaxf(m_reg, pmax); alpha = __builtin_amdgcn_exp2f((m_reg - mn) * C2); m_reg = mn; }
    const float mnL = -mn * C2;
    for (int r = 0; r < 16; ++r) p0[r] = fmaf(p0[r], C2, mnL); for (int r = 0; r < 16; ++r) p1[r] = fmaf(p1[r], C2, mnL);
    for (int r = 0; r < 16; ++r) p0[r] = __builtin_amdgcn_exp2f(p0[r]);
}
__device__ __forceinline__ void finishSM(f32x16& p0, f32x16& p1, float alpha, float& l_reg, bf16x8& pa0, bf16x8& pa1, bf16x8& pa2, bf16x8& pa3) {
    for (int r = 0; r < 16; ++r) p1[r] = __builtin_amdgcn_exp2f(p1[r]);
    float ps = 0; for (int r = 0; r < 16; ++r) ps += p0[r]; for (int r = 0; r < 16; ++r) ps += p1[r];
    { auto rr = __builtin_amdgcn_permlane32_swap(__float_as_uint(ps), __float_as_uint(ps), false, false);
      ps = __uint_as_float(rr[0]) + __uint_as_float(rr[1]); }
    l_reg = l_reg * alpha + ps;
#define PK4(P, B_, OUT) do { unsigned a0 = cvtpk(P[B_+0], P[B_+1]), a1 = cvtpk(P[B_+2], P[B_+3]);                          \
        unsigned b0 = cvtpk(P[B_+4], P[B_+5]), b1 = cvtpk(P[B_+6], P[B_+7]);                                             \
        auto r0 = __builtin_amdgcn_permlane32_swap(a0, b0, false, false); auto r1 = __builtin_amdgcn_permlane32_swap(a1, b1, false, false); \
        v4u w = {r0[0], r1[0], r0[1], r1[1]}; OUT = *reinterpret_cast<bf16x8*>(&w); } while (0)
    PK4(p0, 0, pa0); PK4(p0, 8, pa1); PK4(p1, 0, pa2); PK4(p1, 8, pa3);
#undef PK4
}
template <int KB>
__device__ __forceinline__ void qkt(f32x16& p0, f32x16& p1, const char* K_lds, int r32, int hi, const bf16x8* qr) {
    p0 = f32x16{}; p1 = f32x16{};
    const char* kb[4];
#pragma unroll
    for (int dd = 0; dd < 4; ++dd) kb[dd] = K_lds + KB * SHM_K + KSWZ(r32, (dd * 16 + hi * 8) * 2);
#pragma unroll
    for (int d0 = 0; d0 < 8; ++d0) { const char* a = kb[d0 & 3] + (d0 >> 2) * 128;
        bf16x8 b0 = *reinterpret_cast<const bf16x8*>(a);
        bf16x8 b1 = *reinterpret_cast<const bf16x8*>(a + 32 * 256);
        p0 = __builtin_amdgcn_mfma_f32_32x32x16_bf16(b0, qr[d0], p0, 0, 0, 0);
        p1 = __builtin_amdgcn_mfma_f32_32x32x16_bf16(b1, qr[d0], p1, 0, 0, 0); }
}
template <int VB>
__device__ __forceinline__ void pv_tile(f32x16* o, int vb0, bf16x8 pa0, bf16x8 pa1, bf16x8 pa2, bf16x8 pa3) {
#define TRRD(dst, off) asm volatile("ds_read_b64_tr_b16 %0, %1 offset:%2" : "=&v"(dst) : "v"(vb0), "i"(off) : "memory")
#define PV_D0(d0) do { s16x4 l0, l1, l2, l3, h0, h1, h2, h3; constexpr int b_ = VB * SHM_V + v_rd_off(d0, 0, 0); \
        TRRD(l0, b_); TRRD(h0, b_ + 2048); TRRD(l1, b_ + 4096); TRRD(h1, b_ + 6144); TRRD(l2, b_ + 8192); TRRD(h2, b_ + 10240); TRRD(l3, b_ + 12288); TRRD(h3, b_ + 14336); \
        asm volatile("s_waitcnt lgkmcnt(0)" ::: "memory"); SBAR();   \
        o[d0] = __builtin_amdgcn_mfma_f32_32x32x16_bf16(pa0, (bf16x8){l0[0], l0[1], l0[2], l0[3], h0[0], h0[1], h0[2], h0[3]}, o[d0], 0, 0, 0);   \
        o[d0] = __builtin_amdgcn_mfma_f32_32x32x16_bf16(pa1, (bf16x8){l1[0], l1[1], l1[2], l1[3], h1[0], h1[1], h1[2], h1[3]}, o[d0], 0, 0, 0);   \
        o[d0] = __builtin_amdgcn_mfma_f32_32x32x16_bf16(pa2, (bf16x8){l2[0], l2[1], l2[2], l2[3], h2[0], h2[1], h2[2], h2[3]}, o[d0], 0, 0, 0);   \
        o[d0] = __builtin_amdgcn_mfma_f32_32x32x16_bf16(pa3, (bf16x8){l3[0], l3[1], l3[2], l3[3], h3[0], h3[1], h3[2], h3[3]}, o[d0], 0, 0, 0); } while (0)
    PV_D0(0); PV_D0(1); PV_D0(2); PV_D0(3);
#undef PV_D0
#undef TRRD
}

struct BlockRef { const bf16* Q; const bf16* K; const bf16* V; bf16* O; const unsigned* sel; int P0; };
struct Seam { bf16x8 qr[8]; bf16x8 st_v0, st_v1, st_k0, st_k1; };
#define KVP(p, k0, half) ((const char*)(p) + (size_t)((k0) + 32 * (half)) * (ldkv * 2))
__device__ __forceinline__ bf16x8 ld16(const char* base, unsigned off) { return *reinterpret_cast<const bf16x8*>(base + off); }
#define VMW() asm volatile("s_waitcnt vmcnt(0)" ::: "memory")
#define VMWN(n) asm volatile("s_waitcnt vmcnt(%0)" :: "i"(n) : "memory")
#define SLOAD_H(Kp, Vp, k0) do { S.st_v0 = ld16(KVP(Vp, k0, 0), kvoff); S.st_v1 = ld16(KVP(Vp, k0, 1), kvoff);              \
                         S.st_k0 = ld16(KVP(Kp, k0, 0), kvoff); S.st_k1 = ld16(KVP(Kp, k0, 1), kvoff); } while (0)
#define SWRITE_HK(bf) do { *(bf16x8*)(K_lds + (bf) * SHM_K + kws) = S.st_k0; *(bf16x8*)(K_lds + (bf) * SHM_K + kws + 32 * 256) = S.st_k1; } while (0)
#define SWRITE_HV(bf) do { *(bf16x8*)(V_lds + (bf) * SHM_V + vst0) = S.st_v0; *(bf16x8*)(V_lds + (bf) * SHM_V + vst1) = S.st_v1; } while (0)
#define SWRITE_H(bf) do { SWRITE_HV(bf); SWRITE_HK(bf); } while (0)
constexpr int ldq = PW, ldkv = PW, ldo = OPW;
__device__ __forceinline__ void attn_prime(const BlockRef& cur, char* lds, Seam& S, const int tid) {
    const int wid = __builtin_amdgcn_readfirstlane(tid >> 6), lane = tid & 63, r32 = lane & 31, hi = lane >> 5;
    const int sr = tid >> 4, sc = (tid & 15) * 8, kws = KSWZ(sr, sc * 2); char* K_lds = lds + 2 * SHM_V;
    const unsigned kvoff = (unsigned)(sr * ldkv + sc) * 2u, qoff = (unsigned)((wid * QBLK + r32) * ldq + hi * 8) * 2u;
    for (int d0 = 0; d0 < 8; ++d0) S.qr[d0] = ld16((const char*)cur.Q + d0 * 32, qoff);
    SLOAD_H(cur.K, cur.V, 0); VMW(); SWRITE_HK(0);
    __syncthreads();
}
__device__ __forceinline__ void attn_block(const BlockRef& cur, const BlockRef& nxt, char* lds, Seam& S, const int tid) {
    const int wid = __builtin_amdgcn_readfirstlane(tid >> 6), lane = tid & 63, r32 = lane & 31, hi = lane >> 5;
    const int NT = (cur.P0 + QB - 1) / KVBLK + 1;
    const int qlo = cur.P0 + wid * QBLK, qm = qlo + r32 - 4 * hi;
    const bool moba = cur.sel != nullptr;
    unsigned selmask = 0u; if (moba) selmask = *(const unsigned*)((const char*)cur.sel + (unsigned)(wid * QBLK + r32) * 4u);
    char* V_lds = lds; char* K_lds = lds + 2 * SHM_V;
    float* ws = (float*)(lds + 2 * SHM_V + 2 * SHM_K) + wid * 64; float* li_l = ws, * al_l = ws + 32;
    float m_reg = -1e30f, l_reg = 0; f32x16 o[4] = {};
    const int sr = tid >> 4, sc = (tid & 15) * 8, vst0 = v_st(sr, sc), vst1 = v_st(32 + sr, sc), kws = KSWZ(sr, sc * 2);
    const unsigned kvoff = (unsigned)(sr * ldkv + sc) * 2u, qoff = (unsigned)((wid * QBLK + r32) * ldq + hi * 8) * 2u;
    const int vb0 = (int)(uintptr_t)V_lds + v_rd_base(lane);
    const bf16* Kh = cur.K; const bf16* Vh = cur.V;
#define RESC(a) do { if (__any((a) < 1.f)) { if (hi == 0) al_l[r32] = (a); asm volatile("s_waitcnt lgkmcnt(0)" ::: "memory");              \
                     for (int d_ = 0; d_ < 4; ++d_) for (int r = 0; r < 16; ++r) o[d_][r] *= al_l[crow(r, hi)]; } } while (0)
#define KBASE(t) ((t) * KVBLK)
#define MASKT(P0_, P1_, t) do { const int kb_ = KBASE(t); if (kb_ + KVBLK - 1 > qlo) mask_tile(P0_, P1_, qm - kb_); \
        else if (moba && kb_ < cur.P0) mask_sel(P0_, P1_, (selmask >> (kb_ >> 8)) & 1u); } while (0)
    constexpr int NQL = 8;
#define SEAM_K0() do { VMWN(NQL); SWRITE_HK(0); SBAR(); } while (0)
    f32x16 pA0, pA1, pB0, pB1; float mnA, mnB, alA, alB; bf16x8 pa0, pa1, pa2, pa3;
    SWRITE_HV(0); SBAR();
    if (NT > 1) { SLOAD_H(Kh, Vh, KBASE(1)); }
    SBAR(); qkt<0>(pA0, pA1, K_lds, r32, hi, S.qr);
    MASKT(pA0, pA1, 0); partialSM(pA0, pA1, m_reg, mnA, alA);
    if (NT > 1) { VMW(); SWRITE_H(1); }
    __syncthreads();
#define HALF_STEP(PX0, PX1, mnX, alX, PY0, PY1, alY, t, KB, VB, SB) do {                                                      \
        SBAR(); qkt<KB>(PX0, PX1, K_lds, r32, hi, S.qr);                                                         \
        finishSM(PY0, PY1, alY, l_reg, pa0, pa1, pa2, pa3); SBAR();                                                           \
        if ((t) + 1 < NT) { SLOAD_H(Kh, Vh, KBASE((t) + 1)); SBAR(); }                                               \
        pv_tile<VB>(o, vb0, pa0, pa1, pa2, pa3); MASKT(PX0, PX1, (t)); partialSM(PX0, PX1, m_reg, mnX, alX);                                        \
        __syncthreads();                                                                                                      \
        if ((t) + 1 < NT) { VMW(); SWRITE_H(SB); }                                                                          \
        RESC(alX); __syncthreads(); } while (0)
    for (int t = 1; t + 1 < NT; t += 2) {
        HALF_STEP(pB0, pB1, mnB, alB, pA0, pA1, alA, t, 1, 0, 0);
        HALF_STEP(pA0, pA1, mnA, alA, pB0, pB1, alB, t + 1, 0, 1, 1);
    }
    const bool even = (NT & 1) == 0;
    if (even) { SBAR(); qkt<1>(pB0, pB1, K_lds, r32, hi, S.qr); SBAR(); }
    { const bf16* Kn = nxt.K; const bf16* Vn = nxt.V; SLOAD_H(Kn, Vn, 0); SBAR(); }
#pragma unroll
    for (int d0 = 0; d0 < 8; ++d0) S.qr[d0] = ld16((const char*)nxt.Q + d0 * 32, qoff);
    SBAR();
    finishSM(pA0, pA1, alA, l_reg, pa0, pa1, pa2, pa3); SBAR();
    pv_tile<0>(o, vb0, pa0, pa1, pa2, pa3);
    if (even) { MASKT(pB0, pB1, NT - 1); partialSM(pB0, pB1, m_reg, mnB, alB); __syncthreads(); RESC(alB);
        finishSM(pB0, pB1, alB, l_reg, pa0, pa1, pa2, pa3); SBAR(); pv_tile<1>(o, vb0, pa0, pa1, pa2, pa3); }
    SBAR(); SEAM_K0();
    if (hi == 0) li_l[r32] = l_reg; asm volatile("s_waitcnt lgkmcnt(0)" ::: "memory");
    float rli[16];
#pragma unroll
    for (int r = 0; r < 16; ++r) rli[r] = __builtin_amdgcn_rcpf(li_l[crow(r, hi)]);
    unsigned ooff = (unsigned)((wid * QBLK + 4 * hi) * ldo + r32) * 2u;
    asm volatile("" : "+v"(ooff));
    char* Ob = (char*)cur.O;
#pragma unroll
    for (int r = 0; r < 16; ++r) { const unsigned orow_b = (unsigned)(((r & 3) + 8 * (r >> 2)) * ldo) * 2u;
#pragma unroll
        for (int d0 = 0; d0 < 4; ++d0) { const float v = o[d0][r] * rli[r];
            const float vn = __shfl_xor(v, 1);
            if ((r32 & 1) == 0) *(unsigned*)(Ob + (ooff + orow_b + d0 * 64)) = cvtpk(v, vn); } }
    __syncthreads();
#undef RESC
#undef KBASE
#undef MASKT
#undef SEAM_K0
#undef HALF_STEP
}
#undef KVP
#undef VMW
#undef VMWN
#undef SLOAD_H
#undef SWRITE_HK
#undef SWRITE_HV
#undef SWRITE_H
}

#define XB_TMO      128
#define XB_XCNT(j)  (256  + 64 * (j))
#define XB_XSUB(j)  (1280 + 64 * (j))
#define XB_XGEN(j)  (2304 + 64 * (j))
#define XB_TOP      3328
#define XB_TOPGEN   3392
#define XCD_BAR_WORDS 3456
#define XB_SPIN_CAP (1u << 18)
__device__ __forceinline__ unsigned xb_ld(unsigned* p)              { return __hip_atomic_load(p, __ATOMIC_RELAXED, __HIP_MEMORY_SCOPE_AGENT); }
__device__ __forceinline__ unsigned xb_add(unsigned* p, unsigned v) { return __hip_atomic_fetch_add(p, v, __ATOMIC_RELAXED, __HIP_MEMORY_SCOPE_AGENT); }
__device__ __forceinline__ unsigned xb_xcc_id() { return (unsigned)__builtin_amdgcn_s_getreg((3 << 11) | 20) & 0xFu; }
#define XB_SPIN(cond, bar) do { unsigned _sp = 0; while (cond) { __builtin_amdgcn_s_sleep(1); \
    if ((++_sp & 255u) == 0u) { if (xb_ld(&(bar)[XB_TMO])) break; if (_sp > XB_SPIN_CAP) { atomicAdd(&(bar)[XB_TMO], 1u); break; } } } } while (0)
struct XcdBarrier { unsigned* bar; unsigned x; volatile LAS unsigned* st; };
__device__ __forceinline__ XcdBarrier xcd_barrier_post(unsigned* bar, volatile LAS unsigned* st) {
    XcdBarrier b; b.bar = bar; b.x = xb_xcc_id(); b.st = st;
    if (threadIdx.x == 0) (void)xb_add(&bar[XB_XCNT(b.x)], 1u);
    return b;
}
__device__ __forceinline__ void xcd_barrier_complete(unsigned* bar, unsigned x, unsigned& nloc, unsigned& nx) {
    const unsigned G = gridDim.x * gridDim.y * gridDim.z;
    unsigned sum, cnt, mine, sp = 0u;
    for (;;) {
        sum = 0u; cnt = 0u; mine = 0u;
#pragma unroll
        for (unsigned j = 0; j < 16; ++j) { const unsigned c = xb_ld(&bar[XB_XCNT(j)]); sum += c; cnt += (c > 0u) ? 1u : 0u; mine = (j == x) ? c : mine; }
        if (sum == G) break;
        __builtin_amdgcn_s_sleep(1);
        if ((++sp & 255u) == 0u) { if (xb_ld(&bar[XB_TMO])) break; if (sp > XB_SPIN_CAP) { atomicAdd(&bar[XB_TMO], 1u); break; } }
    }
    nloc = mine > 0u ? mine : 1u; nx = cnt > 0u ? cnt : 1u;
}
__device__ __forceinline__ void xcd_barrier(const XcdBarrier& b) {
    asm volatile("s_waitcnt vmcnt(0)" ::: "memory");
    __syncthreads();
    if (threadIdx.x == 0) {
        unsigned* bar = b.bar;
        __builtin_amdgcn_s_waitcnt(0);
        unsigned nloc = b.st[0], nx = b.st[1];
        if (nloc == 0u) { xcd_barrier_complete(bar, b.x, nloc, nx); b.st[0] = nloc; b.st[1] = nx; }
        const unsigned old = xb_add(&bar[XB_XSUB(b.x)], 1u);
        const unsigned gen = old / nloc;
        if (old + 1u == (gen + 1u) * nloc) {
            __builtin_amdgcn_fence(__ATOMIC_RELEASE, "agent");
            asm volatile("s_waitcnt vmcnt(0)" ::: "memory");
            const unsigned og = xb_add(&bar[XB_TOP], 1u);
            const unsigned tg = og / nx;
            if (og + 1u == (tg + 1u) * nx) xb_add(&bar[XB_TOPGEN], 1u);
            else XB_SPIN(xb_ld(&bar[XB_TOPGEN]) == tg, bar);
            __builtin_amdgcn_fence(__ATOMIC_ACQUIRE, "agent");
            xb_add(&bar[XB_XGEN(b.x)], 1u);
            asm volatile("s_waitcnt vmcnt(0)" ::: "memory");
        } else {
            XB_SPIN(xb_ld(&bar[XB_XGEN(b.x)]) == gen, bar);
            __builtin_amdgcn_fence(__ATOMIC_ACQUIRE, "agent");
            asm volatile("s_waitcnt vmcnt(0)" ::: "memory");
        }
    }
    __syncthreads();
}

constexpr int NWAVES = 8;
struct Args { const void* in[N_IN]; float* out; unsigned char* ws; int ph_lo, ph_hi; };
static_assert(sizeof(Args) == (N_IN + 2) * 8 + 8, "Args has no padding");

struct Frame {
    LAS unsigned char* lds; char* ldsg; unsigned char* ws; int tid, lane, wave, vcu, G;
};
__device__ __forceinline__ Frame phase_frame(const Frame& F0) {
    Frame F = F0; int t = threadIdx.x; asm volatile("" : "+v"(t)); size_t z = 0; asm volatile("" : "+s"(z));
    F.tid = t; F.lane = t & 63; F.wave = __builtin_amdgcn_readfirstlane(t >> 6); F.ws = F0.ws + z; return F;
}

__device__ __forceinline__ void p0_transpose_item(const float* W, const float* gk, int K, int N, bf16* WT, int rowmode, LAS float* scr, int item, int lane) {
    const int nblk = N / 32, kb = item / nblk, nb = item - kb * nblk, k0 = 64 * kb, n0 = 32 * nb;
#pragma unroll 8
    for (int i = 0; i < 32; ++i) { const int kk = 2 * i + (lane >> 5); float w = W[(size_t)(k0 + kk) * N + n0 + (lane & 31)]; if (gk) w *= gk[k0 + kk]; scr[kk * 33 + (lane & 31)] = w; }
    LDS_WAIT(); asm volatile("" ::: "memory");
    const int c = lane & 7;
    const int rbase = rowmode == 0 ? n0 : ((n0 >> 7) * 256 + (n0 & 127) + (rowmode == 2 ? 128 : 0));
#pragma unroll
    for (int j = 0; j < 4; ++j) { const int n = (lane >> 3) + 8 * j; const LAS float* s = scr + (8 * c) * 33 + n;
        v4u o; o.x = cvt_pk_bf16(s[0 * 33], s[1 * 33]); o.y = cvt_pk_bf16(s[2 * 33], s[3 * 33]); o.z = cvt_pk_bf16(s[4 * 33], s[5 * 33]); o.w = cvt_pk_bf16(s[6 * 33], s[7 * 33]);
        *(GAS v4u*)(WT + (size_t)(rbase + n) * K + k0 + 8 * c) = o; }
    LDS_WAIT(); asm volatile("" ::: "memory");
}

__device__ __forceinline__ void p0_prologue(const Frame& F0, const Args& a) {
    const Frame F = phase_frame(F0);
    LAS float* scr = (LAS float*)(F.lds + F.wave * 16384);
    const int gw = F.vcu * NWAVES + F.wave, NGW = F.G * NWAVES;
    constexpr int I_IN = (DM / 64) * (PW / 32), I_OUT = (DM / 64) * (DM / 32), I_G = (DM / 64) * (DFF / 32), I_D = (DFF / 64) * (DM / 32);
    constexpr int I_LAYER = I_IN + I_OUT + 2 * I_G + I_D;
    for (int it = gw; it < 2 * I_LAYER; it += NGW) {
        const int l = it >= I_LAYER ? 1 : 0; int r = it - l * I_LAYER;
        if (r < I_IN) { p0_transpose_item((const float*)a.in[IN_WIN] + (size_t)l * DM * PW, (const float*)a.in[IN_GATTN] + l * DM, DM, PW, (bf16*)(F.ws + WS_WIN + l * SZ_WIN), 0, scr, r, F.lane); continue; } r -= I_IN;
        if (r < I_OUT) { p0_transpose_item((const float*)a.in[IN_WOUT] + (size_t)l * DM * DM, nullptr, DM, DM, (bf16*)(F.ws + WS_WOUT + l * SZ_WOUT), 0, scr, r, F.lane); continue; } r -= I_OUT;
        if (r < I_G) { p0_transpose_item((const float*)a.in[IN_WGATE] + (size_t)l * DM * DFF, (const float*)a.in[IN_GFFN] + l * DM, DM, DFF, (bf16*)(F.ws + WS_WGU + l * SZ_WGU), 1, scr, r, F.lane); continue; } r -= I_G;
        if (r < I_G) { p0_transpose_item((const float*)a.in[IN_WUP] + (size_t)l * DM * DFF, (const float*)a.in[IN_GFFN] + l * DM, DM, DFF, (bf16*)(F.ws + WS_WGU + l * SZ_WGU), 2, scr, r, F.lane); continue; } r -= I_G;
        p0_transpose_item((const float*)a.in[IN_WDOWN] + (size_t)l * DFF * DM, nullptr, DFF, DM, (bf16*)(F.ws + WS_WDN + l * SZ_WDN), 0, scr, r, F.lane);
    }
    { const float* x = (const float*)a.in[IN_X]; bf16* xb = (bf16*)(F.ws + WS_XB); float* ssb = (float*)(F.ws + WS_SSB);
      for (int m = gw; m < SEQ; m += NGW) {
          const GAS f32x4* xr = (const GAS f32x4*)(x + (size_t)m * DM) + F.lane; GAS v2u* o8 = (GAS v2u*)(xb + (size_t)m * DM) + F.lane; float s = 0.f;
#pragma unroll 4
          for (int j = 0; j < 16; ++j) { const f32x4 v = xr[64 * j]; s += (v[0] * v[0] + v[1] * v[1]) + (v[2] * v[2] + v[3] * v[3]); v2u w; w.x = cvt_pk_bf16(v[0], v[1]); w.y = cvt_pk_bf16(v[2], v[3]); o8[64 * j] = w; }
          s = wave_sum(s);
          if (F.lane < 16) ssb[(size_t)m * 16 + F.lane] = F.lane == 0 ? s : 0.f; } }
    { const int* pos = (const int*)a.in[IN_POS]; float* cs = (float*)(F.ws + WS_CS);
      const float INV[16] = {1.000000000e+00f, 4.403665960e-01f, 1.939227432e-01f, 8.539710194e-02f, 3.760603070e-02f, 1.656043902e-02f, 7.292664610e-03f, 3.211445874e-03f,
                             1.414213562e-03f, 6.227723788e-04f, 2.742481884e-04f, 1.207697351e-04f, 5.318296098e-05f, 2.341999971e-05f, 1.031338616e-05f, 4.541670478e-06f};
      for (int idx = F.vcu * 512 + F.tid; idx < SEQ * 16; idx += F.G * 512) {
          const int row = idx >> 4, i = idx & 15; float inv = INV[0];
#pragma unroll
          for (int k = 1; k < 16; ++k) inv = (i == k) ? INV[k] : inv;
          const float angf = (float)pos[row] * inv; const double ang = (double)angf;
          const double qd = __builtin_rint(ang * 0.63661977236758134308); const int qi = (int)qd;
          double r = __builtin_fma(-qd, 1.57079632679489655800e+00, ang); r = __builtin_fma(-qd, 6.12323399573676603587e-17, r);
          const double r2 = r * r;
          double sp = -2.5052108385441718775e-08; sp = sp * r2 + 2.7557319223985890653e-06; sp = sp * r2 - 1.9841269841269841253e-04; sp = sp * r2 + 8.3333333333333332177e-03; sp = sp * r2 - 1.6666666666666665741e-01;
          const double sn = r + r * r2 * sp;
          double cp = 2.0876756987868098979e-09; cp = cp * r2 - 2.7557319223985888276e-07; cp = cp * r2 + 2.4801587301587301566e-05; cp = cp * r2 - 1.3888888888888889419e-03; cp = cp * r2 + 4.1666666666666664354e-02; cp = cp * r2 - 0.5;
          const double cn = 1.0 + r2 * cp;
          const int q4 = qi & 3;
          const double c = (q4 == 0) ? cn : (q4 == 1) ? -sn : (q4 == 2) ? -cn : sn;
          const double s = (q4 == 0) ? sn : (q4 == 1) ? cn : (q4 == 2) ? -sn : -cn;
          cs[(size_t)row * 32 + i] = (float)c; cs[(size_t)row * 32 + 16 + i] = (float)s; } }
    { const float* mem = (const float*)a.in[IN_MEM]; const float* gm = (const float*)a.in[IN_GMEM]; const float* W = (const float*)a.in[IN_WMEMKV]; float* mkv = (float*)(F.ws + WS_MKV);
      LAS float* am = (LAS float*)(F.lds);
      LAS float* rsd = (LAS float*)(F.lds + 8192);
      for (int it = F.vcu; it < (MEML / 16) * (2 * MEM_W / 128); it += F.G) {
          const int mb = it / (2 * MEM_W / 128), nb = it - mb * (2 * MEM_W / 128), m0 = mb * 16, n0 = nb * 128;
          __syncthreads();
          for (int rr = F.wave; rr < 16; rr += NWAVES) { const GAS f32x4* xr = (const GAS f32x4*)(mem + (size_t)(m0 + rr) * DM) + F.lane; float s = 0.f;
              for (int j = 0; j < 16; ++j) { const f32x4 v = xr[64 * j]; s += (v[0] * v[0] + v[1] * v[1]) + (v[2] * v[2] + v[3] * v[3]); }
              s = wave_sum(s); if (F.lane == 0) rsd[rr] = __builtin_amdgcn_rsqf(s * (1.0f / DM) + NORM_EPS); }
          const int n = F.tid & 127, mg = F.tid >> 7;
          f32x4 acc = {0.f, 0.f, 0.f, 0.f};
          for (int k0 = 0; k0 < DM; k0 += 64) {
              __syncthreads();
              { const int kk = F.tid & 63, r0 = F.tid >> 6;
                const float gg = gm[k0 + kk];
                am[kk * 16 + r0] = mem[(size_t)(m0 + r0) * DM + k0 + kk] * gg; am[kk * 16 + r0 + 8] = mem[(size_t)(m0 + r0 + 8) * DM + k0 + kk] * gg; }
              __syncthreads();
#pragma unroll 8
              for (int kk = 0; kk < 64; ++kk) { const float w = W[(size_t)(k0 + kk) * (2 * MEM_W) + n0 + n]; const f32x4 av = *(const LAS f32x4*)(am + kk * 16 + mg * 4); acc += av * w; }
          }
#pragma unroll
          for (int i = 0; i < 4; ++i) mkv[(size_t)(m0 + mg * 4 + i) * (2 * MEM_W) + n0 + n] = acc[i] * rsd[mg * 4 + i];
      }
      __syncthreads(); }
}

__device__ __forceinline__ void norm_phase(const Frame& F0, const Args& a, int layer) {
    const Frame F = phase_frame(F0);
    bf16* proj = (bf16*)(F.ws + WS_PROJ); const float* cs = (const float*)(F.ws + WS_CS); float* ksum = (float*)(F.ws + WS_KSUM);
    const bool moba = (layer == 0);
    LAS float* red = (LAS float*)F.lds;
    const int l15 = F.lane & 15;
    for (int it = F.vcu; it < 128 * 14; it += F.G) {
        const int cg = it % 14, rb = it / 14;
        const bool is_q = cg < 6, is_k = cg >= 6 && cg < 12, is_m = cg >= 12;
        const int colbase = is_q ? 512 * cg : is_k ? SELF_W + 512 * (cg - 6) : 3 * SELF_W + 512 * (cg - 12);
        float g8[8];
        { const float* gp = is_q ? (const float*)a.in[IN_GQ] + layer * HD : (const float*)a.in[IN_GK] + layer * HD;
#pragma unroll
          for (int j = 0; j < 8; ++j) g8[j] = is_m ? 1.0f : gp[l15 * 8 + j]; }
        float ks8[8];
#pragma unroll
        for (int j = 0; j < 8; ++j) ks8[j] = 0.f;
        for (int i = 0; i < 8; ++i) {
            const int row = rb * 64 + F.wave * 8 + i;
            GAS v4u* p = (GAS v4u*)(proj + (size_t)row * PW + colbase + F.lane * 8);
            const v4u w = *p; float y[8];
            y[0] = bf_lo(w.x); y[1] = bf_hi(w.x); y[2] = bf_lo(w.y); y[3] = bf_hi(w.y); y[4] = bf_lo(w.z); y[5] = bf_hi(w.z); y[6] = bf_lo(w.w); y[7] = bf_hi(w.w);
            float s = 0.f;
#pragma unroll
            for (int j = 0; j < 8; ++j) s += y[j] * y[j];
            s += __shfl_xor(s, 1); s += __shfl_xor(s, 2); s += __shfl_xor(s, 4); s += __shfl_xor(s, 8);
            float rs;
            if (is_m) { s += __shfl_xor(s, 16); rs = __builtin_amdgcn_rsqf(s * (1.0f / 256.0f) + NORM_EPS); }
            else rs = __builtin_amdgcn_rsqf(s * (1.0f / 128.0f) + NORM_EPS);
#pragma unroll
            for (int j = 0; j < 8; ++j) y[j] = y[j] * rs * g8[j];
            if (!is_m) {
                const int ci = (l15 & 1) * 8;
                const f32x4 c0 = *(const f32x4*)(cs + (size_t)row * 32 + ci), c1 = *(const f32x4*)(cs + (size_t)row * 32 + ci + 4);
                const f32x4 s0 = *(const f32x4*)(cs + (size_t)row * 32 + 16 + ci), s1 = *(const f32x4*)(cs + (size_t)row * 32 + 16 + ci + 4);
                const float cc[8] = {c0[0], c0[1], c0[2], c0[3], c1[0], c1[1], c1[2], c1[3]}, sn[8] = {s0[0], s0[1], s0[2], s0[3], s1[0], s1[1], s1[2], s1[3]};
#pragma unroll
                for (int j = 0; j < 8; ++j) { const float other = __shfl_xor(y[j], 2);
                    const float r1 = y[j] * cc[j] - other * sn[j], r2 = y[j] * cc[j] + other * sn[j];
                    y[j] = (l15 < 2) ? r1 : (l15 < 4) ? r2 : y[j]; }
            }
            v4u o; o.x = cvt_pk_bf16(y[0], y[1]); o.y = cvt_pk_bf16(y[2], y[3]); o.z = cvt_pk_bf16(y[4], y[5]); o.w = cvt_pk_bf16(y[6], y[7]);
            *p = o;
#pragma unroll
            for (int j = 0; j < 8; ++j) ks8[j] += y[j];
        }
        if (moba && is_k) {
            __syncthreads();
#pragma unroll
            for (int j = 0; j < 8; ++j) red[F.wave * 512 + F.lane * 8 + j] = ks8[j];
            __syncthreads();
            float t = 0.f;
#pragma unroll
            for (int w = 0; w < 8; ++w) t += red[w * 512 + F.tid];
            const int head = 4 * (cg - 6) + (F.tid >> 7), dim = F.tid & 127, blk = rb >> 2, sub = rb & 3;
            ksum[((size_t)(head * NBLK + blk) * 4 + sub) * HD + dim] = t;
        }
    }
    { const float* mkv = (const float*)(F.ws + WS_MKV); bf16* kmn = (bf16*)(F.ws + WS_KMN); bf16* vt = (bf16*)(F.ws + WS_VT);
      const float* gk = (const float*)a.in[IN_GMK] + layer * 256; const float* gq = (const float*)a.in[IN_GMQ] + layer * 256;
      const int gw = F.vcu * NWAVES + F.wave, NGW = F.G * NWAVES;
      for (int t = gw; t < 4 * MEML; t += NGW) { const int h = t >> 8, key = t & 255;
          const f32x4 v = *(const f32x4*)(mkv + (size_t)key * 2048 + h * 256 + F.lane * 4);
          float s = (v[0] * v[0] + v[1] * v[1]) + (v[2] * v[2] + v[3] * v[3]); s = wave_sum(s);
          const float rs = __builtin_amdgcn_rsqf(s * (1.0f / 256.0f) + NORM_EPS);
          const f32x4 g1 = *(const f32x4*)(gk + F.lane * 4), g2 = *(const f32x4*)(gq + F.lane * 4);
          v2u o; o.x = cvt_pk_bf16(v[0] * rs * g1[0] * g2[0], v[1] * rs * g1[1] * g2[1]); o.y = cvt_pk_bf16(v[2] * rs * g1[2] * g2[2], v[3] * rs * g1[3] * g2[3]);
          *(v2u*)(kmn + (size_t)t * 256 + F.lane * 4) = o; }
      for (int idx = F.vcu * 512 + F.tid; idx < 4 * 256 * 256; idx += F.G * 512) { const int hd = idx >> 8, key = idx & 255;
          const float v = mkv[(size_t)key * 2048 + 1024 + hd]; vt[idx] = (bf16)(cvt_pk_bf16(v, 0.f) & 0xffffu); } }
}

__device__ __forceinline__ void gate_phase(const Frame& F0) {
    const Frame F = phase_frame(F0);
    const bf16* proj = (const bf16*)(F.ws + WS_PROJ); const float* ksum = (const float*)(F.ws + WS_KSUM); unsigned* sel = (unsigned*)(F.ws + WS_SEL);
    LAS float* km = (LAS float*)F.lds;
    for (int it = F.vcu; it < NHEAD * NBLK; it += F.G) {
        const int h = it / NBLK, b0 = it % NBLK;
        __syncthreads();
        for (int e = F.tid; e < b0 * HD; e += 512) { const int blk = e >> 7, dim = e & 127; const float* kp = ksum + ((size_t)(h * NBLK + blk) * 4) * HD + dim;
            km[e] = ((kp[0] + kp[HD]) + (kp[2 * HD] + kp[3 * HD])) * (1.0f / 256.0f); }
        __syncthreads();
        if (F.tid < 256) {
            const int row = b0 * 256 + F.tid;
            const v4u* qp = (const v4u*)(proj + (size_t)row * PW + h * HD);
            v4u q[16];
#pragma unroll
            for (int j = 0; j < 16; ++j) q[j] = qp[j];
            float v1 = -__builtin_inff(), v2 = v1, v3 = v1; int i1 = 32, i2 = 32, i3 = 32;
            for (int blk = 0; blk < b0; ++blk) {
                const LAS f32x4* kr = (const LAS f32x4*)(km + blk * HD); float g0 = 0.f, g1 = 0.f;
#pragma unroll
                for (int j = 0; j < 16; ++j) { const f32x4 ka = kr[2 * j], kb = kr[2 * j + 1];
                    g0 += bf_lo(q[j].x) * ka[0] + bf_hi(q[j].x) * ka[1] + bf_lo(q[j].y) * ka[2] + bf_hi(q[j].y) * ka[3];
                    g1 += bf_lo(q[j].z) * kb[0] + bf_hi(q[j].z) * kb[1] + bf_lo(q[j].w) * kb[2] + bf_hi(q[j].w) * kb[3]; }
                const float gt = g0 + g1;
                if (gt > v1) { v3 = v2; i3 = i2; v2 = v1; i2 = i1; v1 = gt; i1 = blk; }
                else if (gt > v2) { v3 = v2; i3 = i2; v2 = gt; i2 = blk; }
                else if (gt > v3) { v3 = gt; i3 = blk; }
            }
            unsigned m = 0u; if (i1 < 32) m |= 1u << i1; if (i2 < 32) m |= 1u << i2; if (i3 < 32) m |= 1u << i3;
            sel[(size_t)h * SEQ + row] = m;
        }
    }
    __syncthreads();
}

__device__ __forceinline__ att::BlockRef attn_ref(const Frame& F, int layer, int i) {
    const bf16* proj = (const bf16*)(F.ws + WS_PROJ); att::BlockRef r;
    if (layer == 0) {
        const int g = F.vcu >> 5, k = F.vcu & 31;
        const int head = 3 * g + i, qb = (i == 0) ? k : (i == 1) ? ((k + 16) & 31) : (k < 16 ? 31 - 2 * k : 62 - 2 * k);
        r.Q = proj + (size_t)(qb * 256) * PW + head * HD; r.K = proj + SELF_W + head * HD; r.V = proj + 2 * SELF_W + head * HD;
        r.O = (bf16*)(F.ws + WS_ATT) + (size_t)(qb * 256) * OPW + head * HD; r.sel = (const unsigned*)(F.ws + WS_SEL) + (size_t)head * SEQ + qb * 256; r.P0 = qb * 256;
    } else {
        const int item = F.vcu * 3 + (i >> 1), sp = item >> 4, pr = item & 15, qb = (i & 1) ? 31 - pr : pr;
        const int h = sp >> 2, c = (sp >> 1) & 1, e = sp & 1;
        r.Q = proj + (size_t)(qb * 256) * PW + (h * 2 + c) * HD; r.K = proj + SELF_W + (h * 2 + c) * HD; r.V = proj + 2 * SELF_W + h * 256 + e * HD;
        r.O = (bf16*)(F.ws + WS_OP) + (size_t)(qb * 256) * OPW + sp * HD; r.sel = nullptr; r.P0 = qb * 256;
    }
    return r;
}
__device__ __forceinline__ void attn_phase(const Frame& F0, int layer) {
    if (F0.G != 256) return;
    const Frame F = phase_frame(F0);
    char* lds = F.ldsg;
    const int nb = layer == 0 ? 3 : 6;
    att::Seam S;
    att::BlockRef cur = attn_ref(F, layer, 0);
    const int tid_ = F.tid;
    att::attn_prime(cur, lds, S, tid_);
    for (int i = 0; i < nb; ++i) {
        const att::BlockRef nxt = (i + 1 < nb) ? attn_ref(F, layer, i + 1) : cur;
        att::attn_block(cur, nxt, lds, S, tid_);
        cur = nxt;
    }
    VM_WAIT(); __builtin_amdgcn_s_waitcnt(0); __syncthreads();
}

__device__ __forceinline__ void diff_combine_phase(const Frame& F0, const Args& a) {
    const Frame F = phase_frame(F0);
    const bf16* op = (const bf16*)(F.ws + WS_OP); bf16* att_o = (bf16*)(F.ws + WS_ATT);
    float d1 = 0.f, d2 = 0.f;
    { const float* q1 = (const float*)a.in[IN_LQ1]; const float* k1 = (const float*)a.in[IN_LK1]; const float* q2 = (const float*)a.in[IN_LQ2]; const float* k2 = (const float*)a.in[IN_LK2];
      d1 = q1[F.lane] * k1[F.lane] + q1[F.lane + 64] * k1[F.lane + 64]; d2 = q2[F.lane] * k2[F.lane] + q2[F.lane + 64] * k2[F.lane + 64];
      d1 = wave_sum(d1); d2 = wave_sum(d2); }
    const float lam = __expf(d1) - __expf(d2) + LAM_INIT;
    const f32x4 gs = *(const f32x4*)((const float*)a.in[IN_GSUB] + F.lane * 4);
    const int gw = F.vcu * NWAVES + F.wave, NGW = F.G * NWAVES;
    for (int row = gw; row < SEQ; row += NGW) {
        for (int h = 0; h < 12; ++h) {
            const int e = F.lane >> 5, d = (F.lane & 31) * 4;
            const v2u w0 = *(const v2u*)(op + (size_t)row * OPW + ((h * 2 + 0) * 2 + e) * HD + d), w1 = *(const v2u*)(op + (size_t)row * OPW + ((h * 2 + 1) * 2 + e) * HD + d);
            float o[4] = {bf_lo(w0.x) - lam * bf_lo(w1.x), bf_hi(w0.x) - lam * bf_hi(w1.x), bf_lo(w0.y) - lam * bf_lo(w1.y), bf_hi(w0.y) - lam * bf_hi(w1.y)};
            float s = (o[0] * o[0] + o[1] * o[1]) + (o[2] * o[2] + o[3] * o[3]); s = wave_sum(s);
            const float rs = __builtin_amdgcn_rsqf(s * (1.0f / 256.0f) + SUBLN_EPS) * (1.0f - LAM_INIT);
            v2u r; r.x = cvt_pk_bf16(o[0] * rs * gs[0], o[1] * rs * gs[1]); r.y = cvt_pk_bf16(o[2] * rs * gs[2], o[3] * rs * gs[3]);
            *(v2u*)(att_o + (size_t)row * OPW + h * 256 + F.lane * 4) = r;
        }
    }
}

constexpr int N_PHASES = 1 + 2 * 8;
__global__ void __launch_bounds__(NWAVES * 64, 2) hybrid_fwd(Args args) {
    extern __shared__ __attribute__((aligned(16))) unsigned char lds[];
    Frame F;
    F.lds = (LAS unsigned char*)lds; F.ldsg = (char*)lds; F.ws = args.ws;
    F.tid = threadIdx.x; F.lane = F.tid & 63; F.wave = __builtin_amdgcn_readfirstlane(F.tid >> 6);
    F.G = gridDim.x; { const int bx = blockIdx.x; F.vcu = (F.G % 8 == 0) ? (bx % 8) * (F.G / 8) + bx / 8 : bx; }
    volatile LAS unsigned* MISC = (volatile LAS unsigned*)(F.lds + MISC_OFF);
    for (int u = F.tid; u < 64; u += NWAVES * 64) MISC[u] = 0u;
    __syncthreads();
    const int lo = args.ph_lo, hi = args.ph_hi;
    const bool one = (hi - lo) > 1;
    gu32* ctl = (gu32*)(args.ws + WS_CTL);
    XcdBarrier bar; bar.bar = (unsigned*)(ctl + CW_BAR); bar.x = 0; bar.st = nullptr;
    if (one) bar = xcd_barrier_post((unsigned*)(ctl + CW_BAR), MISC + 8);
#ifndef PH_MASK
#define PH_MASK 0xffff
#endif
#define IN(k) (lo <= (k) && (k) < hi)
#define EN(b) ((PH_MASK >> (b)) & 1)
#define SEAM(k) do { if (IN(k) && IN((k) + 1)) { XcdBarrier b2_ = bar; size_t bz_ = 0; asm volatile("" : "+s"(bz_)); b2_.bar = bar.bar + bz_; xcd_barrier(b2_); } } while (0)
    float* xout = args.out;
    PG8_LAS float* exch = (PG8_LAS float*)(F.lds + EXCH_OFF);
#define WSP(T, off) ((T*)(wsl + (off)))
#define WS_LOCAL() size_t wz_ = 0; asm volatile("" : "+s"(wz_)); unsigned char* wsl = args.ws + wz_

    if (EN(0) && IN(0)) { p0_prologue(F, args); }
    SEAM(0);
#pragma unroll 1
    for (int l = 0; l < 2; ++l) {
        const int pb = 1 + 8 * l;
        if (EN(1) && IN(pb + 0)) {
            WS_LOCAL();
            pg8::Gemm g{WSP(bf16, WS_XB), WSP(const bf16, WS_WIN + l * SZ_WIN), SEQ, PW, DM, DM, DM, 0}; pg8::StaticOrder S; S.init(SEQ, PW, F.G, (int)blockIdx.x);
            pg8::EpiProj E{WSP(bf16, WS_PROJ), PW, WSP(float, WS_SSB), 1.0f / DM, NORM_EPS};
            pg8::gemm_phase<pg8::EpiProj, pg8::StaticOrder>(F.lds, g, S, E);
        }
        SEAM(pb + 0);
        if (EN(2) && IN(pb + 1)) { norm_phase(F, args, l); }
        SEAM(pb + 1);
        if (EN(3) && IN(pb + 2)) { if (l == 0) gate_phase(F); }
        SEAM(pb + 2);
        if (IN(pb + 3)) {
            if (EN(4)) { WS_LOCAL();
              pg8::Gemm g{WSP(bf16, WS_PROJ) + 3 * SELF_W, WSP(const bf16, WS_KMN), SEQ, MEM_W, 256, PW, 256, 256}; pg8::StaticOrder S; S.init(SEQ, MEM_W, F.G, (int)blockIdx.x);
              pg8::EpiMemS E{WSP(bf16, WS_PM), WSP(float, WS_PS)};
              pg8::gemm_phase<pg8::EpiMemS, pg8::StaticOrder>(F.lds, g, S, E); }
            __syncthreads();
            if (EN(5)) attn_phase(F, l);
        }
        SEAM(pb + 3);
        if (IN(pb + 4)) {
            if (EN(6)) { WS_LOCAL();
              pg8::Gemm g{WSP(bf16, WS_PM), WSP(const bf16, WS_VT), SEQ, MEM_W, 256, MEM_W, 256, 256}; pg8::StaticOrder S; S.init(SEQ, MEM_W, F.G, (int)blockIdx.x);
              pg8::EpiMemO E{WSP(bf16, WS_ATT), WSP(float, WS_PS)};
              pg8::gemm_phase<pg8::EpiMemO, pg8::StaticOrder>(F.lds, g, S, E); }
            if (EN(7) && l == 1) diff_combine_phase(F, args);
        }
        SEAM(pb + 4);
        if (EN(8) && IN(pb + 5)) {
            WS_LOCAL();
            pg8::Gemm g{WSP(bf16, WS_ATT), WSP(const bf16, WS_WOUT + l * SZ_WOUT), SEQ, DM, DM, OPW, DM, 0}; pg8::StaticOrder S; S.init(SEQ, DM, F.G, (int)blockIdx.x);
            pg8::EpiRes<true> E{l == 0 ? (const float*)args.in[IN_X] : xout, xout, WSP(bf16, WS_XB), WSP(float, WS_SSA), DM, exch};
            pg8::gemm_phase<pg8::EpiRes<true>, pg8::StaticOrder>(F.lds, g, S, E);
        }
        SEAM(pb + 5);
        if (EN(9) && IN(pb + 6)) {
            WS_LOCAL();
            pg8::Gemm g{WSP(bf16, WS_XB), WSP(const bf16, WS_WGU + l * SZ_WGU), SEQ, NGU, DM, DM, DM, 0}; pg8::StaticOrder S; S.init(SEQ, NGU, F.G, (int)blockIdx.x);
            pg8::EpiGU E{WSP(bf16, WS_HID), DFF, WSP(float, WS_SSA), 1.0f / DM, NORM_EPS};
            pg8::gemm_phase<pg8::EpiGU, pg8::StaticOrder>(F.lds, g, S, E);
        }
        SEAM(pb + 6);
        if (EN(10) && IN(pb + 7)) {
            WS_LOCAL();
            pg8::Gemm g{WSP(bf16, WS_HID), WSP(const bf16, WS_WDN + l * SZ_WDN), SEQ, DM, DFF, DFF, DFF, 0}; pg8::StaticOrder S; S.init(SEQ, DM, F.G, (int)blockIdx.x);
            pg8::EpiRes<true> E{xout, xout, WSP(bf16, WS_XB), WSP(float, WS_SSB), DM, exch};
            pg8::gemm_phase<pg8::EpiRes<true>, pg8::StaticOrder>(F.lds, g, S, E);
        }
        SEAM(pb + 7);
    }
#undef IN
#undef SEAM
}

extern "C" void kernel_launch(void* const* d_in, const int* in_sizes, int n_in, void* d_out, int out_size, void* d_ws, size_t ws_size, hipStream_t stream) {
    static int grid = 0;
    if (grid == 0) {
        if (n_in != N_IN || in_sizes[0] != SEQ * DM || out_size != SEQ * DM || ws_size < WS_END) {
            fprintf(stderr, "kernel_launch: unexpected shapes (n_in %d, in0 %d, out %d, ws %zu < %zu); nothing launched\n", n_in, n_in > 0 ? in_sizes[0] : -1, out_size, ws_size, (size_t)WS_END); grid = -1; return; }
        int dev = 0, cus = 0, per_cu = 0;
        if (hipGetDevice(&dev) != hipSuccess || hipDeviceGetAttribute(&cus, hipDeviceAttributeMultiprocessorCount, dev) != hipSuccess) { grid = -1; return; }
        if (hipFuncSetAttribute((const void*)hybrid_fwd, hipFuncAttributeMaxDynamicSharedMemorySize, LDS_BYTES) != hipSuccess) { fprintf(stderr, "kernel_launch: hipFuncSetAttribute failed\n"); grid = -1; return; }
        if (hipOccupancyMaxActiveBlocksPerMultiprocessor(&per_cu, (const void*)hybrid_fwd, NWAVES * 64, LDS_BYTES) != hipSuccess || per_cu < 1)
            fprintf(stderr, "kernel_launch: note: occupancy query reports %d workgroups per CU\n", per_cu);
        (void)hipGetLastError();
        grid = cus;
        if (grid != 256) fprintf(stderr, "kernel_launch: %d CUs; the attention phase is dealt for 256\n", grid);
    }
    if (grid < 0) return;
    if (hipMemsetAsync((char*)d_ws + WS_CTL, 0, CTL_ZERO_BYTES, stream) != hipSuccess) return;
    Args a{};
    for (int i = 0; i < N_IN; ++i) a.in[i] = d_in[i];
    a.out = (float*)d_out; a.ws = (unsigned char*)d_ws;
#if MK_ONE_LAUNCH
    a.ph_lo = 0; a.ph_hi = N_PHASES;
    hipLaunchKernelGGL(hybrid_fwd, dim3(grid), dim3(NWAVES * 64), LDS_BYTES, stream, a);
#else
    for (int p = 0; p < N_PHASES; ++p) {
        if (p == 1 + 8 + 2) continue;
        a.ph_lo = p; a.ph_hi = p + 1;
        hipLaunchKernelGGL(hybrid_fwd, dim3(grid), dim3(NWAVES * 64), LDS_BYTES, stream, a);
    }
#endif
}
```

```cpp
#include <hip/hip_runtime.h>
#include <cstdio>
#include <cstdint>

#ifndef MK_ONE_LAUNCH
#define MK_ONE_LAUNCH 1
#endif

constexpr int SEQ = 8192, DM = 4096, PW = 10240, SELF_W = 3072, MEM_W = 1024, DFF = 11008, NGU = 2 * DFF, MEML = 256, HD = 128;
constexpr int NHEAD = 24;
constexpr int NBLK = SEQ / 256;
constexpr int OPW = 48 * HD;
constexpr float NORM_EPS = 1e-6f, SUBLN_EPS = 1e-5f;
constexpr float LAM_INIT = 0.35550906759096934f;

enum { IN_X = 0, IN_MEM, IN_POS, IN_GATTN, IN_WIN, IN_WOUT, IN_GQ, IN_GK, IN_GMQ, IN_GMK, IN_GMEM, IN_WMEMKV, IN_LQ1, IN_LK1, IN_LQ2, IN_LK2, IN_GSUB, IN_GFFN, IN_WGATE, IN_WUP, IN_WDOWN, N_IN };

constexpr size_t MiB = 1u << 20;
constexpr size_t SZ_WIN = (size_t)PW * DM * 2, SZ_WOUT = (size_t)DM * DM * 2, SZ_WGU = (size_t)NGU * DM * 2, SZ_WDN = (size_t)DM * DFF * 2;
constexpr size_t WS_CTL = 0, CTL_ZERO_BYTES = 64 * 1024;
constexpr size_t WS_WIN = 1 * MiB;
constexpr size_t WS_WOUT = WS_WIN + 2 * SZ_WIN;
constexpr size_t WS_WGU = WS_WOUT + 2 * SZ_WOUT;
constexpr size_t WS_WDN = WS_WGU + 2 * SZ_WGU;
constexpr size_t WS_XB = WS_WDN + 2 * SZ_WDN;
constexpr size_t WS_PROJ = WS_XB + (size_t)SEQ * DM * 2;
constexpr size_t WS_ATT = WS_PROJ + (size_t)SEQ * PW * 2;
constexpr size_t WS_HID = WS_ATT + (size_t)SEQ * OPW * 2;
constexpr size_t WS_OP = WS_HID + (size_t)SEQ * DFF * 2;
constexpr size_t WS_PM = WS_OP + (size_t)SEQ * OPW * 2;
constexpr size_t WS_SSA = WS_PM + (size_t)SEQ * MEM_W * 2;
constexpr size_t WS_SSB = WS_SSA + 1 * MiB;
constexpr size_t WS_CS = WS_SSB + 1 * MiB;
constexpr size_t WS_MKV = WS_CS + 1 * MiB;
constexpr size_t WS_KMN = WS_MKV + 2 * MiB;
constexpr size_t WS_VT = WS_KMN + 1 * MiB;
constexpr size_t WS_KSUM = WS_VT + 1 * MiB;
constexpr size_t WS_SEL = WS_KSUM + 2 * MiB;
constexpr size_t WS_PS = WS_SEL + 1 * MiB;
constexpr size_t WS_WMK = WS_PS + 1 * MiB;
constexpr size_t WS_MEMB = WS_WMK + (size_t)2 * MEM_W * DM * 2;
constexpr size_t WS_RSM = WS_MEMB + (size_t)MEML * DM * 2;
constexpr size_t WS_END = WS_RSM + 1 * MiB;
constexpr int CW_TMO = 0, CW_BAR = 4096;

constexpr int RING_BYTES = 131072;
constexpr int EXCH_OFF = RING_BYTES;
constexpr int MISC_OFF = EXCH_OFF + 4096;
constexpr int LDS_BYTES = 147456;
static_assert(MISC_OFF + 256 <= LDS_BYTES, "LDS map");

#define GAS __attribute__((address_space(1)))
#define LAS __attribute__((address_space(3)))
typedef unsigned short bf16;
typedef unsigned v4u __attribute__((ext_vector_type(4)));
typedef unsigned v2u __attribute__((ext_vector_type(2)));
typedef float f32x4 __attribute__((ext_vector_type(4)));
typedef float f32x2 __attribute__((ext_vector_type(2)));
typedef float f32x16 __attribute__((ext_vector_type(16)));
typedef short bf16x8 __attribute__((ext_vector_type(8)));
typedef short s16x4 __attribute__((ext_vector_type(4)));
typedef GAS unsigned gu32;
#define RLX_AGENT __ATOMIC_RELAXED, __HIP_MEMORY_SCOPE_AGENT
#define LDS_WAIT() asm volatile("s_waitcnt lgkmcnt(0)" ::: "memory")
#define VM_WAIT() asm volatile("s_waitcnt vmcnt(0)" ::: "memory")

__device__ __forceinline__ unsigned cvt_pk_bf16(float lo, float hi) { unsigned r; asm volatile("v_cvt_pk_bf16_f32 %0, %1, %2" : "=v"(r) : "v"(lo), "v"(hi)); return r; }
__device__ __forceinline__ float bf_lo(unsigned w) { return __uint_as_float(w << 16); }
__device__ __forceinline__ float bf_hi(unsigned w) { return __uint_as_float(w & 0xffff0000u); }
__device__ __forceinline__ float wave_sum(float v) {
#pragma unroll
    for (int o = 1; o < 64; o <<= 1) v += __shfl_xor(v, o);
    return v;
}

namespace pg8 {
#define PG8_LAS __attribute__((address_space(3)))
typedef unsigned short bf16_t;
typedef unsigned u32x4 __attribute__((ext_vector_type(4)));
constexpr int BM = 256, BK = 64, HALF = 128, HTB = HALF * BK * 2, STAGE_BYTES = 8 * HTB, NXCD = 8, WGM = 8;

__host__ __device__ __forceinline__ int lds_byte(int r, int c) { const int st = (r >> 4) * 2 + (c >> 5), rr = r & 15, cc = c & 31, ob = rr * 64 + cc * 2; return st * 1024 + (ob ^ (((ob >> 9) & 1) << 5)); }
__host__ __device__ __forceinline__ void stage_rc(int b, int& R, int& C) { const int st = b / 1024, sb = b % 1024, swz = sb ^ (((sb >> 9) & 1) << 5); R = (st >> 1) * 16 + swz / 64; C = (st & 1) * 32 + (swz % 64) / 2; }
__host__ __device__ __forceinline__ int perm32(int rho) { const int n = rho >> 4, i = rho & 15; return 8 * (i >> 2) + 4 * n + (i & 3); }

struct Unit { int pm, pn; };
struct Gemm { const bf16_t* A; const bf16_t* Bt; int M, N, K, lda, ldb, a_pn_step; };

struct StaticOrder {
    int nM, nN, nwg, G, c;
    __host__ __device__ void init(int M, int N, int G_, int c_) { nM = M / BM; nN = N / BM; nwg = nM * nN; G = G_; c = c_; }
    __host__ __device__ bool next(int i, Unit& u) const {
        const long L = (long)i * G + c; if (L >= nwg) return false;
        int wgid = (int)L; { const int q = nwg / NXCD, r = nwg % NXCD, xcd = wgid % NXCD, off = wgid / NXCD; wgid = (xcd < r ? xcd * (q + 1) : r * (q + 1) + (xcd - r) * q) + off; }
        const int nig = WGM * nN, gid = wgid / nig, fm = gid * WGM, gsz = (nM - fm) < WGM ? (nM - fm) : WGM;
        u.pm = fm + ((wgid % nig) % gsz); u.pn = (wgid % nig) / gsz; return true;
    }
    __device__ __forceinline__ void a_ready(const Unit&) const {}
    __device__ __forceinline__ void done(const Unit&) const {}
};

__device__ __forceinline__ float row_rstd(const float* ss, int row, float inv_d, float eps) {
    const f32x4* sp = (const f32x4*)(ss + (size_t)row * 16);
    const f32x4 a = sp[0], b = sp[1], c = sp[2], d = sp[3];
    const float t = ((a[0] + a[1]) + (a[2] + a[3])) + ((b[0] + b[1]) + (b[2] + b[3])) + ((c[0] + c[1]) + (c[2] + c[3])) + ((d[0] + d[1]) + (d[2] + d[3]));
    return __builtin_amdgcn_rsqf(t * inv_d + eps);
}
struct EpiProj {
    static constexpr bool PERM = true, AFTER_DRAIN = false;
    bf16_t* O; int ldc; const float* ss; float inv_d, eps;
    __device__ __forceinline__ void operator()(const f32x4 (&acc)[2][2][4][2], const Unit& u, int wr, int wc, int fr, int fq) const {
        const int row0 = u.pm * BM + wr * 64 + fr, col0 = u.pn * BM + wc * 32 + 8 * fq;
#pragma unroll
        for (int ai = 0; ai < 2; ++ai)
#pragma unroll
            for (int m = 0; m < 4; ++m) { const int row = row0 + ai * HALF + m * 16; const float rs = row_rstd(ss, row, inv_d, eps);
                bf16_t* rowp = O + (size_t)row * ldc + col0;
#pragma unroll
                for (int bj = 0; bj < 2; ++bj) { const f32x4 v0 = acc[ai][bj][m][0] * rs, v1 = acc[ai][bj][m][1] * rs;
                    u32x4 w; w.x = cvt_pk_bf16(v0[0], v0[1]); w.y = cvt_pk_bf16(v0[2], v0[3]); w.z = cvt_pk_bf16(v1[0], v1[1]); w.w = cvt_pk_bf16(v1[2], v1[3]);
                    *(u32x4*)(rowp + bj * HALF) = w; } }
    }
};
__device__ __forceinline__ float silu_mul(float g, float u) { const float e = __builtin_amdgcn_exp2f(-1.4426950408889634f * g); return g * __builtin_amdgcn_rcpf(1.0f + e) * u; }
struct EpiGU {
    static constexpr bool PERM = true, AFTER_DRAIN = false;
    bf16_t* O; int ldc; const float* ss; float inv_d, eps;
    __device__ __forceinline__ void operator()(const f32x4 (&acc)[2][2][4][2], const Unit& u, int wr, int wc, int fr, int fq) const {
        const int row0 = u.pm * BM + wr * 64 + fr, col0 = u.pn * HALF + wc * 32 + 8 * fq;
#pragma unroll
        for (int ai = 0; ai < 2; ++ai)
#pragma unroll
            for (int m = 0; m < 4; ++m) { const int row = row0 + ai * HALF + m * 16; const float rs = row_rstd(ss, row, inv_d, eps);
                const f32x4 g0 = acc[ai][0][m][0] * rs, g1 = acc[ai][0][m][1] * rs, u0 = acc[ai][1][m][0] * rs, u1 = acc[ai][1][m][1] * rs;
                u32x4 w; w.x = cvt_pk_bf16(silu_mul(g0[0], u0[0]), silu_mul(g0[1], u0[1])); w.y = cvt_pk_bf16(silu_mul(g0[2], u0[2]), silu_mul(g0[3], u0[3]));
                w.z = cvt_pk_bf16(silu_mul(g1[0], u1[0]), silu_mul(g1[1], u1[1])); w.w = cvt_pk_bf16(silu_mul(g1[2], u1[2]), silu_mul(g1[3], u1[3]));
                *(u32x4*)(O + (size_t)row * ldc + col0) = w; }
    }
};
template <bool STATS> struct EpiRes {
    static constexpr bool PERM = true, AFTER_DRAIN = false;
    const float* base; float* out; bf16_t* xb; float* ss; int ldc; PG8_LAS float* exch;
    __device__ __forceinline__ void operator()(const f32x4 (&acc)[2][2][4][2], const Unit& u, int wr, int wc, int fr, int fq) const {
        const int row0 = u.pm * BM + wr * 64 + fr, col0 = u.pn * BM + wc * 32 + 8 * fq;
#pragma unroll
        for (int ai = 0; ai < 2; ++ai)
#pragma unroll
            for (int m = 0; m < 4; ++m) { const int row = row0 + ai * HALF + m * 16; const size_t off = (size_t)row * ldc + col0; float q = 0.f;
#pragma unroll
                for (int bj = 0; bj < 2; ++bj) { const f32x4 b0 = *(const f32x4*)(base + off + bj * HALF), b1 = *(const f32x4*)(base + off + bj * HALF + 4);
                    const f32x4 o0 = b0 + acc[ai][bj][m][0], o1 = b1 + acc[ai][bj][m][1];
                    *(f32x4*)(out + off + bj * HALF) = o0; *(f32x4*)(out + off + bj * HALF + 4) = o1;
                    if (STATS) { q += (o0[0] * o0[0] + o0[1] * o0[1]) + (o0[2] * o0[2] + o0[3] * o0[3]) + (o1[0] * o1[0] + o1[1] * o1[1]) + (o1[2] * o1[2] + o1[3] * o1[3]);
                        u32x4 w; w.x = cvt_pk_bf16(o0[0], o0[1]); w.y = cvt_pk_bf16(o0[2], o0[3]); w.z = cvt_pk_bf16(o1[0], o1[1]); w.w = cvt_pk_bf16(o1[2], o1[3]);
                        *(u32x4*)(xb + off + bj * HALF) = w; } }
                if (STATS) { q += __shfl_xor(q, 16); q += __shfl_xor(q, 32); if (fq == 0) exch[(ai * HALF + wr * 64 + m * 16 + fr) * 4 + wc] = q; }
                asm volatile("" ::: "memory"); }
        if (STATS) {
            asm volatile("s_waitcnt lgkmcnt(0)" ::: "memory"); __builtin_amdgcn_s_barrier(); asm volatile("" ::: "memory");
            const int t = threadIdx.x;
            if (t < 256) { const f32x4 p = *(const PG8_LAS f32x4*)(exch + t * 4); ss[(size_t)(u.pm * BM + t) * 16 + u.pn] = (p[0] + p[1]) + (p[2] + p[3]); }
        }
    }
};
struct EpiMKV {
    static constexpr bool PERM = true, AFTER_DRAIN = false;
    float* O; int ldc; const float* rs;
    __device__ __forceinline__ void operator()(const f32x4 (&acc)[2][2][4][2], const Unit& u, int wr, int wc, int fr, int fq) const {
        const int row0 = u.pm * BM + wr * 64 + fr, col0 = u.pn * BM + wc * 32 + 8 * fq;
#pragma unroll
        for (int ai = 0; ai < 2; ++ai)
#pragma unroll
            for (int m = 0; m < 4; ++m) { const int row = row0 + ai * HALF + m * 16; const float r = rs[row]; float* rowp = O + (size_t)row * ldc + col0;
#pragma unroll
                for (int bj = 0; bj < 2; ++bj) { *(f32x4*)(rowp + bj * HALF) = acc[ai][bj][m][0] * r; *(f32x4*)(rowp + bj * HALF + 4) = acc[ai][bj][m][1] * r; } }
    }
};
struct EpiMemS {
    static constexpr bool PERM = true, AFTER_DRAIN = false;
    bf16_t* P; float* ps;
    __device__ __forceinline__ void operator()(const f32x4 (&acc)[2][2][4][2], const Unit& u, int wr, int wc, int fr, int fq) const {
        const int row0 = u.pm * BM + wr * 64 + fr, col0 = u.pn * BM + wc * 32 + 8 * fq; constexpr float C = 0.0625f * 1.4426950408889634f;
#pragma unroll
        for (int ai = 0; ai < 2; ++ai)
#pragma unroll
            for (int m = 0; m < 4; ++m) { const int row = row0 + ai * HALF + m * 16;
#pragma unroll
                for (int bj = 0; bj < 2; ++bj) { const f32x4 a0 = acc[ai][bj][m][0], a1 = acc[ai][bj][m][1];
                    u32x4 w; w.x = cvt_pk_bf16(__builtin_amdgcn_exp2f(a0[0] * C), __builtin_amdgcn_exp2f(a0[1] * C)); w.y = cvt_pk_bf16(__builtin_amdgcn_exp2f(a0[2] * C), __builtin_amdgcn_exp2f(a0[3] * C));
                    w.z = cvt_pk_bf16(__builtin_amdgcn_exp2f(a1[0] * C), __builtin_amdgcn_exp2f(a1[1] * C)); w.w = cvt_pk_bf16(__builtin_amdgcn_exp2f(a1[2] * C), __builtin_amdgcn_exp2f(a1[3] * C));
                    *(u32x4*)(P + (size_t)row * MEM_W + col0 + bj * HALF) = w;
                    float q = ((bf_lo(w.x) + bf_hi(w.x)) + (bf_lo(w.y) + bf_hi(w.y))) + ((bf_lo(w.z) + bf_hi(w.z)) + (bf_lo(w.w) + bf_hi(w.w)));
                    q += __shfl_xor(q, 16); q += __shfl_xor(q, 32);
                    if (fq == 0) ps[((size_t)row * 4 + u.pn) * 8 + bj * 4 + wc] = q; } }
    }
};
struct EpiMemO {
    static constexpr bool PERM = true, AFTER_DRAIN = false;
    bf16_t* O; const float* ps;
    __device__ __forceinline__ void operator()(const f32x4 (&acc)[2][2][4][2], const Unit& u, int wr, int wc, int fr, int fq) const {
        const int row0 = u.pm * BM + wr * 64 + fr, col0 = SELF_W + u.pn * BM + wc * 32 + 8 * fq;
#pragma unroll
        for (int ai = 0; ai < 2; ++ai)
#pragma unroll
            for (int m = 0; m < 4; ++m) { const int row = row0 + ai * HALF + m * 16;
                const f32x4* lp = (const f32x4*)(ps + ((size_t)row * 4 + u.pn) * 8); const f32x4 la = lp[0], lb = lp[1];
                const float rl = 1.0f / (((la[0] + la[1]) + (la[2] + la[3])) + ((lb[0] + lb[1]) + (lb[2] + lb[3])));
#pragma unroll
                for (int bj = 0; bj < 2; ++bj) { const f32x4 v0 = acc[ai][bj][m][0] * rl, v1 = acc[ai][bj][m][1] * rl;
                    u32x4 w; w.x = cvt_pk_bf16(v0[0], v0[1]); w.y = cvt_pk_bf16(v0[2], v0[3]); w.z = cvt_pk_bf16(v1[0], v1[1]); w.w = cvt_pk_bf16(v1[2], v1[3]);
                    *(u32x4*)(O + (size_t)row * OPW + col0 + bj * HALF) = w; } }
    }
};

template <class Epi, class Sched, bool ALIGN_EPI = true>
__device__ __forceinline__ void gemm_phase(PG8_LAS unsigned char* lds, const Gemm g, const Sched& S, const Epi& E) {
    int tid_ = threadIdx.x; asm volatile("" : "+v"(tid_));
    const int tid = tid_, wid = __builtin_amdgcn_readfirstlane(tid >> 6), lane = tid & 63, wr = wid >> 2, wc = wid & 3, fr = lane & 15, fq = lane >> 4;
    const int K = g.K, nt = K / BK;
    unsigned voffA[2], voffB[2];
#pragma unroll
    for (int i = 0; i < 2; ++i) { int R, C; stage_rc(tid * 16 + i * 8192, R, C); const int Rb = Epi::PERM ? ((R & ~31) + perm32(R & 31)) : R;
        voffA[i] = (unsigned)(R * g.lda + C) * 2u; voffB[i] = (unsigned)(Rb * g.ldb + C) * 2u; }
    const size_t kstep = (size_t)(BK * 2);
    const size_t hstepA = (size_t)HALF * g.lda * 2, hstepB = (size_t)HALF * g.ldb * 2;
    const size_t tstepA = 2 * hstepA, tstepB = 2 * hstepB, pnstepA = (size_t)g.a_pn_step * 2;
    const unsigned ldsw = (unsigned)wid * 1024u;
    const int aoff = lds_byte(wr * 64 + fr, fq * 8), boff = lds_byte(wc * 32 + fr, fq * 8);
#define PG8_SA(b, h) (((b) * 2 + (h)) * HTB)
#define PG8_SB(b, h) ((4 + (b) * 2 + (h)) * HTB)
#define PG8_STAGE(bufoff, gbase, voff) do { _Pragma("unroll") for (int _i = 0; _i < 2; ++_i) \
        __builtin_amdgcn_global_load_lds((const unsigned*)((const char*)(gbase) + (voff)[_i]), (PG8_LAS unsigned*)(lds + (bufoff) + ldsw + _i * 8192), 16, 0, 0); } while (0)
#define PG8_LDA(dst, b, h) do { _Pragma("unroll") for (int m = 0; m < 4; ++m) _Pragma("unroll") for (int k = 0; k < 2; ++k) dst[m][k] = *(const PG8_LAS bf16x8*)(lds + PG8_SA(b, h) + aoff + m * 2048 + k * 1024); } while (0)
#define PG8_LDB(dst, b, h) do { _Pragma("unroll") for (int n = 0; n < 2; ++n) _Pragma("unroll") for (int k = 0; k < 2; ++k) dst[n][k] = *(const PG8_LAS bf16x8*)(lds + PG8_SB(b, h) + boff + n * 2048 + k * 1024); } while (0)
#define PG8_MMA(ai, bj, At, Bt) do { __builtin_amdgcn_s_setprio(1); _Pragma("unroll") for (int m = 0; m < 4; ++m) _Pragma("unroll") for (int n = 0; n < 2; ++n) _Pragma("unroll") for (int k = 0; k < 2; ++k) \
        acc[ai][bj][m][n] = __builtin_amdgcn_mfma_f32_16x16x32_bf16(Bt[n][k], At[m][k], acc[ai][bj][m][n], 0, 0, 0); __builtin_amdgcn_s_setprio(0); } while (0)
#define PG8_WAIT_V(n) asm volatile("s_waitcnt vmcnt(" #n ")" ::: "memory")
#define PG8_WAIT_L(n) asm volatile("s_waitcnt lgkmcnt(" #n ")" ::: "memory")
#define PG8_BAR __builtin_amdgcn_s_barrier()
#define PG8_SCHED __builtin_amdgcn_sched_barrier(0)
    __builtin_amdgcn_s_waitcnt(0);
    Unit cur, nxt; int ui = 0;
    if (!S.next(0, cur)) return;
    f32x4 acc[2][2][4][2];
#pragma unroll
    for (int a = 0; a < 2; ++a)
#pragma unroll
        for (int b = 0; b < 2; ++b)
#pragma unroll
            for (int m = 0; m < 4; ++m)
#pragma unroll
                for (int n = 0; n < 2; ++n) acc[a][b][m][n] = (f32x4){0.f, 0.f, 0.f, 0.f};
    bf16x8 At[4][2], B0[2][2], B1[2][2];
    const char* cA = (const char*)g.A + (size_t)cur.pm * tstepA + (size_t)cur.pn * pnstepA; const char* cB = (const char*)g.Bt + (size_t)cur.pn * tstepB;
    S.a_ready(cur);
    PG8_STAGE(PG8_SB(0, 0), cB, voffB); PG8_STAGE(PG8_SB(0, 1), cB + hstepB, voffB); PG8_STAGE(PG8_SA(0, 0), cA, voffA); PG8_STAGE(PG8_SA(0, 1), cA + hstepA, voffA);
    if (wr == 1) PG8_BAR;
    PG8_WAIT_V(2); PG8_BAR;
    PG8_STAGE(PG8_SB(1, 0), cB + kstep, voffB); PG8_STAGE(PG8_SA(1, 0), cA + kstep, voffA); PG8_STAGE(PG8_SB(1, 1), cB + hstepB + kstep, voffB);
    PG8_WAIT_V(6); PG8_BAR;
    for (;;) {
        const bool has_next = S.next(ui + 1, nxt);
        const char* nA = has_next ? (const char*)g.A + (size_t)nxt.pm * tstepA + (size_t)nxt.pn * pnstepA : cA; const char* nB = has_next ? (const char*)g.Bt + (size_t)nxt.pn * tstepB : cB;
#pragma unroll 1
        for (int t = 0; t < nt; t += 2) {
            const bool last = (t == nt - 2);
            const char* a1 = cA + (size_t)(t + 1) * kstep;
            const char* a2 = last ? nA : cA + (size_t)(t + 2) * kstep; const char* b2 = last ? nB : cB + (size_t)(t + 2) * kstep;
            const char* a3 = a2 + kstep; const char* b3 = b2 + kstep;
            if (last && has_next) S.a_ready(nxt);
            PG8_LDB(B0, 0, 0); PG8_LDB(B1, 0, 1); PG8_SCHED; PG8_LDA(At, 0, 0); PG8_STAGE(PG8_SA(1, 1), a1 + hstepA, voffA);
            PG8_WAIT_V(8); PG8_WAIT_L(0); PG8_BAR; PG8_MMA(0, 0, At, B0); PG8_MMA(0, 1, At, B1); PG8_BAR; PG8_SCHED;
            PG8_LDA(At, 0, 1); PG8_STAGE(PG8_SB(0, 0), b2, voffB); PG8_STAGE(PG8_SB(0, 1), b2 + hstepB, voffB); PG8_STAGE(PG8_SA(0, 0), a2, voffA);
            PG8_WAIT_V(8); PG8_WAIT_L(0); PG8_BAR; PG8_MMA(1, 0, At, B0); PG8_MMA(1, 1, At, B1); PG8_BAR; PG8_SCHED;
            PG8_LDB(B0, 1, 0); PG8_LDB(B1, 1, 1); PG8_SCHED; PG8_LDA(At, 1, 0); PG8_STAGE(PG8_SA(0, 1), a2 + hstepA, voffA);
            PG8_WAIT_V(8); PG8_WAIT_L(0); PG8_BAR; PG8_MMA(0, 0, At, B0); PG8_MMA(0, 1, At, B1); PG8_BAR; PG8_SCHED;
            PG8_LDA(At, 1, 1); PG8_STAGE(PG8_SB(1, 0), b3, voffB); PG8_STAGE(PG8_SB(1, 1), b3 + hstepB, voffB); PG8_STAGE(PG8_SA(1, 0), a3, voffA);
            PG8_WAIT_V(8); PG8_WAIT_L(0); PG8_BAR; PG8_MMA(1, 0, At, B0); PG8_MMA(1, 1, At, B1); PG8_BAR; PG8_SCHED;
        }
        if constexpr (ALIGN_EPI) { if (wr == 0) PG8_BAR; }
        E(acc, cur, wr, wc, fr, fq); S.done(cur);
        if (!has_next) break;
#pragma unroll
        for (int a = 0; a < 2; ++a)
#pragma unroll
            for (int b = 0; b < 2; ++b)
#pragma unroll
                for (int m = 0; m < 4; ++m)
#pragma unroll
                    for (int n = 0; n < 2; ++n) acc[a][b][m][n] = (f32x4){0.f, 0.f, 0.f, 0.f};
        cur = nxt; cA = nA; cB = nB; ++ui;
        if constexpr (ALIGN_EPI) { if (wr == 1) PG8_BAR; }
    }
    PG8_WAIT_V(0); __builtin_amdgcn_s_waitcnt(0);
    if constexpr (!ALIGN_EPI) { if (wr == 0) PG8_BAR; }
    PG8_BAR;
#undef PG8_SA
#undef PG8_SB
#undef PG8_STAGE
#undef PG8_LDA
#undef PG8_LDB
#undef PG8_MMA
#undef PG8_WAIT_V
#undef PG8_WAIT_L
#undef PG8_BAR
#undef PG8_SCHED
}
}

namespace att {
constexpr float SCALE = 0.08838834764831845f;
constexpr int NW = 8, QBLK = 32, KVBLK = 64, QB = NW * QBLK, D = 128;
constexpr int SHM_V = KVBLK * D * 2, SHM_K = KVBLK * D * 2;
constexpr int ATT_LDS_BYTES = 2 * SHM_V + 2 * SHM_K + NW * 64 * 4;
constexpr float THR = 8.f;
#define KSWZ(row, colB) ((row) * 256 + ((colB) ^ (((row) & 7) << 4)))
#define SBAR() __builtin_amdgcn_sched_barrier(0)
__device__ __forceinline__ int v_st(int k, int c) { const int kk = (k & ~0xC) | ((k & 4) << 1) | ((k & 8) >> 1); return ((kk >> 3) * 4 + (c >> 5)) * 512 + ((kk & 7) * 32 + (c & 31)) * 2; }
__device__ __forceinline__ int v_rd_base(int lane) { return ((lane & 3) << 3) | (((lane >> 2) & 3) << 6) | (((lane >> 4) & 1) << 5) | (((lane >> 5) & 1) << 8); }
constexpr int v_rd_off(int d0, int ks, int half) { return d0 * 512 + ks * 4096 + half * 2048; }
__device__ __forceinline__ int crow(int r, int hi) { return (r & 3) + 8 * (r >> 2) + 4 * hi; }
__device__ __forceinline__ unsigned cvtpk(float lo, float hi) { unsigned r; asm volatile("v_cvt_pk_bf16_f32 %0, %1, %2" : "=v"(r) : "v"(lo), "v"(hi)); return r; }
__device__ __forceinline__ bf16x8 load8(const bf16* p) { return *reinterpret_cast<const bf16x8*>(p); }
__device__ __forceinline__ void mask_tile(f32x16& p0, f32x16& p1, int dq) {
    const float NEG = -__builtin_inff();
#pragma unroll
    for (int r = 0; r < 16; ++r) {
        const int c = (r & 3) + 8 * (r >> 2);
        if (dq - c < 0) p0[r] = NEG;
        if (dq - c - 32 < 0) p1[r] = NEG;
    }
}
__device__ __forceinline__ void mask_sel(f32x16& p0, f32x16& p1, unsigned keep) {
    const float NEG = -__builtin_inff();
#pragma unroll
    for (int r = 0; r < 16; ++r) { p0[r] = keep ? p0[r] : NEG; p1[r] = keep ? p1[r] : NEG; }
}
__device__ __forceinline__ void partialSM(f32x16& p0, f32x16& p1, float& m_reg, float& mn, float& alpha) {
    float pmax = p0[0]; for (int r = 1; r < 16; ++r) pmax = fmaxf(pmax, p0[r]); for (int r = 0; r < 16; ++r) pmax = fmaxf(pmax, p1[r]);
    { auto rr = __builtin_amdgcn_permlane32_swap(__float_as_uint(pmax), __float_as_uint(pmax), false, false);
      pmax = fmaxf(__uint_as_float(rr[0]), __uint_as_float(rr[1])); }
    constexpr float C2 = 1.4426950408889634f * SCALE;
    if (__builtin_expect(__all((pmax - m_reg) * SCALE <= THR), 1)) { mn = m_reg; alpha = 1.f; }
    else { mn = fmaxf(m_reg, pmax); alpha = __builtin_amdgcn_exp2f((m_reg - mn) * C2); m_reg = mn; }
    const float mnL = -mn * C2;
    for (int r = 0; r < 16; ++r) p0[r] = fmaf(p0[r], C2, mnL); for (int r = 0; r < 16; ++r) p1[r] = fmaf(p1[r], C2, mnL);
    for (int r = 0; r < 16; ++r) p0[r] = __builtin_amdgcn_exp2f(p0[r]);
}
__device__ __forceinline__ void finishSM(f32x16& p0, f32x16& p1, float alpha, float& l_reg, bf16x8& pa0, bf16x8& pa1, bf16x8& pa2, bf16x8& pa3) {
    for (int r = 0; r < 16; ++r) p1[r] = __builtin_amdgcn_exp2f(p1[r]);
    float ps = 0; for (int r = 0; r < 16; ++r) ps += p0[r]; for (int r = 0; r < 16; ++r) ps += p1[r];
    { auto rr = __builtin_amdgcn_permlane32_swap(__float_as_uint(ps), __float_as_uint(ps), false, false);
      ps = __uint_as_float(rr[0]) + __uint_as_float(rr[1]); }
    l_reg = l_reg * alpha + ps;
#define PK4(P, B_, OUT) do { unsigned a0 = cvtpk(P[B_+0], P[B_+1]), a1 = cvtpk(P[B_+2], P[B_+3]);                          \
        unsigned b0 = cvtpk(P[B_+4], P[B_+5]), b1 = cvtpk(P[B_+6], P[B_+7]);                                             \
        auto r0 = __builtin_amdgcn_permlane32_swap(a0, b0, false, false); auto r1 = __builtin_amdgcn_permlane32_swap(a1, b1, false, false); \
        v4u w = {r0[0], r1[0], r0[1], r1[1]}; OUT = *reinterpret_cast<bf16x8*>(&w); } while (0)
    PK4(p0, 0, pa0); PK4(p0, 8, pa1); PK4(p1, 0, pa2); PK4(p1, 8, pa3);
#undef PK4
}
template <int KB>
__device__ __forceinline__ void qkt(f32x16& p0, f32x16& p1, const char* K_lds, int r32, int hi, const bf16x8* qr) {
    p0 = f32x16{}; p1 = f32x16{};
    const char* kb[4];
#pragma unroll
    for (int dd = 0; dd < 4; ++dd) kb[dd] = K_lds + KB * SHM_K + KSWZ(r32, (dd * 16 + hi * 8) * 2);
#pragma unroll
    for (int d0 = 0; d0 < 8; ++d0) { const char* a = kb[d0 & 3] + (d0 >> 2) * 128;
        bf16x8 b0 = *reinterpret_cast<const bf16x8*>(a);
        bf16x8 b1 = *reinterpret_cast<const bf16x8*>(a + 32 * 256);
        p0 = __builtin_amdgcn_mfma_f32_32x32x16_bf16(b0, qr[d0], p0, 0, 0, 0);
        p1 = __builtin_amdgcn_mfma_f32_32x32x16_bf16(b1, qr[d0], p1, 0, 0, 0); }
}
template <int VB>
__device__ __forceinline__ void pv_tile(f32x16* o, int vb0, bf16x8 pa0, bf16x8 pa1, bf16x8 pa2, bf16x8 pa3) {
#define TRRD(dst, off) asm volatile("ds_read_b64_tr_b16 %0, %1 offset:%2" : "=&v"(dst) : "v"(vb0), "i"(off) : "memory")
#define PV_D0(d0) do { s16x4 l0, l1, l2, l3, h0, h1, h2, h3; constexpr int b_ = VB * SHM_V + v_rd_off(d0, 0, 0); \
        TRRD(l0, b_); TRRD(h0, b_ + 2048); TRRD(l1, b_ + 4096); TRRD(h1, b_ + 6144); TRRD(l2, b_ + 8192); TRRD(h2, b_ + 10240); TRRD(l3, b_ + 12288); TRRD(h3, b_ + 14336); \
        asm volatile("s_waitcnt lgkmcnt(0)" ::: "memory"); SBAR();   \
        o[d0] = __builtin_amdgcn_mfma_f32_32x32x16_bf16(pa0, (bf16x8){l0[0], l0[1], l0[2], l0[3], h0[0], h0[1], h0[2], h0[3]}, o[d0], 0, 0, 0);   \
        o[d0] = __builtin_amdgcn_mfma_f32_32x32x16_bf16(pa1, (bf16x8){l1[0], l1[1], l1[2], l1[3], h1[0], h1[1], h1[2], h1[3]}, o[d0], 0, 0, 0);   \
        o[d0] = __builtin_amdgcn_mfma_f32_32x32x16_bf16(pa2, (bf16x8){l2[0], l2[1], l2[2], l2[3], h2[0], h2[1], h2[2], h2[3]}, o[d0], 0, 0, 0);   \
        o[d0] = __builtin_amdgcn_mfma_f32_32x32x16_bf16(pa3, (bf16x8){l3[0], l3[1], l3[2], l3[3], h3[0], h3[1], h3[2], h3[3]}, o[d0], 0, 0, 0); } while (0)
    PV_D0(0); PV_D0(1); PV_D0(2); PV_D0(3);
#undef PV_D0
#undef TRRD
}

struct BlockRef { const bf16* Q; const bf16* K; const bf16* V; bf16* O; const unsigned* sel; int P0; };
struct Seam { bf16x8 qr[8]; bf16x8 st_v0, st_v1, st_k0, st_k1; };
#define KVP(p, k0, half) ((const char*)(p) + (size_t)((k0) + 32 * (half)) * (ldkv * 2))
__device__ __forceinline__ bf16x8 ld16(const char* base, unsigned off) { return *reinterpret_cast<const bf16x8*>(base + off); }
#define VMW() asm volatile("s_waitcnt vmcnt(0)" ::: "memory")
#define VMWN(n) asm volatile("s_waitcnt vmcnt(%0)" :: "i"(n) : "memory")
#define SLOAD_H(Kp, Vp, k0) do { S.st_v0 = ld16(KVP(Vp, k0, 0), kvoff); S.st_v1 = ld16(KVP(Vp, k0, 1), kvoff);              \
                         S.st_k0 = ld16(KVP(Kp, k0, 0), kvoff); S.st_k1 = ld16(KVP(Kp, k0, 1), kvoff); } while (0)
#define SWRITE_HK(bf) do { *(bf16x8*)(K_lds + (bf) * SHM_K + kws) = S.st_k0; *(bf16x8*)(K_lds + (bf) * SHM_K + kws + 32 * 256) = S.st_k1; } while (0)
#define SWRITE_HV(bf) do { *(bf16x8*)(V_lds + (bf) * SHM_V + vst0) = S.st_v0; *(bf16x8*)(V_lds + (bf) * SHM_V + vst1) = S.st_v1; } while (0)
#define SWRITE_H(bf) do { SWRITE_HV(bf); SWRITE_HK(bf); } while (0)
constexpr int ldq = PW, ldkv = PW, ldo = OPW;
__device__ __forceinline__ void attn_prime(const BlockRef& cur, char* lds, Seam& S, const int tid) {
    const int wid = __builtin_amdgcn_readfirstlane(tid >> 6), lane = tid & 63, r32 = lane & 31, hi = lane >> 5;
    const int sr = tid >> 4, sc = (tid & 15) * 8, kws = KSWZ(sr, sc * 2); char* K_lds = lds + 2 * SHM_V;
    const unsigned kvoff = (unsigned)(sr * ldkv + sc) * 2u, qoff = (unsigned)((wid * QBLK + r32) * ldq + hi * 8) * 2u;
    for (int d0 = 0; d0 < 8; ++d0) S.qr[d0] = ld16((const char*)cur.Q + d0 * 32, qoff);
    SLOAD_H(cur.K, cur.V, 0); VMW(); SWRITE_HK(0);
    __syncthreads();
}
__device__ __forceinline__ void attn_block(const BlockRef& cur, const BlockRef& nxt, char* lds, Seam& S, const int tid) {
    const int wid = __builtin_amdgcn_readfirstlane(tid >> 6), lane = tid & 63, r32 = lane & 31, hi = lane >> 5;
    const int NT = (cur.P0 + QB - 1) / KVBLK + 1;
    const int qlo = cur.P0 + wid * QBLK, qm = qlo + r32 - 4 * hi;
    const bool moba = cur.sel != nullptr;
    unsigned selmask = 0u; if (moba) selmask = *(const unsigned*)((const char*)cur.sel + (unsigned)(wid * QBLK + r32) * 4u);
    char* V_lds = lds; char* K_lds = lds + 2 * SHM_V;
    float* ws = (float*)(lds + 2 * SHM_V + 2 * SHM_K) + wid * 64; float* li_l = ws, * al_l = ws + 32;
    float m_reg = -1e30f, l_reg = 0; f32x16 o[4] = {};
    const int sr = tid >> 4, sc = (tid & 15) * 8, vst0 = v_st(sr, sc), vst1 = v_st(32 + sr, sc), kws = KSWZ(sr, sc * 2);
    const unsigned kvoff = (unsigned)(sr * ldkv + sc) * 2u, qoff = (unsigned)((wid * QBLK + r32) * ldq + hi * 8) * 2u;
    const int vb0 = (int)(uintptr_t)V_lds + v_rd_base(lane);
    const bf16* Kh = cur.K; const bf16* Vh = cur.V;
#define RESC(a) do { if (__any((a) < 1.f)) { if (hi == 0) al_l[r32] = (a); asm volatile("s_waitcnt lgkmcnt(0)" ::: "memory");              \
                     for (int d_ = 0; d_ < 4; ++d_) for (int r = 0; r < 16; ++r) o[d_][r] *= al_l[crow(r, hi)]; } } while (0)
#define KBASE(t) ((t) * KVBLK)
#define MASKT(P0_, P1_, t) do { const int kb_ = KBASE(t); if (kb_ + KVBLK - 1 > qlo) mask_tile(P0_, P1_, qm - kb_); \
        else if (moba && kb_ < cur.P0) mask_sel(P0_, P1_, (selmask >> (kb_ >> 8)) & 1u); } while (0)
    constexpr int NQL = 8;
#define SEAM_K0() do { VMWN(NQL); SWRITE_HK(0); SBAR(); } while (0)
    f32x16 pA0, pA1, pB0, pB1; float mnA, mnB, alA, alB; bf16x8 pa0, pa1, pa2, pa3;
    SWRITE_HV(0); SBAR();
    if (NT > 1) { SLOAD_H(Kh, Vh, KBASE(1)); }
    SBAR(); qkt<0>(pA0, pA1, K_lds, r32, hi, S.qr);
    MASKT(pA0, pA1, 0); partialSM(pA0, pA1, m_reg, mnA, alA);
    if (NT > 1) { VMW(); SWRITE_H(1); }
    __syncthreads();
#define HALF_STEP(PX0, PX1, mnX, alX, PY0, PY1, alY, t, KB, VB, SB) do {                                                      \
        SBAR(); qkt<KB>(PX0, PX1, K_lds, r32, hi, S.qr);                                                         \
        finishSM(PY0, PY1, alY, l_reg, pa0, pa1, pa2, pa3); SBAR();                                                           \
        if ((t) + 1 < NT) { SLOAD_H(Kh, Vh, KBASE((t) + 1)); SBAR(); }                                               \
        pv_tile<VB>(o, vb0, pa0, pa1, pa2, pa3); MASKT(PX0, PX1, (t)); partialSM(PX0, PX1, m_reg, mnX, alX);                                        \
        __syncthreads();                                                                                                      \
        if ((t) + 1 < NT) { VMW(); SWRITE_H(SB); }                                                                          \
        RESC(alX); __syncthreads(); } while (0)
    for (int t = 1; t + 1 < NT; t += 2) {
        HALF_STEP(pB0, pB1, mnB, alB, pA0, pA1, alA, t, 1, 0, 0);
        HALF_STEP(pA0, pA1, mnA, alA, pB0, pB1, alB, t + 1, 0, 1, 1);
    }
    const bool even = (NT & 1) == 0;
    if (even) { SBAR(); qkt<1>(pB0, pB1, K_lds, r32, hi, S.qr); SBAR(); }
    { const bf16* Kn = nxt.K; const bf16* Vn = nxt.V; SLOAD_H(Kn, Vn, 0); SBAR(); }
#pragma unroll
    for (int d0 = 0; d0 < 8; ++d0) S.qr[d0] = ld16((const char*)nxt.Q + d0 * 32, qoff);
    SBAR();
    finishSM(pA0, pA1, alA, l_reg, pa0, pa1, pa2, pa3); SBAR();
    pv_tile<0>(o, vb0, pa0, pa1, pa2, pa3);
    if (even) { MASKT(pB0, pB1, NT - 1); partialSM(pB0, pB1, m_reg, mnB, alB); __syncthreads(); RESC(alB);
        finishSM(pB0, pB1, alB, l_reg, pa0, pa1, pa2, pa3); SBAR(); pv_tile<1>(o, vb0, pa0, pa1, pa2, pa3); }
    SBAR(); SEAM_K0();
    if (hi == 0) li_l[r32] = l_reg; asm volatile("s_waitcnt lgkmcnt(0)" ::: "memory");
    float rli[16];
#pragma unroll
    for (int r = 0; r < 16; ++r) rli[r] = __builtin_amdgcn_rcpf(li_l[crow(r, hi)]);
    unsigned ooff = (unsigned)((wid * QBLK + 4 * hi) * ldo + r32) * 2u;
    asm volatile("" : "+v"(ooff));
    char* Ob = (char*)cur.O;
#pragma unroll
    for (int r = 0; r < 16; ++r) { const unsigned orow_b = (unsigned)(((r & 3) + 8 * (r >> 2)) * ldo) * 2u;
#pragma unroll
        for (int d0 = 0; d0 < 4; ++d0) { const float v = o[d0][r] * rli[r];
            const float vn = __shfl_xor(v, 1);
            if ((r32 & 1) == 0) *(unsigned*)(Ob + (ooff + orow_b + d0 * 64)) = cvtpk(v, vn); } }
    __syncthreads();
#undef RESC
#undef KBASE
#undef MASKT
#undef SEAM_K0
#undef HALF_STEP
}
#undef KVP
#undef VMW
#undef VMWN
#undef SLOAD_H
#undef SWRITE_HK
#undef SWRITE_HV
#undef SWRITE_H
}

#define XB_TMO      128
#define XB_XCNT(j)  (256  + 64 * (j))
#define XB_XSUB(j)  (1280 + 64 * (j))
#define XB_XGEN(j)  (2304 + 64 * (j))
#define XB_TOP      3328
#define XB_TOPGEN   3392
#define XCD_BAR_WORDS 3456
#define XB_SPIN_CAP (1u << 18)
__device__ __forceinline__ unsigned xb_ld(unsigned* p)              { return __hip_atomic_load(p, __ATOMIC_RELAXED, __HIP_MEMORY_SCOPE_AGENT); }
__device__ __forceinline__ unsigned xb_add(unsigned* p, unsigned v) { return __hip_atomic_fetch_add(p, v, __ATOMIC_RELAXED, __HIP_MEMORY_SCOPE_AGENT); }
__device__ __forceinline__ unsigned xb_xcc_id() { return (unsigned)__builtin_amdgcn_s_getreg((3 << 11) | 20) & 0xFu; }
#define XB_SPIN(cond, bar) do { unsigned _sp = 0; while (cond) { __builtin_amdgcn_s_sleep(1); \
    if ((++_sp & 255u) == 0u) { if (xb_ld(&(bar)[XB_TMO])) break; if (_sp > XB_SPIN_CAP) { atomicAdd(&(bar)[XB_TMO], 1u); break; } } } } while (0)
struct XcdBarrier { unsigned* bar; unsigned x; volatile LAS unsigned* st; };
__device__ __forceinline__ XcdBarrier xcd_barrier_post(unsigned* bar, volatile LAS unsigned* st) {
    XcdBarrier b; b.bar = bar; b.x = xb_xcc_id(); b.st = st;
    if (threadIdx.x == 0) (void)xb_add(&bar[XB_XCNT(b.x)], 1u);
    return b;
}
__device__ __forceinline__ void xcd_barrier_complete(unsigned* bar, unsigned x, unsigned& nloc, unsigned& nx) {
    const unsigned G = gridDim.x * gridDim.y * gridDim.z;
    unsigned sum, cnt, mine, sp = 0u;
    for (;;) {
        sum = 0u; cnt = 0u; mine = 0u;
#pragma unroll
        for (unsigned j = 0; j < 16; ++j) { const unsigned c = xb_ld(&bar[XB_XCNT(j)]); sum += c; cnt += (c > 0u) ? 1u : 0u; mine = (j == x) ? c : mine; }
        if (sum == G) break;
        __builtin_amdgcn_s_sleep(1);
        if ((++sp & 255u) == 0u) { if (xb_ld(&bar[XB_TMO])) break; if (sp > XB_SPIN_CAP) { atomicAdd(&bar[XB_TMO], 1u); break; } }
    }
    nloc = mine > 0u ? mine : 1u; nx = cnt > 0u ? cnt : 1u;
}
__device__ __forceinline__ void xcd_barrier(const XcdBarrier& b) {
    asm volatile("s_waitcnt vmcnt(0)" ::: "memory");
    __syncthreads();
    if (threadIdx.x == 0) {
        unsigned* bar = b.bar;
        __builtin_amdgcn_s_waitcnt(0);
        unsigned nloc = b.st[0], nx = b.st[1];
        if (nloc == 0u) { xcd_barrier_complete(bar, b.x, nloc, nx); b.st[0] = nloc; b.st[1] = nx; }
        const unsigned old = xb_add(&bar[XB_XSUB(b.x)], 1u);
        const unsigned gen = old / nloc;
        if (old + 1u == (gen + 1u) * nloc) {
            __builtin_amdgcn_fence(__ATOMIC_RELEASE, "agent");
            asm volatile("s_waitcnt vmcnt(0)" ::: "memory");
            const unsigned og = xb_add(&bar[XB_TOP], 1u);
            const unsigned tg = og / nx;
            if (og + 1u == (tg + 1u) * nx) xb_add(&bar[XB_TOPGEN], 1u);
            else XB_SPIN(xb_ld(&bar[XB_TOPGEN]) == tg, bar);
            __builtin_amdgcn_fence(__ATOMIC_ACQUIRE, "agent");
            xb_add(&bar[XB_XGEN(b.x)], 1u);
            asm volatile("s_waitcnt vmcnt(0)" ::: "memory");
        } else {
            XB_SPIN(xb_ld(&bar[XB_XGEN(b.x)]) == gen, bar);
            __builtin_amdgcn_fence(__ATOMIC_ACQUIRE, "agent");
            asm volatile("s_waitcnt vmcnt(0)" ::: "memory");
        }
    }
    __syncthreads();
}

__device__ __forceinline__ void xcd_barrier_slim(const XcdBarrier& b) {
    asm volatile("s_waitcnt vmcnt(0)" ::: "memory");
    __syncthreads();
    if (threadIdx.x == 0) {
        unsigned* bar = b.bar;
        __builtin_amdgcn_s_waitcnt(0);
        unsigned nloc = b.st[0], nx = b.st[1];
        if (nloc == 0u || nx == 0u) { atomicAdd(&bar[XB_TMO], 1u); nloc = 1u; nx = 1u; }
        const unsigned old = xb_add(&bar[XB_XSUB(b.x)], 1u);
        const unsigned gen = old / nloc;
        if (old + 1u == (gen + 1u) * nloc) {
            __builtin_amdgcn_fence(__ATOMIC_RELEASE, "agent");
            asm volatile("s_waitcnt vmcnt(0)" ::: "memory");
            const unsigned og = xb_add(&bar[XB_TOP], 1u);
            const unsigned tg = og / nx;
            if (og + 1u == (tg + 1u) * nx) xb_add(&bar[XB_TOPGEN], 1u);
            else XB_SPIN(xb_ld(&bar[XB_TOPGEN]) == tg, bar);
            __builtin_amdgcn_fence(__ATOMIC_ACQUIRE, "agent");
            xb_add(&bar[XB_XGEN(b.x)], 1u);
            asm volatile("s_waitcnt vmcnt(0)" ::: "memory");
        } else {
            XB_SPIN(xb_ld(&bar[XB_XGEN(b.x)]) == gen, bar);
            __builtin_amdgcn_fence(__ATOMIC_ACQUIRE, "agent");
            asm volatile("s_waitcnt vmcnt(0)" ::: "memory");
        }
    }
    __syncthreads();
}

constexpr int NWAVES = 8;
struct Args { const void* in[N_IN]; float* out; unsigned char* ws; int ph_lo, ph_hi; };
static_assert(sizeof(Args) == (N_IN + 2) * 8 + 8, "Args has no padding");

struct Frame {
    LAS unsigned char* lds; char* ldsg; unsigned char* ws; int tid, lane, wave, vcu, G;
};
__device__ __forceinline__ Frame phase_frame(const Frame& F0) {
    Frame F = F0; int t = threadIdx.x; asm volatile("" : "+v"(t)); size_t z = 0; asm volatile("" : "+s"(z));
    F.tid = t; F.lane = t & 63; F.wave = __builtin_amdgcn_readfirstlane(t >> 6); F.ws = F0.ws + z; return F;
}

__device__ __forceinline__ void p0_transpose_item(const float* W, const float* gk, int K, int N, bf16* WT, int rowmode, LAS float* scr, int item, int lane) {
    const int nblk = N / 64, kb = item / nblk, nb = item - kb * nblk, k0 = 64 * kb, n0 = 64 * nb;
    const int kk4 = lane >> 4, nq = lane & 15;
    f32x4 v[16];
#pragma unroll
    for (int i = 0; i < 16; ++i) v[i] = *(const GAS f32x4*)(W + (size_t)(k0 + 4 * i + kk4) * N + n0 + 4 * nq);
#pragma unroll
    for (int i = 0; i < 16; ++i) { const int k = 4 * i + kk4; f32x4 w = v[i]; if (gk) w = w * gk[k0 + k];
        *(LAS f32x4*)(scr + k * 64 + ((4 * nq) ^ (k & 0x38))) = w; }
    LDS_WAIT(); asm volatile("" ::: "memory");
    const int r = lane >> 3, c = lane & 7;
    const int rbase = rowmode == 0 ? n0 : ((n0 >> 7) * 256 + (n0 & 127) + (rowmode == 2 ? 128 : 0));
#pragma unroll
    for (int i = 0; i < 8; ++i) { const int n = 8 * i + r; const LAS float* sp = scr + (8 * c) * 64 + (n ^ (8 * c));
        v4u o; o.x = cvt_pk_bf16(sp[0 * 64], sp[1 * 64]); o.y = cvt_pk_bf16(sp[2 * 64], sp[3 * 64]); o.z = cvt_pk_bf16(sp[4 * 64], sp[5 * 64]); o.w = cvt_pk_bf16(sp[6 * 64], sp[7 * 64]);
        *(GAS v4u*)(WT + (size_t)(rbase + n) * K + k0 + 8 * c) = o; }
    LDS_WAIT(); asm volatile("" ::: "memory");
}

__device__ __forceinline__ void p0_prologue(const Frame& F0, const Args& a) {
    const Frame F = phase_frame(F0);
    LAS float* scr = (LAS float*)(F.lds + F.wave * 16384);
    const int gw = F.vcu * NWAVES + F.wave, NGW = F.G * NWAVES;
    constexpr int I_IN = (DM / 64) * (PW / 64), I_OUT = (DM / 64) * (DM / 64), I_G = (DM / 64) * (DFF / 64), I_D = (DFF / 64) * (DM / 64), I_MK = (DM / 64) * (2 * MEM_W / 64);
    constexpr int I_LAYER = I_IN + I_OUT + 2 * I_G + I_D;
    for (int it = gw; it < 2 * I_LAYER + I_MK; it += NGW) {
        if (it >= 2 * I_LAYER) { p0_transpose_item((const float*)a.in[IN_WMEMKV], nullptr, DM, 2 * MEM_W, (bf16*)(F.ws + WS_WMK), 0, scr, it - 2 * I_LAYER, F.lane); continue; }
        const int l = it >= I_LAYER ? 1 : 0; int r = it - l * I_LAYER;
        if (r < I_IN) { p0_transpose_item((const float*)a.in[IN_WIN] + (size_t)l * DM * PW, (const float*)a.in[IN_GATTN] + l * DM, DM, PW, (bf16*)(F.ws + WS_WIN + l * SZ_WIN), 0, scr, r, F.lane); continue; } r -= I_IN;
        if (r < I_OUT) { p0_transpose_item((const float*)a.in[IN_WOUT] + (size_t)l * DM * DM, nullptr, DM, DM, (bf16*)(F.ws + WS_WOUT + l * SZ_WOUT), 0, scr, r, F.lane); continue; } r -= I_OUT;
        if (r < I_G) { p0_transpose_item((const float*)a.in[IN_WGATE] + (size_t)l * DM * DFF, (const float*)a.in[IN_GFFN] + l * DM, DM, DFF, (bf16*)(F.ws + WS_WGU + l * SZ_WGU), 1, scr, r, F.lane); continue; } r -= I_G;
        if (r < I_G) { p0_transpose_item((const float*)a.in[IN_WUP] + (size_t)l * DM * DFF, (const float*)a.in[IN_GFFN] + l * DM, DM, DFF, (bf16*)(F.ws + WS_WGU + l * SZ_WGU), 2, scr, r, F.lane); continue; } r -= I_G;
        p0_transpose_item((const float*)a.in[IN_WDOWN] + (size_t)l * DFF * DM, nullptr, DFF, DM, (bf16*)(F.ws + WS_WDN + l * SZ_WDN), 0, scr, r, F.lane);
    }
    { const float* x = (const float*)a.in[IN_X]; bf16* xb = (bf16*)(F.ws + WS_XB); float* ssb = (float*)(F.ws + WS_SSB);
      for (int m = gw; m < SEQ; m += NGW) {
          const GAS f32x4* xr = (const GAS f32x4*)(x + (size_t)m * DM) + F.lane; GAS v2u* o8 = (GAS v2u*)(xb + (size_t)m * DM) + F.lane; float s = 0.f;
#pragma unroll 4
          for (int j = 0; j < 16; ++j) { const f32x4 v = xr[64 * j]; s += (v[0] * v[0] + v[1] * v[1]) + (v[2] * v[2] + v[3] * v[3]); v2u w; w.x = cvt_pk_bf16(v[0], v[1]); w.y = cvt_pk_bf16(v[2], v[3]); o8[64 * j] = w; }
          s = wave_sum(s);
          if (F.lane < 16) ssb[(size_t)m * 16 + F.lane] = F.lane == 0 ? s : 0.f; } }
    { const int* pos = (const int*)a.in[IN_POS]; float* cs = (float*)(F.ws + WS_CS);
      const float INV[16] = {1.000000000e+00f, 4.403665960e-01f, 1.939227432e-01f, 8.539710194e-02f, 3.760603070e-02f, 1.656043902e-02f, 7.292664610e-03f, 3.211445874e-03f,
                             1.414213562e-03f, 6.227723788e-04f, 2.742481884e-04f, 1.207697351e-04f, 5.318296098e-05f, 2.341999971e-05f, 1.031338616e-05f, 4.541670478e-06f};
      for (int idx = F.vcu * 512 + F.tid; idx < SEQ * 16; idx += F.G * 512) {
          const int row = idx >> 4, i = idx & 15; float inv = INV[0];
#pragma unroll
          for (int k = 1; k < 16; ++k) inv = (i == k) ? INV[k] : inv;
          const float angf = (float)pos[row] * inv; const double ang = (double)angf;
          const double qd = __builtin_rint(ang * 0.63661977236758134308); const int qi = (int)qd;
          double r = __builtin_fma(-qd, 1.57079632679489655800e+00, ang); r = __builtin_fma(-qd, 6.12323399573676603587e-17, r);
          const double r2 = r * r;
          double sp = -2.5052108385441718775e-08; sp = sp * r2 + 2.7557319223985890653e-06; sp = sp * r2 - 1.9841269841269841253e-04; sp = sp * r2 + 8.3333333333333332177e-03; sp = sp * r2 - 1.6666666666666665741e-01;
          const double sn = r + r * r2 * sp;
          double cp = 2.0876756987868098979e-09; cp = cp * r2 - 2.7557319223985888276e-07; cp = cp * r2 + 2.4801587301587301566e-05; cp = cp * r2 - 1.3888888888888889419e-03; cp = cp * r2 + 4.1666666666666664354e-02; cp = cp * r2 - 0.5;
          const double cn = 1.0 + r2 * cp;
          const int q4 = qi & 3;
          const double c = (q4 == 0) ? cn : (q4 == 1) ? -sn : (q4 == 2) ? -cn : sn;
          const double s = (q4 == 0) ? sn : (q4 == 1) ? cn : (q4 == 2) ? -sn : -cn;
          cs[(size_t)row * 32 + i] = (float)c; cs[(size_t)row * 32 + 16 + i] = (float)s; } }
    { const float* mem = (const float*)a.in[IN_MEM]; const float* gm = (const float*)a.in[IN_GMEM]; bf16* mb = (bf16*)(F.ws + WS_MEMB); float* rsm = (float*)(F.ws + WS_RSM);
      for (int m = gw; m < MEML; m += NGW) {
          const GAS f32x4* xr = (const GAS f32x4*)(mem + (size_t)m * DM) + F.lane; const GAS f32x4* gr = (const GAS f32x4*)gm + F.lane; GAS v2u* o8 = (GAS v2u*)(mb + (size_t)m * DM) + F.lane; float s = 0.f;
#pragma unroll 4
          for (int j = 0; j < 16; ++j) { const f32x4 v = xr[64 * j]; const f32x4 g = gr[64 * j]; s += (v[0] * v[0] + v[1] * v[1]) + (v[2] * v[2] + v[3] * v[3]);
              v2u w; w.x = cvt_pk_bf16(v[0] * g[0], v[1] * g[1]); w.y = cvt_pk_bf16(v[2] * g[2], v[3] * g[3]); o8[64 * j] = w; }
          s = wave_sum(s);
          if (F.lane == 0) rsm[m] = __builtin_amdgcn_rsqf(s * (1.0f / DM) + NORM_EPS); } }
}

__device__ __forceinline__ void norm_phase(const Frame& F0, const Args& a, int layer, bool skip8) {
    const Frame F = phase_frame(F0);
    bf16* proj = (bf16*)(F.ws + WS_PROJ); const float* cs = (const float*)(F.ws + WS_CS); float* ksum = (float*)(F.ws + WS_KSUM);
    const bool moba = (layer == 0);
    LAS float* red = (LAS float*)F.lds;
    const int l15 = F.lane & 15;
    const int first = skip8 ? 8 : 0;
    if (F.vcu >= first)
    for (int it = F.vcu - first; it < 128 * 14; it += F.G - first) {
        const int cg = it % 14, rb = it / 14;
        const bool is_q = cg < 6, is_k = cg >= 6 && cg < 12, is_m = cg >= 12;
        const int colbase = is_q ? 512 * cg : is_k ? SELF_W + 512 * (cg - 6) : 3 * SELF_W + 512 * (cg - 12);
        float g8[8];
        { const float* gp = is_q ? (const float*)a.in[IN_GQ] + layer * HD : (const float*)a.in[IN_GK] + layer * HD;
#pragma unroll
          for (int j = 0; j < 8; ++j) g8[j] = is_m ? 1.0f : gp[l15 * 8 + j]; }
        float ks8[8];
#pragma unroll
        for (int j = 0; j < 8; ++j) ks8[j] = 0.f;
        for (int i = 0; i < 8; ++i) {
            const int row = rb * 64 + F.wave * 8 + i;
            GAS v4u* p = (GAS v4u*)(proj + (size_t)row * PW + colbase + F.lane * 8);
            const v4u w = *p; float y[8];
            y[0] = bf_lo(w.x); y[1] = bf_hi(w.x); y[2] = bf_lo(w.y); y[3] = bf_hi(w.y); y[4] = bf_lo(w.z); y[5] = bf_hi(w.z); y[6] = bf_lo(w.w); y[7] = bf_hi(w.w);
            float s = 0.f;
#pragma unroll
            for (int j = 0; j < 8; ++j) s += y[j] * y[j];
            s += __shfl_xor(s, 1); s += __shfl_xor(s, 2); s += __shfl_xor(s, 4); s += __shfl_xor(s, 8);
            float rs;
            if (is_m) { s += __shfl_xor(s, 16); rs = __builtin_amdgcn_rsqf(s * (1.0f / 256.0f) + NORM_EPS); }
            else rs = __builtin_amdgcn_rsqf(s * (1.0f / 128.0f) + NORM_EPS);
#pragma unroll
            for (int j = 0; j < 8; ++j) y[j] = y[j] * rs * g8[j];
            if (!is_m) {
                const int ci = (l15 & 1) * 8;
                const f32x4 c0 = *(const f32x4*)(cs + (size_t)row * 32 + ci), c1 = *(const f32x4*)(cs + (size_t)row * 32 + ci + 4);
                const f32x4 s0 = *(const f32x4*)(cs + (size_t)row * 32 + 16 + ci), s1 = *(const f32x4*)(cs + (size_t)row * 32 + 16 + ci + 4);
                const float cc[8] = {c0[0], c0[1], c0[2], c0[3], c1[0], c1[1], c1[2], c1[3]}, sn[8] = {s0[0], s0[1], s0[2], s0[3], s1[0], s1[1], s1[2], s1[3]};
#pragma unroll
                for (int j = 0; j < 8; ++j) { const float other = __shfl_xor(y[j], 2);
                    const float r1 = y[j] * cc[j] - other * sn[j], r2 = y[j] * cc[j] + other * sn[j];
                    y[j] = (l15 < 2) ? r1 : (l15 < 4) ? r2 : y[j]; }
            }
            v4u o; o.x = cvt_pk_bf16(y[0], y[1]); o.y = cvt_pk_bf16(y[2], y[3]); o.z = cvt_pk_bf16(y[4], y[5]); o.w = cvt_pk_bf16(y[6], y[7]);
            *p = o;
#pragma unroll
            for (int j = 0; j < 8; ++j) ks8[j] += y[j];
        }
        if (moba && is_k) {
            __syncthreads();
#pragma unroll
            for (int j = 0; j < 8; ++j) red[F.wave * 512 + F.lane * 8 + j] = ks8[j];
            __syncthreads();
            float t = 0.f;
#pragma unroll
            for (int w = 0; w < 8; ++w) t += red[w * 512 + F.tid];
            const int head = 4 * (cg - 6) + (F.tid >> 7), dim = F.tid & 127, blk = rb >> 2, sub = rb & 3;
            ksum[((size_t)(head * NBLK + blk) * 4 + sub) * HD + dim] = t;
        }
    }
}
__device__ __forceinline__ void memprep_phase(const Frame& F0, const Args& a, int layer) {
    const Frame F = phase_frame(F0);
    { const float* mkv = (const float*)(F.ws + WS_MKV); bf16* kmn = (bf16*)(F.ws + WS_KMN); bf16* vt = (bf16*)(F.ws + WS_VT);
      const float* gk = (const float*)a.in[IN_GMK] + layer * 256; const float* gq = (const float*)a.in[IN_GMQ] + layer * 256;
      const int gw = F.vcu * NWAVES + F.wave, NGW = F.G * NWAVES;
      for (int t = gw; t < 4 * MEML; t += NGW) { const int h = t >> 8, key = t & 255;
          const f32x4 v = *(const f32x4*)(mkv + (size_t)key * 2048 + h * 256 + F.lane * 4);
          float s = (v[0] * v[0] + v[1] * v[1]) + (v[2] * v[2] + v[3] * v[3]); s = wave_sum(s);
          const float rs = __builtin_amdgcn_rsqf(s * (1.0f / 256.0f) + NORM_EPS);
          const f32x4 g1 = *(const f32x4*)(gk + F.lane * 4), g2 = *(const f32x4*)(gq + F.lane * 4);
          v2u o; o.x = cvt_pk_bf16(v[0] * rs * g1[0] * g2[0], v[1] * rs * g1[1] * g2[1]); o.y = cvt_pk_bf16(v[2] * rs * g1[2] * g2[2], v[3] * rs * g1[3] * g2[3]);
          *(v2u*)(kmn + (size_t)t * 256 + F.lane * 4) = o; }
      for (int idx = F.vcu * 512 + F.tid; idx < 4 * 256 * 256; idx += F.G * 512) { const int hd = idx >> 8, key = idx & 255;
          const float v = mkv[(size_t)key * 2048 + 1024 + hd]; vt[idx] = (bf16)(cvt_pk_bf16(v, 0.f) & 0xffffu); } }
}

__device__ __forceinline__ void gate_phase(const Frame& F0) {
    const Frame F = phase_frame(F0);
    const bf16* proj = (const bf16*)(F.ws + WS_PROJ); const float* ksum = (const float*)(F.ws + WS_KSUM); unsigned* sel = (unsigned*)(F.ws + WS_SEL);
    LAS float* km = (LAS float*)F.lds;
    for (int it = F.vcu; it < NHEAD * NBLK; it += F.G) {
        const int h = it / NBLK, b0 = it % NBLK;
        __syncthreads();
        for (int e = F.tid; e < b0 * HD; e += 512) { const int blk = e >> 7, dim = e & 127; const float* kp = ksum + ((size_t)(h * NBLK + blk) * 4) * HD + dim;
            km[e] = ((kp[0] + kp[HD]) + (kp[2 * HD] + kp[3 * HD])) * (1.0f / 256.0f); }
        __syncthreads();
        if (F.tid < 256) {
            const int row = b0 * 256 + F.tid;
            const v4u* qp = (const v4u*)(proj + (size_t)row * PW + h * HD);
            v4u q[16];
#pragma unroll
            for (int j = 0; j < 16; ++j) q[j] = qp[j];
            float v1 = -__builtin_inff(), v2 = v1, v3 = v1; int i1 = 32, i2 = 32, i3 = 32;
            for (int blk = 0; blk < b0; ++blk) {
                const LAS f32x4* kr = (const LAS f32x4*)(km + blk * HD); float g0 = 0.f, g1 = 0.f;
#pragma unroll
                for (int j = 0; j < 16; ++j) { const f32x4 ka = kr[2 * j], kb = kr[2 * j + 1];
                    g0 += bf_lo(q[j].x) * ka[0] + bf_hi(q[j].x) * ka[1] + bf_lo(q[j].y) * ka[2] + bf_hi(q[j].y) * ka[3];
                    g1 += bf_lo(q[j].z) * kb[0] + bf_hi(q[j].z) * kb[1] + bf_lo(q[j].w) * kb[2] + bf_hi(q[j].w) * kb[3]; }
                const float gt = g0 + g1;
                if (gt > v1) { v3 = v2; i3 = i2; v2 = v1; i2 = i1; v1 = gt; i1 = blk; }
                else if (gt > v2) { v3 = v2; i3 = i2; v2 = gt; i2 = blk; }
                else if (gt > v3) { v3 = gt; i3 = blk; }
            }
            unsigned m = 0u; if (i1 < 32) m |= 1u << i1; if (i2 < 32) m |= 1u << i2; if (i3 < 32) m |= 1u << i3;
            sel[(size_t)h * SEQ + row] = m;
        }
    }
    __syncthreads();
}

__device__ __forceinline__ att::BlockRef attn_ref(const Frame& F, int layer, int i) {
    const bf16* proj = (const bf16*)(F.ws + WS_PROJ); att::BlockRef r;
    if (layer == 0) {
        const int g = F.vcu >> 5, k = F.vcu & 31;
        const int head = 3 * g + i, qb = (i == 0) ? k : (i == 1) ? ((k + 16) & 31) : (k < 16 ? 31 - 2 * k : 62 - 2 * k);
        r.Q = proj + (size_t)(qb * 256) * PW + head * HD; r.K = proj + SELF_W + head * HD; r.V = proj + 2 * SELF_W + head * HD;
        r.O = (bf16*)(F.ws + WS_ATT) + (size_t)(qb * 256) * OPW + head * HD; r.sel = (const unsigned*)(F.ws + WS_SEL) + (size_t)head * SEQ + qb * 256; r.P0 = qb * 256;
    } else {
        const int item = F.vcu * 3 + (i >> 1), sp = item >> 4, pr = item & 15, qb = (i & 1) ? 31 - pr : pr;
        const int h = sp >> 2, c = (sp >> 1) & 1, e = sp & 1;
        r.Q = proj + (size_t)(qb * 256) * PW + (h * 2 + c) * HD; r.K = proj + SELF_W + (h * 2 + c) * HD; r.V = proj + 2 * SELF_W + h * 256 + e * HD;
        r.O = (bf16*)(F.ws + WS_OP) + (size_t)(qb * 256) * OPW + sp * HD; r.sel = nullptr; r.P0 = qb * 256;
    }
    return r;
}
__device__ __forceinline__ void attn_phase(const Frame& F0, int layer) {
    if (F0.G != 256) return;
    const Frame F = phase_frame(F0);
    char* lds = F.ldsg;
    const int nb = layer == 0 ? 3 : 6;
    att::Seam S;
    att::BlockRef cur = attn_ref(F, layer, 0);
    const int tid_ = F.tid;
    att::attn_prime(cur, lds, S, tid_);
    for (int i = 0; i < nb; ++i) {
        const att::BlockRef nxt = (i + 1 < nb) ? attn_ref(F, layer, i + 1) : cur;
        att::attn_block(cur, nxt, lds, S, tid_);
        cur = nxt;
    }
    VM_WAIT(); __builtin_amdgcn_s_waitcnt(0); __syncthreads();
}

__device__ __forceinline__ void diff_combine_phase(const Frame& F0, const Args& a) {
    const Frame F = phase_frame(F0);
    const bf16* op = (const bf16*)(F.ws + WS_OP); bf16* att_o = (bf16*)(F.ws + WS_ATT);
    float d1 = 0.f, d2 = 0.f;
    { const float* q1 = (const float*)a.in[IN_LQ1]; const float* k1 = (const float*)a.in[IN_LK1]; const float* q2 = (const float*)a.in[IN_LQ2]; const float* k2 = (const float*)a.in[IN_LK2];
      d1 = q1[F.lane] * k1[F.lane] + q1[F.lane + 64] * k1[F.lane + 64]; d2 = q2[F.lane] * k2[F.lane] + q2[F.lane + 64] * k2[F.lane + 64];
      d1 = wave_sum(d1); d2 = wave_sum(d2); }
    const float lam = __expf(d1) - __expf(d2) + LAM_INIT;
    const f32x4 gs = *(const f32x4*)((const float*)a.in[IN_GSUB] + F.lane * 4);
    const int gw = F.vcu * NWAVES + F.wave, NGW = F.G * NWAVES;
    for (int row = gw; row < SEQ; row += NGW) {
        for (int h = 0; h < 12; ++h) {
            const int e = F.lane >> 5, d = (F.lane & 31) * 4;
            const v2u w0 = *(const v2u*)(op + (size_t)row * OPW + ((h * 2 + 0) * 2 + e) * HD + d), w1 = *(const v2u*)(op + (size_t)row * OPW + ((h * 2 + 1) * 2 + e) * HD + d);
            float o[4] = {bf_lo(w0.x) - lam * bf_lo(w1.x), bf_hi(w0.x) - lam * bf_hi(w1.x), bf_lo(w0.y) - lam * bf_lo(w1.y), bf_hi(w0.y) - lam * bf_hi(w1.y)};
            float s = (o[0] * o[0] + o[1] * o[1]) + (o[2] * o[2] + o[3] * o[3]); s = wave_sum(s);
            const float rs = __builtin_amdgcn_rsqf(s * (1.0f / 256.0f) + SUBLN_EPS) * (1.0f - LAM_INIT);
            v2u r; r.x = cvt_pk_bf16(o[0] * rs * gs[0], o[1] * rs * gs[1]); r.y = cvt_pk_bf16(o[2] * rs * gs[2], o[3] * rs * gs[3]);
            *(v2u*)(att_o + (size_t)row * OPW + h * 256 + F.lane * 4) = r;
        }
    }
}

constexpr int N_PHASES = 1 + 2 * 8;
__global__ void __launch_bounds__(NWAVES * 64, 2) hybrid_fwd(Args args) {
    extern __shared__ __attribute__((aligned(16))) unsigned char lds[];
    Frame F;
    F.lds = (LAS unsigned char*)lds; F.ldsg = (char*)lds; F.ws = args.ws;
    F.tid = threadIdx.x; F.lane = F.tid & 63; F.wave = __builtin_amdgcn_readfirstlane(F.tid >> 6);
    F.G = gridDim.x; { const int bx = blockIdx.x; F.vcu = (F.G % 8 == 0) ? (bx % 8) * (F.G / 8) + bx / 8 : bx; }
    volatile LAS unsigned* MISC = (volatile LAS unsigned*)(F.lds + MISC_OFF);
    for (int u = F.tid; u < 64; u += NWAVES * 64) MISC[u] = 0u;
    __syncthreads();
    const int lo = args.ph_lo, hi = args.ph_hi;
    const bool one = (hi - lo) > 1;
    gu32* ctl = (gu32*)(args.ws + WS_CTL);
    XcdBarrier bar; bar.bar = (unsigned*)(ctl + CW_BAR); bar.x = 0; bar.st = nullptr;
    if (one) bar = xcd_barrier_post((unsigned*)(ctl + CW_BAR), MISC + 8);
#ifndef PH_MASK
#define PH_MASK 0xffff
#endif
#define IN(k) (lo <= (k) && (k) < hi)
#define EN(b) ((PH_MASK >> (b)) & 1)
#define SEAM0(k) do { if (IN(k) && IN((k) + 1)) { XcdBarrier b2_ = bar; size_t bz_ = 0; asm volatile("" : "+s"(bz_)); b2_.bar = bar.bar + bz_; xcd_barrier(b2_); } } while (0)
#define SEAM(k) do { if (IN(k) && IN((k) + 1)) { XcdBarrier b2_ = bar; size_t bz_ = 0; asm volatile("" : "+s"(bz_)); b2_.bar = bar.bar + bz_; xcd_barrier_slim(b2_); } } while (0)
    float* xout = args.out;
    PG8_LAS float* exch = (PG8_LAS float*)(F.lds + EXCH_OFF);
#define WSP(T, off) ((T*)(wsl + (off)))
#define WS_LOCAL() size_t wz_ = 0; asm volatile("" : "+s"(wz_)); unsigned char* wsl = args.ws + wz_

    if (EN(0) && IN(0)) { p0_prologue(F, args); }
    SEAM0(0);
#pragma unroll 1
    for (int l = 0; l < 2; ++l) {
        const int pb = 1 + 8 * l;
        if (EN(1) && IN(pb + 0)) {
            WS_LOCAL();
            pg8::Gemm g{WSP(bf16, WS_XB), WSP(const bf16, WS_WIN + l * SZ_WIN), SEQ, PW, DM, DM, DM, 0}; pg8::StaticOrder S; S.init(SEQ, PW, F.G, (int)blockIdx.x);
            pg8::EpiProj E{WSP(bf16, WS_PROJ), PW, WSP(float, WS_SSB), 1.0f / DM, NORM_EPS};
            pg8::gemm_phase<pg8::EpiProj, pg8::StaticOrder>(F.lds, g, S, E);
        }
        SEAM(pb + 0);
        if (EN(2) && IN(pb + 1)) {
            if (l == 0) {
                WS_LOCAL();
                pg8::Gemm g{WSP(bf16, WS_MEMB), WSP(const bf16, WS_WMK), MEML, 2 * MEM_W, DM, DM, DM, 0}; pg8::StaticOrder S; S.init(MEML, 2 * MEM_W, F.G, F.vcu);
                pg8::EpiMKV E{WSP(float, WS_MKV), 2 * MEM_W, WSP(const float, WS_RSM)};
                pg8::gemm_phase<pg8::EpiMKV, pg8::StaticOrder>(F.lds, g, S, E);
                __syncthreads();
            }
            norm_phase(F, args, l, l == 0 && F.G > 16);
        }
        SEAM(pb + 1);
        if (EN(3) && IN(pb + 2)) { memprep_phase(F, args, l); if (l == 0) gate_phase(F); }
        SEAM(pb + 2);
        if (IN(pb + 3)) {
            if (EN(4)) { WS_LOCAL();
              pg8::Gemm g{WSP(bf16, WS_PROJ) + 3 * SELF_W, WSP(const bf16, WS_KMN), SEQ, MEM_W, 256, PW, 256, 256}; pg8::StaticOrder S; S.init(SEQ, MEM_W, F.G, (int)blockIdx.x);
              pg8::EpiMemS E{WSP(bf16, WS_PM), WSP(float, WS_PS)};
              pg8::gemm_phase<pg8::EpiMemS, pg8::StaticOrder>(F.lds, g, S, E); }
            __syncthreads();
            if (EN(5)) attn_phase(F, l);
        }
        SEAM(pb + 3);
        if (IN(pb + 4)) {
            if (EN(6)) { WS_LOCAL();
              pg8::Gemm g{WSP(bf16, WS_PM), WSP(const bf16, WS_VT), SEQ, MEM_W, 256, MEM_W, 256, 256}; pg8::StaticOrder S; S.init(SEQ, MEM_W, F.G, (int)blockIdx.x);
              pg8::EpiMemO E{WSP(bf16, WS_ATT), WSP(float, WS_PS)};
              pg8::gemm_phase<pg8::EpiMemO, pg8::StaticOrder>(F.lds, g, S, E); }
            if (EN(7) && l == 1) diff_combine_phase(F, args);
        }
        SEAM(pb + 4);
        if (EN(8) && IN(pb + 5)) {
            WS_LOCAL();
            pg8::Gemm g{WSP(bf16, WS_ATT), WSP(const bf16, WS_WOUT + l * SZ_WOUT), SEQ, DM, DM, OPW, DM, 0}; pg8::StaticOrder S; S.init(SEQ, DM, F.G, (int)blockIdx.x);
            pg8::EpiRes<true> E{l == 0 ? (const float*)args.in[IN_X] : xout, xout, WSP(bf16, WS_XB), WSP(float, WS_SSA), DM, exch};
            pg8::gemm_phase<pg8::EpiRes<true>, pg8::StaticOrder>(F.lds, g, S, E);
        }
        SEAM(pb + 5);
        if (EN(9) && IN(pb + 6)) {
            WS_LOCAL();
            pg8::Gemm g{WSP(bf16, WS_XB), WSP(const bf16, WS_WGU + l * SZ_WGU), SEQ, NGU, DM, DM, DM, 0}; pg8::StaticOrder S; S.init(SEQ, NGU, F.G, (int)blockIdx.x);
            pg8::EpiGU E{WSP(bf16, WS_HID), DFF, WSP(float, WS_SSA), 1.0f / DM, NORM_EPS};
            pg8::gemm_phase<pg8::EpiGU, pg8::StaticOrder>(F.lds, g, S, E);
        }
        SEAM(pb + 6);
        if (EN(10) && IN(pb + 7)) {
            WS_LOCAL();
            pg8::Gemm g{WSP(bf16, WS_HID), WSP(const bf16, WS_WDN + l * SZ_WDN), SEQ, DM, DFF, DFF, DFF, 0}; pg8::StaticOrder S; S.init(SEQ, DM, F.G, (int)blockIdx.x);
            pg8::EpiRes<true> E{xout, xout, WSP(bf16, WS_XB), WSP(float, WS_SSB), DM, exch};
            pg8::gemm_phase<pg8::EpiRes<true>, pg8::StaticOrder>(F.lds, g, S, E);
        }
        SEAM(pb + 7);
    }
#undef IN
#undef SEAM
#undef SEAM0
}

extern "C" void kernel_launch(void* const* d_in, const int* in_sizes, int n_in, void* d_out, int out_size, void* d_ws, size_t ws_size, hipStream_t stream) {
    static int grid = 0;
    if (grid == 0) {
        if (n_in != N_IN || in_sizes[0] != SEQ * DM || out_size != SEQ * DM || ws_size < WS_END) {
            fprintf(stderr, "kernel_launch: unexpected shapes (n_in %d, in0 %d, out %d, ws %zu < %zu); nothing launched\n", n_in, n_in > 0 ? in_sizes[0] : -1, out_size, ws_size, (size_t)WS_END); grid = -1; return; }
        int dev = 0, cus = 0, per_cu = 0;
        if (hipGetDevice(&dev) != hipSuccess || hipDeviceGetAttribute(&cus, hipDeviceAttributeMultiprocessorCount, dev) != hipSuccess) { grid = -1; return; }
        if (hipFuncSetAttribute((const void*)hybrid_fwd, hipFuncAttributeMaxDynamicSharedMemorySize, LDS_BYTES) != hipSuccess) { fprintf(stderr, "kernel_launch: hipFuncSetAttribute failed\n"); grid = -1; return; }
        if (hipOccupancyMaxActiveBlocksPerMultiprocessor(&per_cu, (const void*)hybrid_fwd, NWAVES * 64, LDS_BYTES) != hipSuccess || per_cu < 1)
            fprintf(stderr, "kernel_launch: note: occupancy query reports %d workgroups per CU\n", per_cu);
        (void)hipGetLastError();
        grid = cus;
        if (grid != 256) fprintf(stderr, "kernel_launch: %d CUs; the attention phase is dealt for 256\n", grid);
    }
    if (grid < 0) return;
    if (hipMemsetAsync((char*)d_ws + WS_CTL, 0, CTL_ZERO_BYTES, stream) != hipSuccess) return;
    Args a{};
    for (int i = 0; i < N_IN; ++i) a.in[i] = d_in[i];
    a.out = (float*)d_out; a.ws = (unsigned char*)d_ws;
#if MK_ONE_LAUNCH
    a.ph_lo = 0; a.ph_hi = N_PHASES;
    hipLaunchKernelGGL(hybrid_fwd, dim3(grid), dim3(NWAVES * 64), LDS_BYTES, stream, a);
#else
    for (int p = 0; p < N_PHASES; ++p) {
        if (p == 1 + 8 + 2) continue;
        a.ph_lo = p; a.ph_hi = p + 1;
        hipLaunchKernelGGL(hybrid_fwd, dim3(grid), dim3(NWAVES * 64), LDS_BYTES, stream, a);
    }
#endif
}
```

```cpp
#include <hip/hip_runtime.h>
#include <cstdio>
#include <cstdint>

#ifndef MK_ONE_LAUNCH
#define MK_ONE_LAUNCH 1
#endif

constexpr int SEQ = 8192, DM = 4096, PW = 10240, SELF_W = 3072, MEM_W = 1024, DFF = 11008, NGU = 2 * DFF, MEML = 256, HD = 128;
constexpr int NHEAD = 24;
constexpr int NBLK = SEQ / 256;
constexpr int OPW = 48 * HD;
constexpr float NORM_EPS = 1e-6f, SUBLN_EPS = 1e-5f;
constexpr float LAM_INIT = 0.35550906759096934f;

enum { IN_X = 0, IN_MEM, IN_POS, IN_GATTN, IN_WIN, IN_WOUT, IN_GQ, IN_GK, IN_GMQ, IN_GMK, IN_GMEM, IN_WMEMKV, IN_LQ1, IN_LK1, IN_LQ2, IN_LK2, IN_GSUB, IN_GFFN, IN_WGATE, IN_WUP, IN_WDOWN, N_IN };

constexpr size_t MiB = 1u << 20;
constexpr size_t SZ_WIN = (size_t)PW * DM * 2, SZ_WOUT = (size_t)DM * DM * 2, SZ_WGU = (size_t)NGU * DM * 2, SZ_WDN = (size_t)DM * DFF * 2;
constexpr size_t WS_CTL = 0, CTL_ZERO_BYTES = 64 * 1024;
constexpr size_t WS_WIN = 1 * MiB;
constexpr size_t WS_WOUT = WS_WIN + 2 * SZ_WIN;
constexpr size_t WS_WGU = WS_WOUT + 2 * SZ_WOUT;
constexpr size_t WS_WDN = WS_WGU + 2 * SZ_WGU;
constexpr size_t WS_XB = WS_WDN + 2 * SZ_WDN;
constexpr size_t WS_PROJ = WS_XB + (size_t)SEQ * DM * 2;
constexpr size_t WS_ATT = WS_PROJ + (size_t)SEQ * PW * 2;
constexpr size_t WS_HID = WS_ATT + (size_t)SEQ * OPW * 2;
constexpr size_t WS_OP = WS_HID + (size_t)SEQ * DFF * 2;
constexpr size_t WS_PM = WS_OP + (size_t)SEQ * OPW * 2;
constexpr size_t WS_SSA = WS_PM + (size_t)SEQ * MEM_W * 2;
constexpr size_t WS_SSB = WS_SSA + 1 * MiB;
constexpr size_t WS_CS = WS_SSB + 1 * MiB;
constexpr size_t WS_MKV = WS_CS + 1 * MiB;
constexpr size_t WS_KMN = WS_MKV + 2 * MiB;
constexpr size_t WS_VT = WS_KMN + 1 * MiB;
constexpr size_t WS_KSUM = WS_VT + 1 * MiB;
constexpr size_t WS_SEG = WS_KSUM + 2 * MiB;
constexpr size_t WS_CNT = WS_SEG + (size_t)NHEAD * 32 * 32 * 256 * 2;
constexpr size_t WS_FLAT = WS_CNT + 1 * MiB;
constexpr size_t WS_RJ = WS_FLAT + (size_t)NHEAD * 31 * 8192 * 2;
constexpr size_t WS_PARTO = WS_RJ + 1 * MiB;
constexpr size_t WS_PARTML = WS_PARTO + (size_t)NHEAD * SEQ * 4 * HD * 2;
constexpr size_t WS_PS = WS_PARTML + (size_t)NHEAD * SEQ * 4 * 2 * 4;
constexpr size_t WS_WMK = WS_PS + 1 * MiB;
constexpr size_t WS_MEMB = WS_WMK + (size_t)2 * MEM_W * DM * 2;
constexpr size_t WS_RSM = WS_MEMB + (size_t)MEML * DM * 2;
constexpr size_t WS_END = WS_RSM + 1 * MiB;
constexpr int CW_TMO = 0, CW_GATEQ = 64, CW_BAR = 4096;

constexpr int RING_BYTES = 131072;
constexpr int EXCH_OFF = RING_BYTES;
constexpr int MISC_OFF = EXCH_OFF + 8192;
constexpr int LDS_BYTES = 147456;
static_assert(MISC_OFF + 256 + 2048 <= LDS_BYTES, "LDS map");

#define GAS __attribute__((address_space(1)))
#define LAS __attribute__((address_space(3)))
typedef unsigned short bf16;
typedef unsigned v4u __attribute__((ext_vector_type(4)));
typedef unsigned v2u __attribute__((ext_vector_type(2)));
typedef float f32x4 __attribute__((ext_vector_type(4)));
typedef float f32x2 __attribute__((ext_vector_type(2)));
typedef float f32x16 __attribute__((ext_vector_type(16)));
typedef short bf16x8 __attribute__((ext_vector_type(8)));
typedef short s16x4 __attribute__((ext_vector_type(4)));
typedef GAS unsigned gu32;
#define RLX_AGENT __ATOMIC_RELAXED, __HIP_MEMORY_SCOPE_AGENT
#define LDS_WAIT() asm volatile("s_waitcnt lgkmcnt(0)" ::: "memory")
#define VM_WAIT() asm volatile("s_waitcnt vmcnt(0)" ::: "memory")

__device__ __forceinline__ unsigned cvt_pk_bf16(float lo, float hi) { unsigned r; asm volatile("v_cvt_pk_bf16_f32 %0, %1, %2" : "=v"(r) : "v"(lo), "v"(hi)); return r; }
__device__ __forceinline__ float bf_lo(unsigned w) { return __uint_as_float(w << 16); }
__device__ __forceinline__ float bf_hi(unsigned w) { return __uint_as_float(w & 0xffff0000u); }
__device__ __forceinline__ float wave_sum(float v) {
#pragma unroll
    for (int o = 1; o < 64; o <<= 1) v += __shfl_xor(v, o);
    return v;
}

namespace pg8 {
#define PG8_LAS __attribute__((address_space(3)))
typedef unsigned short bf16_t;
typedef unsigned u32x4 __attribute__((ext_vector_type(4)));
constexpr int BM = 256, BK = 64, HALF = 128, HTB = HALF * BK * 2, STAGE_BYTES = 8 * HTB, NXCD = 8, WGM = 8;

__host__ __device__ __forceinline__ int lds_byte(int r, int c) { const int st = (r >> 4) * 2 + (c >> 5), rr = r & 15, cc = c & 31, ob = rr * 64 + cc * 2; return st * 1024 + (ob ^ (((ob >> 9) & 1) << 5)); }
__host__ __device__ __forceinline__ void stage_rc(int b, int& R, int& C) { const int st = b / 1024, sb = b % 1024, swz = sb ^ (((sb >> 9) & 1) << 5); R = (st >> 1) * 16 + swz / 64; C = (st & 1) * 32 + (swz % 64) / 2; }
__host__ __device__ __forceinline__ int perm32(int rho) { const int n = rho >> 4, i = rho & 15; return 8 * (i >> 2) + 4 * n + (i & 3); }

struct Unit { int pm, pn; };
struct Gemm { const bf16_t* A; const bf16_t* Bt; int M, N, K, lda, ldb, a_pn_step, b_oct; };

struct StaticOrder {
    int nM, nN, nwg, G, c;
    __host__ __device__ void init(int M, int N, int G_, int c_) { nM = M / BM; nN = N / BM; nwg = nM * nN; G = G_; c = c_; }
    __host__ __device__ bool next(int i, Unit& u) const {
        const long L = (long)i * G + c; if (L >= nwg) return false;
        int wgid = (int)L; { const int q = nwg / NXCD, r = nwg % NXCD, xcd = wgid % NXCD, off = wgid / NXCD; wgid = (xcd < r ? xcd * (q + 1) : r * (q + 1) + (xcd - r) * q) + off; }
        const int nig = WGM * nN, gid = wgid / nig, fm = gid * WGM, gsz = (nM - fm) < WGM ? (nM - fm) : WGM;
        u.pm = fm + ((wgid % nig) % gsz); u.pn = (wgid % nig) / gsz; return true;
    }
    __device__ __forceinline__ void a_ready(const Unit&) const {}
    __device__ __forceinline__ void done(const Unit&) const {}
};

__device__ __forceinline__ float row_rstd(const float* ss, int row, float inv_d, float eps) {
    const f32x4* sp = (const f32x4*)(ss + (size_t)row * 16);
    const f32x4 a = sp[0], b = sp[1], c = sp[2], d = sp[3];
    const float t = ((a[0] + a[1]) + (a[2] + a[3])) + ((b[0] + b[1]) + (b[2] + b[3])) + ((c[0] + c[1]) + (c[2] + c[3])) + ((d[0] + d[1]) + (d[2] + d[3]));
    return __builtin_amdgcn_rsqf(t * inv_d + eps);
}
struct EpiProj {
    static constexpr bool PERM = true, AFTER_DRAIN = false, BOCT = false, AOCT = false;
    bf16_t* O; int ldc; const float* ss; float inv_d, eps;
    __device__ __forceinline__ void operator()(const f32x4 (&acc)[2][2][4][2], const Unit& u, int wr, int wc, int fr, int fq) const {
        const int row0 = u.pm * BM + wr * 64 + fr, col0 = u.pn * BM + wc * 32 + 8 * fq;
#pragma unroll
        for (int ai = 0; ai < 2; ++ai)
#pragma unroll
            for (int m = 0; m < 4; ++m) { const int row = row0 + ai * HALF + m * 16; const float rs = row_rstd(ss, row, inv_d, eps);
                bf16_t* rowp = O + (size_t)row * ldc + col0;
#pragma unroll
                for (int bj = 0; bj < 2; ++bj) { const f32x4 v0 = acc[ai][bj][m][0] * rs, v1 = acc[ai][bj][m][1] * rs;
                    u32x4 w; w.x = cvt_pk_bf16(v0[0], v0[1]); w.y = cvt_pk_bf16(v0[2], v0[3]); w.z = cvt_pk_bf16(v1[0], v1[1]); w.w = cvt_pk_bf16(v1[2], v1[3]);
                    *(u32x4*)(rowp + bj * HALF) = w; } }
    }
};
struct EpiProjN {
    static constexpr bool PERM = true, AFTER_DRAIN = false, BOCT = true, AOCT = true;
    bf16_t* O; int ldc; const float* ss; float inv_d, eps; PG8_LAS float* exch; PG8_LAS float* tab; const float* gq; const float* gk; const int* pos; float* ksum;
    static __device__ __forceinline__ float shx(float x, int lane_, int mask) { return __builtin_bit_cast(float, __builtin_amdgcn_ds_bpermute((lane_ ^ mask) << 2, __builtin_bit_cast(int, x))); }
    __device__ __forceinline__ void operator()(const f32x4 (&acc)[2][2][4][2], const Unit& u, int wr, int wc, int fr_in, int fq_in) const {
        int fr = fr_in, fq = fq_in; asm volatile("" : "+v"(fr), "+v"(fq));
        const int lane_ = fr + 16 * fq;
        const int row0 = u.pm * BM + wr * 64 + fr, col0 = u.pn * BM + wc * 32 + 8 * fq;
        char* Ob = (char*)O; const unsigned off0 = (unsigned)(row0 * PW + col0) * 2u;
        const int typ = u.pn < 12 ? 0 : u.pn < 24 ? 1 : u.pn < 36 ? 2 : 3;
        if (typ == 2) {
#pragma unroll
            for (int ai = 0; ai < 2; ++ai)
#pragma unroll
                for (int m = 0; m < 4; ++m) { const int row = row0 + ai * HALF + m * 16; const float rs = row_rstd(ss, row, inv_d, eps);
#pragma unroll
                    for (int bj = 0; bj < 2; ++bj) { const f32x4 v0 = acc[ai][bj][m][0] * rs, v1 = acc[ai][bj][m][1] * rs;
                        u32x4 w; w.x = cvt_pk_bf16(v0[0], v0[1]); w.y = cvt_pk_bf16(v0[2], v0[3]); w.z = cvt_pk_bf16(v1[0], v1[1]); w.w = cvt_pk_bf16(v1[2], v1[3]);
                        *(u32x4*)(Ob + (off0 + (unsigned)(((ai * HALF + m * 16) * PW + bj * HALF) * 2))) = w; } }
            return;
        }
#pragma unroll
        for (int ai = 0; ai < 2; ++ai)
#pragma unroll
            for (int m = 0; m < 4; ++m)
#pragma unroll
                for (int bj = 0; bj < 2; ++bj) { const f32x4 v0 = acc[ai][bj][m][0], v1 = acc[ai][bj][m][1];
                    float q = (v0[0] * v0[0] + v0[1] * v0[1]) + (v0[2] * v0[2] + v0[3] * v0[3]) + (v1[0] * v1[0] + v1[1] * v1[1]) + (v1[2] * v1[2] + v1[3] * v1[3]);
                    q += shx(q, lane_, 16); q += shx(q, lane_, 32);
                    if (fq == 0) exch[((ai * HALF + wr * 64 + m * 16 + fr) * 2 + bj) * 4 + wc] = q; }
        { const int t = (wr * 4 + wc) * 64 + fq * 16 + fr;
          if (t < 256) { tab[t] = row_rstd(ss, u.pm * BM + t, inv_d, eps); tab[256 + t] = __int_as_float(pos[u.pm * BM + t]); } }
        asm volatile("s_waitcnt lgkmcnt(0)" ::: "memory"); __builtin_amdgcn_s_barrier(); asm volatile("" ::: "memory");
        f32x4 g0 = {1.f, 1.f, 1.f, 1.f}, g1 = g0;
        if (typ < 2) { const float* gp = (typ == 0 ? gq : gk) + wc * 32 + 8 * fq; g0 = *(const f32x4*)gp; g1 = *(const f32x4*)(gp + 4); }
        if (typ == 0 && ksum == nullptr) { constexpr float QS = 0.08838834764831845f * 1.4426950408889634f; g0 = g0 * QS; g1 = g1 * QS; }
        const bool hi8 = (fq & 1) != 0;
        float ks[2][8];
#pragma unroll
        for (int bj = 0; bj < 2; ++bj)
#pragma unroll
            for (int k = 0; k < 8; ++k) ks[bj][k] = 0.f;
#pragma unroll
        for (int ai = 0; ai < 2; ++ai)
#pragma unroll
            for (int m = 0; m < 4; ++m) { const int rl = ai * HALF + wr * 64 + m * 16 + fr;
                const f32x4 pa = *(const PG8_LAS f32x4*)(exch + (rl * 2 + 0) * 4), pb = *(const PG8_LAS f32x4*)(exch + (rl * 2 + 1) * 4);
                const float rs = tab[rl], rs2 = rs * rs; const float pf = (float)__float_as_int(tab[256 + rl]);
                float sa = ((pa[0] + pa[1]) + (pa[2] + pa[3])) * rs2, sb = ((pb[0] + pb[1]) + (pb[2] + pb[3])) * rs2;
                if (typ == 3) { sa = sb = (sa + sb) * 0.5f; }
#pragma unroll
                for (int bj = 0; bj < 2; ++bj) {
                    const float sc = rs * __builtin_amdgcn_rsqf((bj == 0 ? sa : sb) * (1.0f / 128.0f) + eps); const f32x4 v0 = acc[ai][bj][m][0] * sc * g0, v1 = acc[ai][bj][m][1] * sc * g1;
                    float y[8] = {v0[0], v0[1], v0[2], v0[3], v1[0], v1[1], v1[2], v1[3]};
                    if (typ < 2 && wc == 0) {
#pragma unroll
                        for (int k = 0; k < 8; ++k) { constexpr float IVL[8] = {1.000000000e+00f, 4.403665960e-01f, 1.939227432e-01f, 8.539710194e-02f, 3.760603070e-02f, 1.656043902e-02f, 7.292664610e-03f, 3.211445874e-03f};
                            constexpr float IVH[8] = {1.414213562e-03f, 6.227723788e-04f, 2.742481884e-04f, 1.207697351e-04f, 5.318296098e-05f, 2.341999971e-05f, 1.031338616e-05f, 4.541670478e-06f};
                            const float ang = pf * (hi8 ? IVH[k] : IVL[k]); float rv = ang * 0.15915494309189535f; rv = rv - __builtin_floorf(rv);
                            const float sn = __builtin_amdgcn_sinf(rv), cn = __builtin_amdgcn_cosf(rv);
                            const float other = shx(y[k], lane_, 32);
                            y[k] = (fq < 2) ? y[k] * cn - other * sn : y[k] * cn + other * sn; } }
#pragma unroll
                    for (int k = 0; k < 8; ++k) ks[bj][k] += y[k];
                    u32x4 w; w.x = cvt_pk_bf16(y[0], y[1]); w.y = cvt_pk_bf16(y[2], y[3]); w.z = cvt_pk_bf16(y[4], y[5]); w.w = cvt_pk_bf16(y[6], y[7]);
                    *(u32x4*)(Ob + (off0 + (unsigned)(((ai * HALF + m * 16) * PW + bj * HALF) * 2))) = w;
                    asm volatile("" : "+v"(ks[bj][0]), "+v"(ks[bj][1]), "+v"(ks[bj][2]), "+v"(ks[bj][3]), "+v"(ks[bj][4]), "+v"(ks[bj][5]), "+v"(ks[bj][6]), "+v"(ks[bj][7]) :: "memory"); } }
        if (typ == 1 && ksum != nullptr) {
#pragma unroll
            for (int bj = 0; bj < 2; ++bj)
#pragma unroll
                for (int k = 0; k < 8; ++k) { float t = ks[bj][k]; t += shx(t, lane_, 1); t += shx(t, lane_, 2); t += shx(t, lane_, 4); t += shx(t, lane_, 8); ks[bj][k] = t; }
            if (fr == 0) {
#pragma unroll
                for (int bj = 0; bj < 2; ++bj) { float* kp = ksum + ((size_t)((2 * (u.pn - 12) + bj) * 32 + u.pm) * 2 + wr) * 128 + wc * 32 + 8 * fq;
                    *(f32x4*)kp = (f32x4){ks[bj][0], ks[bj][1], ks[bj][2], ks[bj][3]}; *(f32x4*)(kp + 4) = (f32x4){ks[bj][4], ks[bj][5], ks[bj][6], ks[bj][7]}; } }
        }
    }
};
__device__ __forceinline__ float silu_mul(float g, float u) { const float e = __builtin_amdgcn_exp2f(-1.4426950408889634f * g); return g * __builtin_amdgcn_rcpf(1.0f + e) * u; }
struct EpiGU {
    static constexpr bool PERM = true, AFTER_DRAIN = false, BOCT = true, AOCT = true;
    bf16_t* O; int ldc; const float* ss; float inv_d, eps; PG8_LAS float* tab;
    __device__ __forceinline__ void operator()(const f32x4 (&acc)[2][2][4][2], const Unit& u, int wr, int wc, int fr_in, int fq_in) const {
        int fr = fr_in, fq = fq_in; asm volatile("" : "+v"(fr), "+v"(fq));
        { const int t = (wr * 4 + wc) * 64 + fq * 16 + fr; if (t < 256) tab[t] = row_rstd(ss, u.pm * BM + t, inv_d, eps); }
        asm volatile("s_waitcnt lgkmcnt(0)" ::: "memory"); __builtin_amdgcn_s_barrier(); asm volatile("" ::: "memory");
        char* Ob = (char*)O; const unsigned off0 = (unsigned)(((u.pn * HALF + wc * 32 + 8 * fq) >> 3) * SEQ + u.pm * BM + wr * 64 + fr) * 16u;
#pragma unroll
        for (int ai = 0; ai < 2; ++ai)
#pragma unroll
            for (int m = 0; m < 4; ++m) { const float rs = tab[ai * HALF + wr * 64 + m * 16 + fr];
                const f32x4 g0 = acc[ai][0][m][0] * rs, g1 = acc[ai][0][m][1] * rs, u0 = acc[ai][1][m][0] * rs, u1 = acc[ai][1][m][1] * rs;
                u32x4 w; w.x = cvt_pk_bf16(silu_mul(g0[0], u0[0]), silu_mul(g0[1], u0[1])); w.y = cvt_pk_bf16(silu_mul(g0[2], u0[2]), silu_mul(g0[3], u0[3]));
                w.z = cvt_pk_bf16(silu_mul(g1[0], u1[0]), silu_mul(g1[1], u1[1])); w.w = cvt_pk_bf16(silu_mul(g1[2], u1[2]), silu_mul(g1[3], u1[3]));
                *(u32x4*)(Ob + (off0 + (unsigned)((ai * HALF + m * 16) * 16))) = w; }
    }
};
template <bool AOCT_> struct EpiRes {
    static constexpr bool PERM = true, AFTER_DRAIN = false, BOCT = true, AOCT = AOCT_;
    const float* base32; float* out32; bf16_t* xb; float* ss; int ldc; PG8_LAS float* exch;
    __device__ __forceinline__ void operator()(const f32x4 (&acc)[2][2][4][2], const Unit& u, int wr, int wc, int fr, int fq) const {
        const int row0 = u.pm * BM + wr * 64 + fr, col0 = u.pn * BM + wc * 32 + 8 * fq;
        const bool fin = out32 != nullptr;
#pragma unroll
        for (int ai = 0; ai < 2; ++ai)
#pragma unroll
            for (int m = 0; m < 4; ++m) { const int row = row0 + ai * HALF + m * 16; const size_t off = (size_t)row * ldc + col0; float q = 0.f;
#pragma unroll
                for (int bj = 0; bj < 2; ++bj) { char* xp = (char*)xb + ((size_t)((col0 + bj * HALF) >> 3) * SEQ + row) * 16;
                    const u32x4 r = *(const u32x4*)xp;
                    const f32x4 b0 = (f32x4){bf_lo(r.x), bf_hi(r.x), bf_lo(r.y), bf_hi(r.y)}, b1 = (f32x4){bf_lo(r.z), bf_hi(r.z), bf_lo(r.w), bf_hi(r.w)};
                    const f32x4 o0 = b0 + acc[ai][bj][m][0], o1 = b1 + acc[ai][bj][m][1];
                    if (fin) { *(f32x4*)(out32 + off + bj * HALF) = o0; *(f32x4*)(out32 + off + bj * HALF + 4) = o1; }
                    else { q += (o0[0] * o0[0] + o0[1] * o0[1]) + (o0[2] * o0[2] + o0[3] * o0[3]) + (o1[0] * o1[0] + o1[1] * o1[1]) + (o1[2] * o1[2] + o1[3] * o1[3]);
                        u32x4 w; w.x = cvt_pk_bf16(o0[0], o0[1]); w.y = cvt_pk_bf16(o0[2], o0[3]); w.z = cvt_pk_bf16(o1[0], o1[1]); w.w = cvt_pk_bf16(o1[2], o1[3]);
                        *(u32x4*)xp = w; } }
                if (!fin) { q += __shfl_xor(q, 16); q += __shfl_xor(q, 32); if (fq == 0) exch[(ai * HALF + wr * 64 + m * 16 + fr) * 4 + wc] = q; }
                asm volatile("" ::: "memory"); }
        if (!fin) {
            asm volatile("s_waitcnt lgkmcnt(0)" ::: "memory"); __builtin_amdgcn_s_barrier(); asm volatile("" ::: "memory");
            const int t = (wr * 4 + wc) * 64 + fq * 16 + fr;
            if (t < 256) { const f32x4 p = *(const PG8_LAS f32x4*)(exch + t * 4); ss[(size_t)(u.pm * BM + t) * 16 + u.pn] = (p[0] + p[1]) + (p[2] + p[3]); }
        }
    }
};
struct EpiMKV {
    static constexpr bool PERM = true, AFTER_DRAIN = false, BOCT = false, AOCT = false;
    float* O; int ldc; const float* rs;
    __device__ __forceinline__ void operator()(const f32x4 (&acc)[2][2][4][2], const Unit& u, int wr, int wc, int fr, int fq) const {
        const int row0 = u.pm * BM + wr * 64 + fr, col0 = u.pn * BM + wc * 32 + 8 * fq;
#pragma unroll
        for (int ai = 0; ai < 2; ++ai)
#pragma unroll
            for (int m = 0; m < 4; ++m) { const int row = row0 + ai * HALF + m * 16; const float r = rs[row]; float* rowp = O + (size_t)row * ldc + col0;
#pragma unroll
                for (int bj = 0; bj < 2; ++bj) { *(f32x4*)(rowp + bj * HALF) = acc[ai][bj][m][0] * r; *(f32x4*)(rowp + bj * HALF + 4) = acc[ai][bj][m][1] * r; } }
    }
};
struct EpiMemS {
    static constexpr bool PERM = true, AFTER_DRAIN = false, BOCT = false, AOCT = false;
    bf16_t* P; float* ps;
    __device__ __forceinline__ void operator()(const f32x4 (&acc)[2][2][4][2], const Unit& u, int wr, int wc, int fr, int fq) const {
        const int row0 = u.pm * BM + wr * 64 + fr, col0 = u.pn * BM + wc * 32 + 8 * fq; constexpr float C = 0.0625f * 1.4426950408889634f;
#pragma unroll
        for (int ai = 0; ai < 2; ++ai)
#pragma unroll
            for (int m = 0; m < 4; ++m) { const int row = row0 + ai * HALF + m * 16;
#pragma unroll
                for (int bj = 0; bj < 2; ++bj) { const f32x4 a0 = acc[ai][bj][m][0], a1 = acc[ai][bj][m][1];
                    u32x4 w; w.x = cvt_pk_bf16(__builtin_amdgcn_exp2f(a0[0] * C), __builtin_amdgcn_exp2f(a0[1] * C)); w.y = cvt_pk_bf16(__builtin_amdgcn_exp2f(a0[2] * C), __builtin_amdgcn_exp2f(a0[3] * C));
                    w.z = cvt_pk_bf16(__builtin_amdgcn_exp2f(a1[0] * C), __builtin_amdgcn_exp2f(a1[1] * C)); w.w = cvt_pk_bf16(__builtin_amdgcn_exp2f(a1[2] * C), __builtin_amdgcn_exp2f(a1[3] * C));
                    *(u32x4*)(P + (size_t)row * MEM_W + col0 + bj * HALF) = w;
                    float q = ((bf_lo(w.x) + bf_hi(w.x)) + (bf_lo(w.y) + bf_hi(w.y))) + ((bf_lo(w.z) + bf_hi(w.z)) + (bf_lo(w.w) + bf_hi(w.w)));
                    q += __shfl_xor(q, 16); q += __shfl_xor(q, 32);
                    if (fq == 0) ps[((size_t)row * 4 + u.pn) * 8 + bj * 4 + wc] = q; } }
    }
};
struct EpiMemO {
    static constexpr bool PERM = true, AFTER_DRAIN = false, BOCT = false, AOCT = false;
    bf16_t* O; const float* ps;
    __device__ __forceinline__ void operator()(const f32x4 (&acc)[2][2][4][2], const Unit& u, int wr, int wc, int fr, int fq) const {
        const int row0 = u.pm * BM + wr * 64 + fr, col0 = SELF_W + u.pn * BM + wc * 32 + 8 * fq;
#pragma unroll
        for (int ai = 0; ai < 2; ++ai)
#pragma unroll
            for (int m = 0; m < 4; ++m) { const int row = row0 + ai * HALF + m * 16;
                const f32x4* lp = (const f32x4*)(ps + ((size_t)row * 4 + u.pn) * 8); const f32x4 la = lp[0], lb = lp[1];
                const float rl = 1.0f / (((la[0] + la[1]) + (la[2] + la[3])) + ((lb[0] + lb[1]) + (lb[2] + lb[3])));
#pragma unroll
                for (int bj = 0; bj < 2; ++bj) { const f32x4 v0 = acc[ai][bj][m][0] * rl, v1 = acc[ai][bj][m][1] * rl;
                    u32x4 w; w.x = cvt_pk_bf16(v0[0], v0[1]); w.y = cvt_pk_bf16(v0[2], v0[3]); w.z = cvt_pk_bf16(v1[0], v1[1]); w.w = cvt_pk_bf16(v1[2], v1[3]);
                    *(u32x4*)(O + (size_t)row * OPW + col0 + bj * HALF) = w; } }
    }
};

template <class Epi, class Sched, bool ALIGN_EPI = true>
__device__ __forceinline__ void gemm_phase(PG8_LAS unsigned char* lds, const Gemm g, const Sched& S, const Epi& E, const int wave0) {
    int lane_; asm volatile("v_mbcnt_lo_u32_b32 %0, -1, 0\n\tv_mbcnt_hi_u32_b32 %0, -1, %0" : "=v"(lane_));
    int tid_ = wave0 * 64 + lane_;
    const int tid = tid_, wid = __builtin_amdgcn_readfirstlane(tid >> 6), lane = tid & 63, wr = wid >> 2, wc = wid & 3, fr = lane & 15, fq = lane >> 4;
    const int K = g.K, nt = K / BK;
    unsigned voffA[2], voffB[2];
#pragma unroll
    for (int i = 0; i < 2; ++i) { int R, C; stage_rc(tid * 16 + i * 8192, R, C); const int Rb = Epi::PERM ? ((R & ~31) + perm32(R & 31)) : R;
        if (Epi::AOCT) { const int b = tid * 16 + i * 8192, oc = b >> 11, Ro = (b & 2047) >> 4; voffA[i] = (unsigned)(Ro * 16 + oc * (g.M * 16)); }
        else voffA[i] = (unsigned)(R * g.lda + C) * 2u;
        if (Epi::BOCT) { const int b = tid * 16 + i * 8192, oc = b >> 11, Ro = (b & 2047) >> 4, Rp = Epi::PERM ? ((Ro & ~31) + perm32(Ro & 31)) : Ro; voffB[i] = (unsigned)(Rp * 16 + oc * (g.N * 16)); }
        else voffB[i] = (unsigned)(Rb * g.ldb + C) * 2u; }
    const size_t kstep = Epi::AOCT ? (size_t)(BK / 8) * g.M * 16 : (size_t)(BK * 2), kstepB = Epi::BOCT ? (size_t)(BK / 8) * g.N * 16 : (size_t)(BK * 2);
    const size_t hstepA = Epi::AOCT ? (size_t)HALF * 16 : (size_t)HALF * g.lda * 2, hstepB = Epi::BOCT ? (size_t)HALF * 16 : (size_t)HALF * g.ldb * 2;
    const size_t tstepA = 2 * hstepA, tstepB = 2 * hstepB, pnstepA = (size_t)g.a_pn_step * 2;
    const unsigned ldsw = (unsigned)wid * 1024u;
    const int aoff = Epi::AOCT ? fq * 2048 + (wr * 64 + fr) * 16 : lds_byte(wr * 64 + fr, fq * 8), boff = Epi::BOCT ? fq * 2048 + (wc * 32 + fr) * 16 : lds_byte(wc * 32 + fr, fq * 8);
#define PG8_SA(b, h) (((b) * 2 + (h)) * HTB)
#define PG8_SB(b, h) ((4 + (b) * 2 + (h)) * HTB)
#define PG8_STAGE(bufoff, gbase, voff) do { _Pragma("unroll") for (int _i = 0; _i < 2; ++_i) \
        __builtin_amdgcn_global_load_lds((const unsigned*)((const char*)(gbase) + (voff)[_i]), (PG8_LAS unsigned*)(lds + (bufoff) + ldsw + _i * 8192), 16, 0, 0); } while (0)
#define PG8_LDA(dst, b, h) do { _Pragma("unroll") for (int m = 0; m < 4; ++m) _Pragma("unroll") for (int k = 0; k < 2; ++k) dst[m][k] = *(const PG8_LAS bf16x8*)(lds + PG8_SA(b, h) + aoff + m * (Epi::AOCT ? 256 : 2048) + k * (Epi::AOCT ? 8192 : 1024)); } while (0)
#define PG8_LDB(dst, b, h) do { _Pragma("unroll") for (int n = 0; n < 2; ++n) _Pragma("unroll") for (int k = 0; k < 2; ++k) dst[n][k] = *(const PG8_LAS bf16x8*)(lds + PG8_SB(b, h) + boff + n * (Epi::BOCT ? 256 : 2048) + k * (Epi::BOCT ? 8192 : 1024)); } while (0)
#define PG8_MMA(ai, bj, At, Bt) do { __builtin_amdgcn_s_setprio(1); _Pragma("unroll") for (int m = 0; m < 4; ++m) _Pragma("unroll") for (int n = 0; n < 2; ++n) _Pragma("unroll") for (int k = 0; k < 2; ++k) \
        acc[ai][bj][m][n] = __builtin_amdgcn_mfma_f32_16x16x32_bf16(Bt[n][k], At[m][k], acc[ai][bj][m][n], 0, 0, 0); __builtin_amdgcn_s_setprio(0); } while (0)
#define PG8_WAIT_V(n) asm volatile("s_waitcnt vmcnt(" #n ")" ::: "memory")
#define PG8_WAIT_L(n) asm volatile("s_waitcnt lgkmcnt(" #n ")" ::: "memory")
#define PG8_BAR __builtin_amdgcn_s_barrier()
#define PG8_SCHED __builtin_amdgcn_sched_barrier(0)
    __builtin_amdgcn_s_waitcnt(0);
    Unit cur, nxt; int ui = 0;
    if (!S.next(0, cur)) return;
    f32x4 acc[2][2][4][2];
#pragma unroll
    for (int a = 0; a < 2; ++a)
#pragma unroll
        for (int b = 0; b < 2; ++b)
#pragma unroll
            for (int m = 0; m < 4; ++m)
#pragma unroll
                for (int n = 0; n < 2; ++n) acc[a][b][m][n] = (f32x4){0.f, 0.f, 0.f, 0.f};
    bf16x8 At[4][2], B0[2][2], B1[2][2];
    const char* cA = (const char*)g.A + (size_t)cur.pm * tstepA + (size_t)cur.pn * pnstepA; const char* cB = (const char*)g.Bt + (size_t)cur.pn * tstepB;
    S.a_ready(cur);
    PG8_STAGE(PG8_SB(0, 0), cB, voffB); PG8_STAGE(PG8_SB(0, 1), cB + hstepB, voffB); PG8_STAGE(PG8_SA(0, 0), cA, voffA); PG8_STAGE(PG8_SA(0, 1), cA + hstepA, voffA);
    if (wr == 1) PG8_BAR;
    PG8_WAIT_V(2); PG8_BAR;
    PG8_STAGE(PG8_SB(1, 0), cB + kstepB, voffB); PG8_STAGE(PG8_SA(1, 0), cA + kstep, voffA); PG8_STAGE(PG8_SB(1, 1), cB + hstepB + kstepB, voffB);
    PG8_WAIT_V(6); PG8_BAR;
    for (;;) {
        const bool has_next = S.next(ui + 1, nxt);
        const char* nA = has_next ? (const char*)g.A + (size_t)nxt.pm * tstepA + (size_t)nxt.pn * pnstepA : cA; const char* nB = has_next ? (const char*)g.Bt + (size_t)nxt.pn * tstepB : cB;
#pragma unroll 1
        for (int t = 0; t < nt; t += 2) {
            const bool last = (t == nt - 2);
            const char* a1 = cA + (size_t)(t + 1) * kstep;
            const char* a2 = last ? nA : cA + (size_t)(t + 2) * kstep; const char* b2 = last ? nB : cB + (size_t)(t + 2) * kstepB;
            const char* a3 = a2 + kstep; const char* b3 = b2 + kstepB;
            if (last && has_next) S.a_ready(nxt);
            PG8_LDB(B0, 0, 0); PG8_LDB(B1, 0, 1); PG8_SCHED; PG8_LDA(At, 0, 0); PG8_STAGE(PG8_SA(1, 1), a1 + hstepA, voffA);
            PG8_WAIT_V(8); PG8_WAIT_L(0); PG8_BAR; PG8_MMA(0, 0, At, B0); PG8_MMA(0, 1, At, B1); PG8_BAR; PG8_SCHED;
            PG8_LDA(At, 0, 1); PG8_STAGE(PG8_SB(0, 0), b2, voffB); PG8_STAGE(PG8_SB(0, 1), b2 + hstepB, voffB); PG8_STAGE(PG8_SA(0, 0), a2, voffA);
            PG8_WAIT_V(8); PG8_WAIT_L(0); PG8_BAR; PG8_MMA(1, 0, At, B0); PG8_MMA(1, 1, At, B1); PG8_BAR; PG8_SCHED;
            PG8_LDB(B0, 1, 0); PG8_LDB(B1, 1, 1); PG8_SCHED; PG8_LDA(At, 1, 0); PG8_STAGE(PG8_SA(0, 1), a2 + hstepA, voffA);
            PG8_WAIT_V(8); PG8_WAIT_L(0); PG8_BAR; PG8_MMA(0, 0, At, B0); PG8_MMA(0, 1, At, B1); PG8_BAR; PG8_SCHED;
            PG8_LDA(At, 1, 1); PG8_STAGE(PG8_SB(1, 0), b3, voffB); PG8_STAGE(PG8_SB(1, 1), b3 + hstepB, voffB); PG8_STAGE(PG8_SA(1, 0), a3, voffA);
            PG8_WAIT_V(8); PG8_WAIT_L(0); PG8_BAR; PG8_MMA(1, 0, At, B0); PG8_MMA(1, 1, At, B1); PG8_BAR; PG8_SCHED;
        }
        if constexpr (ALIGN_EPI) { if (wr == 0) PG8_BAR; }
        E(acc, cur, wr, wc, fr, fq); S.done(cur);
        if (!has_next) break;
#pragma unroll
        for (int a = 0; a < 2; ++a)
#pragma unroll
            for (int b = 0; b < 2; ++b)
#pragma unroll
                for (int m = 0; m < 4; ++m)
#pragma unroll
                    for (int n = 0; n < 2; ++n) acc[a][b][m][n] = (f32x4){0.f, 0.f, 0.f, 0.f};
        cur = nxt; cA = nA; cB = nB; ++ui;
        if constexpr (ALIGN_EPI) { if (wr == 1) PG8_BAR; }
    }
    PG8_WAIT_V(0); __builtin_amdgcn_s_waitcnt(0);
    if constexpr (!ALIGN_EPI) { if (wr == 0) PG8_BAR; }
    PG8_BAR;
#undef PG8_SA
#undef PG8_SB
#undef PG8_STAGE
#undef PG8_LDA
#undef PG8_LDB
#undef PG8_MMA
#undef PG8_WAIT_V
#undef PG8_WAIT_L
#undef PG8_BAR
#undef PG8_SCHED
}
}

namespace att {
constexpr float SCALE = 0.08838834764831845f;
constexpr int NW = 8, QBLK = 32, KVBLK = 64, QB = NW * QBLK, D = 128;
constexpr int SHM_V = KVBLK * D * 2, SHM_K = KVBLK * D * 2;
constexpr int ATT_LDS_BYTES = 2 * SHM_V + 2 * SHM_K + NW * 64 * 4 + NW * 32 * 4;
constexpr int STG_OFF = 77824;
constexpr float THR = 8.f;
#define KSWZ(row, colB) ((row) * 256 + ((colB) ^ (((row) & 7) << 4)))
#define SBAR() __builtin_amdgcn_sched_barrier(0)
__device__ __forceinline__ int v_st(int k, int c) { const int kk = (k & ~0xC) | ((k & 4) << 1) | ((k & 8) >> 1); return ((kk >> 3) * 4 + (c >> 5)) * 512 + ((kk & 7) * 32 + (c & 31)) * 2; }
__device__ __forceinline__ int v_rd_base(int lane) { return ((lane & 3) << 3) | (((lane >> 2) & 3) << 6) | (((lane >> 4) & 1) << 5) | (((lane >> 5) & 1) << 8); }
constexpr int v_rd_off(int d0, int ks, int half) { return d0 * 512 + ks * 4096 + half * 2048; }
__device__ __forceinline__ int crow(int r, int hi) { return (r & 3) + 8 * (r >> 2) + 4 * hi; }
__device__ __forceinline__ unsigned cvtpk(float lo, float hi) { unsigned r; asm volatile("v_cvt_pk_bf16_f32 %0, %1, %2" : "=v"(r) : "v"(lo), "v"(hi)); return r; }
__device__ __forceinline__ bf16x8 load8(const bf16* p) { return *reinterpret_cast<const bf16x8*>(p); }
__device__ __forceinline__ void mask_tile(f32x16& p0, f32x16& p1, int dq) {
    const float NEG = -__builtin_inff();
#pragma unroll
    for (int r = 0; r < 16; ++r) {
        const int c = (r & 3) + 8 * (r >> 2);
        if (dq - c < 0) p0[r] = NEG;
        if (dq - c - 32 < 0) p1[r] = NEG;
    }
}
__device__ __forceinline__ void mask_sel(f32x16& p0, f32x16& p1, unsigned keep) {
    const float NEG = -__builtin_inff();
#pragma unroll
    for (int r = 0; r < 16; ++r) { p0[r] = keep ? p0[r] : NEG; p1[r] = keep ? p1[r] : NEG; }
}
__device__ __forceinline__ void partialSM(f32x16& p0, f32x16& p1, float& m_reg, float& mn, float& alpha) {
    float pmax = p0[0]; for (int r = 1; r < 16; ++r) pmax = fmaxf(pmax, p0[r]); for (int r = 0; r < 16; ++r) pmax = fmaxf(pmax, p1[r]);
    { auto rr = __builtin_amdgcn_permlane32_swap(__float_as_uint(pmax), __float_as_uint(pmax), false, false);
      pmax = fmaxf(__uint_as_float(rr[0]), __uint_as_float(rr[1])); }
    constexpr float C2 = 1.4426950408889634f * SCALE;
    if (__builtin_expect(__all((pmax - m_reg) * SCALE <= THR), 1)) { mn = m_reg; alpha = 1.f; }
    else { mn = fmaxf(m_reg, pmax); alpha = __builtin_amdgcn_exp2f((m_reg - mn) * C2); m_reg = mn; }
    const float mnL = -mn * C2;
    for (int r = 0; r < 16; ++r) p0[r] = fmaf(p0[r], C2, mnL); for (int r = 0; r < 16; ++r) p1[r] = fmaf(p1[r], C2, mnL);
    for (int r = 0; r < 16; ++r) p0[r] = __builtin_amdgcn_exp2f(p0[r]);
}
__device__ __forceinline__ void finishSM(f32x16& p0, f32x16& p1, float alpha, float& l_reg, bf16x8& pa0, bf16x8& pa1, bf16x8& pa2, bf16x8& pa3) {
    for (int r = 0; r < 16; ++r) p1[r] = __builtin_amdgcn_exp2f(p1[r]);
    float ps = 0; for (int r = 0; r < 16; ++r) ps += p0[r]; for (int r = 0; r < 16; ++r) ps += p1[r];
    { auto rr = __builtin_amdgcn_permlane32_swap(__float_as_uint(ps), __float_as_uint(ps), false, false);
      ps = __uint_as_float(rr[0]) + __uint_as_float(rr[1]); }
    l_reg = l_reg * alpha + ps;
#define PK4(P, B_, OUT) do { unsigned a0 = cvtpk(P[B_+0], P[B_+1]), a1 = cvtpk(P[B_+2], P[B_+3]);                          \
        unsigned b0 = cvtpk(P[B_+4], P[B_+5]), b1 = cvtpk(P[B_+6], P[B_+7]);                                             \
        auto r0 = __builtin_amdgcn_permlane32_swap(a0, b0, false, false); auto r1 = __builtin_amdgcn_permlane32_swap(a1, b1, false, false); \
        v4u w = {r0[0], r1[0], r0[1], r1[1]}; OUT = *reinterpret_cast<bf16x8*>(&w); } while (0)
    PK4(p0, 0, pa0); PK4(p0, 8, pa1); PK4(p1, 0, pa2); PK4(p1, 8, pa3);
#undef PK4
}
template <int KB>
__device__ __forceinline__ void qkt(f32x16& p0, f32x16& p1, const char* K_lds, int r32, int hi, const bf16x8* qr) {
    p0 = f32x16{}; p1 = f32x16{};
    const char* kb[4];
#pragma unroll
    for (int dd = 0; dd < 4; ++dd) kb[dd] = K_lds + KB * SHM_K + KSWZ(r32, (dd * 16 + hi * 8) * 2);
#pragma unroll
    for (int d0 = 0; d0 < 8; ++d0) { const char* a = kb[d0 & 3] + (d0 >> 2) * 128;
        bf16x8 b0 = *reinterpret_cast<const bf16x8*>(a);
        bf16x8 b1 = *reinterpret_cast<const bf16x8*>(a + 32 * 256);
        p0 = __builtin_amdgcn_mfma_f32_32x32x16_bf16(b0, qr[d0], p0, 0, 0, 0);
        p1 = __builtin_amdgcn_mfma_f32_32x32x16_bf16(b1, qr[d0], p1, 0, 0, 0); }
}
template <int VB, int EXTRA = 0>
__device__ __forceinline__ void pv_tile(f32x16* o, int vb0, bf16x8 pa0, bf16x8 pa1, bf16x8 pa2, bf16x8 pa3) {
#define TRRD(dst, off) asm volatile("ds_read_b64_tr_b16 %0, %1 offset:%2" : "=&v"(dst) : "v"(vb0), "i"(off) : "memory")
#define PV_D0(d0) do { s16x4 l0, l1, l2, l3, h0, h1, h2, h3; constexpr int b_ = EXTRA + VB * SHM_V + v_rd_off(d0, 0, 0); \
        TRRD(l0, b_); TRRD(h0, b_ + 2048); TRRD(l1, b_ + 4096); TRRD(h1, b_ + 6144); TRRD(l2, b_ + 8192); TRRD(h2, b_ + 10240); TRRD(l3, b_ + 12288); TRRD(h3, b_ + 14336); \
        asm volatile("s_waitcnt lgkmcnt(0)" ::: "memory"); SBAR();   \
        o[d0] = __builtin_amdgcn_mfma_f32_32x32x16_bf16(pa0, (bf16x8){l0[0], l0[1], l0[2], l0[3], h0[0], h0[1], h0[2], h0[3]}, o[d0], 0, 0, 0);   \
        o[d0] = __builtin_amdgcn_mfma_f32_32x32x16_bf16(pa1, (bf16x8){l1[0], l1[1], l1[2], l1[3], h1[0], h1[1], h1[2], h1[3]}, o[d0], 0, 0, 0);   \
        o[d0] = __builtin_amdgcn_mfma_f32_32x32x16_bf16(pa2, (bf16x8){l2[0], l2[1], l2[2], l2[3], h2[0], h2[1], h2[2], h2[3]}, o[d0], 0, 0, 0);   \
        o[d0] = __builtin_amdgcn_mfma_f32_32x32x16_bf16(pa3, (bf16x8){l3[0], l3[1], l3[2], l3[3], h3[0], h3[1], h3[2], h3[3]}, o[d0], 0, 0, 0); } while (0)
    PV_D0(0); PV_D0(1); PV_D0(2); PV_D0(3);
#undef PV_D0
#undef TRRD
}

__device__ __forceinline__ unsigned dpp_x1(unsigned v) { return (unsigned)__builtin_amdgcn_update_dpp(0, (int)v, 0xB1, 0xF, 0xF, true); }
__device__ __forceinline__ unsigned dpp_x2(unsigned v) { return (unsigned)__builtin_amdgcn_update_dpp(0, (int)v, 0x4E, 0xF, 0xF, true); }
__device__ __forceinline__ unsigned dpp_x4(unsigned v) { const int t = __builtin_amdgcn_update_dpp(0, (int)v, 0x141, 0xF, 0xF, true);
    return (unsigned)__builtin_amdgcn_update_dpp(0, t, 0x1B, 0xF, 0xF, true); }
__device__ __forceinline__ v2u quad_rows(const f32x16* o, int g, int d0, const float* rl, bool odd, bool t1) {
    const float a0 = o[d0][4 * g + 0] * rl[0], a1 = o[d0][4 * g + 1] * rl[1], a2 = o[d0][4 * g + 2] * rl[2], a3 = o[d0][4 * g + 3] * rl[3];
    const float rA0 = __uint_as_float(dpp_x1(__float_as_uint(odd ? a0 : a1))), rA1 = __uint_as_float(dpp_x1(__float_as_uint(odd ? a2 : a3)));
    const unsigned u0 = odd ? cvtpk(rA0, a1) : cvtpk(a0, rA0);
    const unsigned u1 = odd ? cvtpk(rA1, a3) : cvtpk(a2, rA1);
    const unsigned rB = dpp_x2(t1 ? u0 : u1);
    v2u w; w.x = t1 ? rB : u0; w.y = t1 ? u1 : rB; return w;
}
template <class RowFn>
__device__ __forceinline__ void store_tile_rows(const f32x16* o, const float* li_l, char* stg, int r32, int hi, int lane, const RowFn& rowptr) {
#pragma unroll
    for (int h = 0; h < 2; ++h) {
        { const int q = r32 & 3; const bool odd = (q & 1) != 0, t1 = (q & 2) != 0;
#pragma unroll
          for (int g2 = 0; g2 < 2; ++g2) { float rl[4];
#pragma unroll
              for (int j = 0; j < 4; ++j) rl[j] = __builtin_amdgcn_rcpf(li_l[crow(8 * h + 4 * g2 + j, hi)]);
              const int lr = q + 8 * g2 + 4 * hi;
#pragma unroll
              for (int d0 = 0; d0 < 4; ++d0) { const v2u w = quad_rows(o, 2 * h + g2, d0, rl, odd, t1); *(v2u*)(stg + lr * 256 + d0 * 64 + (r32 & ~3) * 2) = w; } } }
        asm volatile("s_waitcnt lgkmcnt(0)" ::: "memory");
#pragma unroll
        for (int i = 0; i < 4; ++i) { const int lr = 4 * i + (lane >> 4); const v4u x = *(const v4u*)(stg + lr * 256 + (lane & 15) * 16); char* dst = rowptr(16 * h + lr);
            if (dst) *(v4u*)(dst + (lane & 15) * 16) = x; }
        asm volatile("s_waitcnt lgkmcnt(0)" ::: "memory");
    }
}
struct BlockRef { const bf16* K; const bf16* V; char* O; float* ML; unsigned qoff; unsigned pinfo; int P0; int NT; int flags; };
struct Seam { bf16x8 qr[8]; bf16x8 st_v0, st_v1, st_k0, st_k1; };
#define KVP(p, k0, half) ((const char*)(p) + (size_t)((k0) + 32 * (half)) * (ldkv * 2))
__device__ __forceinline__ bf16x8 ld16(const char* base, unsigned off) { return *reinterpret_cast<const bf16x8*>(base + off); }
#define VMW() asm volatile("s_waitcnt vmcnt(0)" ::: "memory")
#define VMWN(n) asm volatile("s_waitcnt vmcnt(%0)" :: "i"(n) : "memory")
#define SLOAD_H(Kp, Vp, k0) do { S.st_v0 = ld16(KVP(Vp, k0, 0), kvoff); S.st_v1 = ld16(KVP(Vp, k0, 1), kvoff);              \
                         S.st_k0 = ld16(KVP(Kp, k0, 0), kvoff); S.st_k1 = ld16(KVP(Kp, k0, 1), kvoff); } while (0)
#define SWRITE_HK(bf) do { *(bf16x8*)(K_lds + (bf) * SHM_K + kws) = S.st_k0; *(bf16x8*)(K_lds + (bf) * SHM_K + kws + 32 * 256) = S.st_k1; } while (0)
#define SWRITE_HV(bf) do { *(bf16x8*)(V_lds + (bf) * SHM_V + vst0) = S.st_v0; *(bf16x8*)(V_lds + (bf) * SHM_V + vst1) = S.st_v1; } while (0)
#define SWRITE_H(bf) do { SWRITE_HV(bf); SWRITE_HK(bf); } while (0)
constexpr int ldq = PW, ldkv = PW, ldo = OPW;
__device__ __forceinline__ void attn_prime(const BlockRef& cur, const char* qbase, char* lds, Seam& S, const int tid) {
    const int sr = tid >> 4, sc = (tid & 15) * 8, kws = KSWZ(sr, sc * 2); char* K_lds = lds + 2 * SHM_V;
    const unsigned kvoff = (unsigned)(sr * ldkv + sc) * 2u;
    for (int d0 = 0; d0 < 8; ++d0) S.qr[d0] = ld16(qbase + d0 * 32, cur.qoff);
    SLOAD_H(cur.K, cur.V, 0); VMW(); SWRITE_HK(0);
    __syncthreads();
}
__device__ __forceinline__ void attn_block(const BlockRef& cur, const BlockRef& nxt, const char* qbase, char* lds, Seam& S, const int tid) {
    const int wid = __builtin_amdgcn_readfirstlane(tid >> 6), lane = tid & 63, r32 = lane & 31, hi = lane >> 5;
    const int NT = cur.NT;
    const int qlo = cur.P0 + wid * QBLK, qm = qlo + r32 - 4 * hi;
    const bool nomask = (cur.flags & 1) != 0;
    char* V_lds = lds; char* K_lds = lds + 2 * SHM_V;
    float* ws = (float*)(lds + 2 * SHM_V + 2 * SHM_K) + wid * 64; float* li_l = ws, * al_l = ws + 32;
    unsigned* rt = (unsigned*)(lds + 2 * SHM_V + 2 * SHM_K + NW * 64 * 4) + wid * 32;
    float m_reg = -1e30f, l_reg = 0; f32x16 o[4] = {};
    const int sr = tid >> 4, sc = (tid & 15) * 8, vst0 = v_st(sr, sc), vst1 = v_st(32 + sr, sc), kws = KSWZ(sr, sc * 2);
    const unsigned kvoff = (unsigned)(sr * ldkv + sc) * 2u;
    const int vb0 = (int)(uintptr_t)V_lds + v_rd_base(lane);
    const bf16* Kh = cur.K; const bf16* Vh = cur.V;
#define RESC(a) do { if (__any((a) < 1.f)) { if (hi == 0) al_l[r32] = (a); asm volatile("s_waitcnt lgkmcnt(0)" ::: "memory");              \
                     for (int d_ = 0; d_ < 4; ++d_) for (int r = 0; r < 16; ++r) o[d_][r] *= al_l[crow(r, hi)]; } } while (0)
#define KBASE(t) ((t) * KVBLK)
#define MASKT(P0_, P1_, t) do { const int kb_ = KBASE(t); if (!nomask && kb_ + KVBLK - 1 > qlo) mask_tile(P0_, P1_, qm - kb_); } while (0)
    constexpr int NQL = 8;
#define SEAM_K0() do { VMWN(NQL); SWRITE_HK(0); SBAR(); } while (0)
    f32x16 pA0, pA1, pB0, pB1; float mnA, mnB, alA, alB; bf16x8 pa0, pa1, pa2, pa3;
    SWRITE_HV(0); SBAR();
    if (NT > 1) { SLOAD_H(Kh, Vh, KBASE(1)); }
    SBAR(); qkt<0>(pA0, pA1, K_lds, r32, hi, S.qr);
    MASKT(pA0, pA1, 0); partialSM(pA0, pA1, m_reg, mnA, alA);
    if (NT > 1) { VMW(); SWRITE_H(1); }
    __syncthreads();
#define HALF_STEP(PX0, PX1, mnX, alX, PY0, PY1, alY, t, KB, VB, SB) do {                                                      \
        SBAR(); qkt<KB>(PX0, PX1, K_lds, r32, hi, S.qr);                                                         \
        finishSM(PY0, PY1, alY, l_reg, pa0, pa1, pa2, pa3); SBAR();                                                           \
        if ((t) + 1 < NT) { SLOAD_H(Kh, Vh, KBASE((t) + 1)); SBAR(); }                                               \
        pv_tile<VB>(o, vb0, pa0, pa1, pa2, pa3); MASKT(PX0, PX1, (t)); partialSM(PX0, PX1, m_reg, mnX, alX);                                        \
        __syncthreads();                                                                                                      \
        if ((t) + 1 < NT) { VMW(); SWRITE_H(SB); }                                                                          \
        RESC(alX); __syncthreads(); } while (0)
    for (int t = 1; t + 1 < NT; t += 2) {
        HALF_STEP(pB0, pB1, mnB, alB, pA0, pA1, alA, t, 1, 0, 0);
        HALF_STEP(pA0, pA1, mnA, alA, pB0, pB1, alB, t + 1, 0, 1, 1);
    }
    const bool even = (NT & 1) == 0;
    if (even) { SBAR(); qkt<1>(pB0, pB1, K_lds, r32, hi, S.qr); SBAR(); }
    { const bf16* Kn = nxt.K; const bf16* Vn = nxt.V; SLOAD_H(Kn, Vn, 0); SBAR(); }
#pragma unroll
    for (int d0 = 0; d0 < 8; ++d0) S.qr[d0] = ld16(qbase + d0 * 32, nxt.qoff);
    SBAR();
    finishSM(pA0, pA1, alA, l_reg, pa0, pa1, pa2, pa3); SBAR();
    pv_tile<0>(o, vb0, pa0, pa1, pa2, pa3);
    if (even) { MASKT(pB0, pB1, NT - 1); partialSM(pB0, pB1, m_reg, mnB, alB); __syncthreads(); RESC(alB);
        finishSM(pB0, pB1, alB, l_reg, pa0, pa1, pa2, pa3); SBAR(); pv_tile<1>(o, vb0, pa0, pa1, pa2, pa3); }
    SBAR(); SEAM_K0();
    if (hi == 0) { li_l[r32] = l_reg; rt[r32] = cur.pinfo; } asm volatile("s_waitcnt lgkmcnt(0)" ::: "memory");
    char* Ob = cur.O; char* stg = lds + STG_OFF + wid * 4096;
    if (hi == 0 && (int)cur.pinfo >= 0) { f32x2 ml = {m_reg, l_reg}; *(f32x2*)(cur.ML + (size_t)cur.pinfo * 2) = ml; }
    store_tile_rows(o, li_l, stg, r32, hi, lane, [&](int row) -> char* { const unsigned info = rt[row]; return (int)info >= 0 ? Ob + (size_t)(info & 0x7fffffffu) * 256u : nullptr; });
    __syncthreads();
#undef RESC
#undef KBASE
#undef MASKT
#undef SEAM_K0
#undef HALF_STEP
}
#undef KVP
#undef VMW
#undef VMWN
#undef SLOAD_H
#undef SWRITE_HK
#undef SWRITE_HV
#undef SWRITE_H
}

namespace att2 {
using att::dpp_x1; using att::dpp_x2; using att::dpp_x4; using att::quad_rows; using att::SHM_K; using att::SHM_V; using att::QBLK; using att::KVBLK; using att::crow; using att::cvtpk; using att::ld16; using att::v_st; using att::v_rd_base;
constexpr int OFF_V0 = 0, OFF_V1 = 2 * SHM_V, OFF_K = OFF_V1 + 2 * SHM_V, OFF_P = OFF_K + 2 * SHM_K, OFF_WS = OFF_P + 2 * 16384, ATT2_LDS_BYTES = OFF_WS + 4 * 128 * 4;
static_assert(ATT2_LDS_BYTES <= MISC_OFF, "diff-attention LDS map");
constexpr int ldkv = PW, ldo = OPW;
struct Ref { const bf16* K; const bf16* V; char* O; unsigned qoff; int P0; int NT; int desc; };
#define BARL() do { asm volatile("s_waitcnt lgkmcnt(0)" ::: "memory"); __builtin_amdgcn_s_barrier(); asm volatile("" ::: "memory"); } while (0)
#define VMW2() asm volatile("s_waitcnt vmcnt(0)" ::: "memory")
__device__ __forceinline__ void store_o(const f32x16* o, char* Ob, const float* li_l, int s, int r32, int hi, unsigned colb) {
    const int q = r32 & 3; const bool odd = (q & 1) != 0, t1 = (q & 2) != 0, b4 = (r32 & 4) != 0;
    unsigned ooff = (unsigned)((s * QBLK + 8 * (b4 ? 1 : 0) + 4 * hi + q) * ldo + (r32 & ~7)) * 2u + colb; asm volatile("" : "+v"(ooff));
#pragma unroll
    for (int G = 0; G < 2; ++G) {
        float rl0[4], rl1[4];
#pragma unroll
        for (int j = 0; j < 4; ++j) { rl0[j] = __builtin_amdgcn_rcpf(li_l[crow(8 * G + j, hi)]); rl1[j] = __builtin_amdgcn_rcpf(li_l[crow(8 * G + 4 + j, hi)]); }
#pragma unroll
        for (int d0 = 0; d0 < 4; ++d0) {
            const v2u w0 = quad_rows(o, 2 * G, d0, rl0, odd, t1), w1 = quad_rows(o, 2 * G + 1, d0, rl1, odd, t1);
            const unsigned rx = dpp_x4(b4 ? w0.x : w1.x), ry = dpp_x4(b4 ? w0.y : w1.y);
            v4u w; w.x = b4 ? rx : w0.x; w.y = b4 ? ry : w0.y; w.z = b4 ? w1.x : rx; w.w = b4 ? w1.y : ry;
            *(v4u*)(Ob + (ooff + (unsigned)(G * 16 * ldo * 2 + d0 * 64))) = w; } }
}
template <int CB>
__device__ __forceinline__ void pv256(f32x16* o, int vb0, bf16x8 pa0, bf16x8 pa1, bf16x8 pa2, bf16x8 pa3) {
    s16x4 Al0, Ah0, Al1, Ah1, Al2, Ah2, Al3, Ah3, Bl0, Bh0, Bl1, Bh1, Bl2, Bh2, Bl3, Bh3;
#define TR(dst, off) asm volatile("ds_read_b64_tr_b16 %0, %1 offset:%2" : "=&v"(dst) : "v"(vb0), "i"(off) : "memory")
#define RD(S, g) do { constexpr int b_ = ((g) >> 2) * OFF_V1 + CB * SHM_V + att::v_rd_off((g) & 3, 0, 0); \
        TR(S##l0, b_); TR(S##h0, b_ + 2048); TR(S##l1, b_ + 4096); TR(S##h1, b_ + 6144); TR(S##l2, b_ + 8192); TR(S##h2, b_ + 10240); TR(S##l3, b_ + 12288); TR(S##h3, b_ + 14336); } while (0)
#define MM(S, g) do { \
        o[g] = __builtin_amdgcn_mfma_f32_32x32x16_bf16(pa0, (bf16x8){S##l0[0], S##l0[1], S##l0[2], S##l0[3], S##h0[0], S##h0[1], S##h0[2], S##h0[3]}, o[g], 0, 0, 0); \
        o[g] = __builtin_amdgcn_mfma_f32_32x32x16_bf16(pa1, (bf16x8){S##l1[0], S##l1[1], S##l1[2], S##l1[3], S##h1[0], S##h1[1], S##h1[2], S##h1[3]}, o[g], 0, 0, 0); \
        o[g] = __builtin_amdgcn_mfma_f32_32x32x16_bf16(pa2, (bf16x8){S##l2[0], S##l2[1], S##l2[2], S##l2[3], S##h2[0], S##h2[1], S##h2[2], S##h2[3]}, o[g], 0, 0, 0); \
        o[g] = __builtin_amdgcn_mfma_f32_32x32x16_bf16(pa3, (bf16x8){S##l3[0], S##l3[1], S##l3[2], S##l3[3], S##h3[0], S##h3[1], S##h3[2], S##h3[3]}, o[g], 0, 0, 0); } while (0)
#define W8() do { asm volatile("s_waitcnt lgkmcnt(8)" ::: "memory"); SBAR(); } while (0)
#define W0() do { asm volatile("s_waitcnt lgkmcnt(0)" ::: "memory"); SBAR(); } while (0)
    asm volatile("s_waitcnt lgkmcnt(0)" ::: "memory");
    RD(A, 0); RD(B, 1); W8(); MM(A, 0); SBAR();
    RD(A, 2); W8(); MM(B, 1); SBAR();
    RD(B, 3); W8(); MM(A, 2); SBAR();
    RD(A, 4); W8(); MM(B, 3); SBAR();
    RD(B, 5); W8(); MM(A, 4); SBAR();
    RD(A, 6); W8(); MM(B, 5); SBAR();
    RD(B, 7); W8(); MM(A, 6); SBAR();
    W0(); MM(B, 7);
#undef TR
#undef RD
#undef MM
#undef W8
#undef W0
}
template <int KB>
__device__ __forceinline__ void qkt_pref(f32x16& p0, f32x16& p1, const char* K_lds, int r32, int hi, const bf16x8* qr, float nm) {
#pragma unroll
    for (int r = 0; r < 16; ++r) { p0[r] = nm; p1[r] = nm; }
    const char* kb[4];
#pragma unroll
    for (int dd = 0; dd < 4; ++dd) kb[dd] = K_lds + KB * SHM_K + KSWZ(r32, (dd * 16 + hi * 8) * 2);
    bf16x8 f0[8], f1[8];
#define QL(d0) do { const char* a_ = kb[(d0) & 3] + ((d0) >> 2) * 128; f0[d0] = *reinterpret_cast<const bf16x8*>(a_); f1[d0] = *reinterpret_cast<const bf16x8*>(a_ + 32 * 256); } while (0)
#define QM(d0) do { p0 = __builtin_amdgcn_mfma_f32_32x32x16_bf16(f0[d0], qr[d0], p0, 0, 0, 0); p1 = __builtin_amdgcn_mfma_f32_32x32x16_bf16(f1[d0], qr[d0], p1, 0, 0, 0); } while (0)
    QL(0); QL(1); QL(2); QL(3); SBAR();
    QM(0); QM(1); QL(4); QL(5); SBAR();
    QM(2); QM(3); QL(6); QL(7); SBAR();
    QM(4); QM(5); SBAR(); QM(6); QM(7);
#undef QL
#undef QM
}
__device__ __forceinline__ void partialSM2(f32x16& p0, f32x16& p1, float& m_reg, float& alpha) {
    float pmax = p0[0];
#pragma unroll
    for (int r = 1; r < 16; ++r) pmax = fmaxf(pmax, p0[r]);
#pragma unroll
    for (int r = 0; r < 16; ++r) pmax = fmaxf(pmax, p1[r]);
    { auto rr = __builtin_amdgcn_permlane32_swap(__float_as_uint(pmax), __float_as_uint(pmax), false, false);
      pmax = fmaxf(__uint_as_float(rr[0]), __uint_as_float(rr[1])); }
    constexpr float THR2 = att::THR * 1.4426950408889634f;
    if (__builtin_expect(__all(pmax <= THR2), 1)) { alpha = 1.f; }
    else { const float d = fmaxf(pmax, 0.f); alpha = __builtin_amdgcn_exp2f(-d); m_reg += d;
#pragma unroll
        for (int r = 0; r < 16; ++r) { p0[r] -= d; p1[r] -= d; } }
#pragma unroll
    for (int r = 0; r < 16; ++r) p0[r] = __builtin_amdgcn_exp2f(p0[r]);
}
struct Cursor { int b, t, NT, desc; const bf16* K; const bf16* V; char* O; };
#define TIDX(c) ((c).desc ? (c).NT - 1 - (c).t : (c).t)
#define ADVANCE(c) do { if (++(c).t == (c).NT) { (c).t = 0; if (++(c).b < nblk) { const Ref r_ = ref((c).b); (c).NT = r_.NT; (c).desc = r_.desc; (c).K = r_.K; (c).V = r_.V; (c).O = r_.O; } } } while (0)
template <class RefFn>
__device__ __forceinline__ void score_stream(const RefFn& ref, int nblk, int G, const char* qbase, char* lds, const int tid) {
    const int wid = __builtin_amdgcn_readfirstlane(tid >> 6), lane = tid & 63, r32 = lane & 31, hi = lane >> 5, s = wid & 3;
    const char* K_lds = lds + OFF_K; char* Pb = lds + OFF_P + s * 4096 + lane * 16;
    float* ws = (float*)(lds + OFF_WS) + s * 128;
    const int t2 = tid & 255, sr = t2 >> 4, sc = (t2 & 15) * 8, kws = KSWZ(sr, sc * 2);
    const unsigned kvoff = (unsigned)(sr * ldkv + sc) * 2u;
    bf16x8 qr[8], sk0[4], sk1[4], sw0[4], sw1[4];
    const int vst = v_st(sr, sc);
#define LOADK(dst, Kp, k0) do { _Pragma("unroll") for (int i_ = 0; i_ < 4; ++i_) dst[i_] = ld16((const char*)(Kp) + (size_t)((k0) + 16 * i_) * (ldkv * 2), kvoff); } while (0)
#define WRITEK(bf, src) do { _Pragma("unroll") for (int i_ = 0; i_ < 4; ++i_) *(bf16x8*)(lds + OFF_K + (bf) * SHM_K + kws + i_ * 4096) = src[i_]; } while (0)
#define LOADW(dst, Vp, k0) do { _Pragma("unroll") for (int i_ = 0; i_ < 4; ++i_) dst[i_] = ld16((const char*)(Vp) + (size_t)((k0) + 16 * i_) * (ldkv * 2) + 256, kvoff); } while (0)
#define WRITEW(bf, src) do { _Pragma("unroll") for (int i_ = 0; i_ < 4; ++i_) *(bf16x8*)(lds + OFF_V1 + (bf) * SHM_V + vst + i_ * 4096) = src[i_]; } while (0)
    Ref cur = ref(0);
    Cursor lk; lk.b = 0; lk.t = 0; lk.NT = cur.NT; lk.desc = cur.desc; lk.K = cur.K; lk.V = cur.V; lk.O = cur.O;
    Cursor lw = lk;
    LOADW(sw0, lw.V, TIDX(lw) * KVBLK); ADVANCE(lw);
    bool hw0 = true, hw1 = false; int gw = 1;
    __builtin_amdgcn_s_setprio(2);
    for (int d0 = 0; d0 < 8; ++d0) qr[d0] = ld16(qbase + d0 * 32, cur.qoff);
    LOADK(sk0, lk.K, TIDX(lk) * KVBLK); ADVANCE(lk); LOADK(sk1, lk.K, TIDX(lk) * KVBLK); ADVANCE(lk);
    WRITEK(0, sk0); WRITEK(1, sk1);
    bool have0 = 2 < G, have1 = false; int gl = 3;
    if (have0) { LOADK(sk0, lk.K, TIDX(lk) * KVBLK); ADVANCE(lk); }
    BARL();
    float m_reg = 0.f, l_reg = 0.f;
    f32x16 pA0, pA1, pB0, pB1; float alA = 1.f, alB = 1.f; bf16x8 pa0, pa1, pa2, pa3;
#define PUBLISH(slot, al) do { *(bf16x8*)(Pb + (slot) * 16384) = pa0; *(bf16x8*)(Pb + (slot) * 16384 + 1024) = pa1; *(bf16x8*)(Pb + (slot) * 16384 + 2048) = pa2; \
        *(bf16x8*)(Pb + (slot) * 16384 + 3072) = pa3; if (hi == 0) ws[64 + (slot) * 32 + r32] = (al); } while (0)
    for (int b = 0; b < nblk; ++b) {
        const Ref nxt = ref(b + 1 < nblk ? b + 1 : b);
        const int NT = cur.NT, qlo = cur.P0 + s * QBLK, qm = qlo + r32 - 4 * hi;
#define MASKT(P0_, P1_, t) do { const int kb_ = (t) * KVBLK; if (kb_ + KVBLK - 1 > qlo) att::mask_tile(P0_, P1_, qm - kb_); } while (0)
        for (int t = 0; t < NT; t += 2) {
            if (have1) WRITEK(1, sk1);
            have1 = gl < G; if (have1) { LOADK(sk1, lk.K, TIDX(lk) * KVBLK); ADVANCE(lk); } ++gl;
            if (hw1) WRITEW(1, sw1);
            hw1 = gw < G; if (hw1) { LOADW(sw1, lw.V, TIDX(lw) * KVBLK); ADVANCE(lw); } ++gw;
            SBAR(); qkt_pref<0>(pA0, pA1, K_lds, r32, hi, qr, (t == 0) ? 0.f : -m_reg);
            if (t > 0 || b > 0) { att::finishSM(pB0, pB1, alB, l_reg, pa0, pa1, pa2, pa3); SBAR(); PUBLISH(1, alB); }
            if (t == 0) { if (b > 0 && hi == 0) ws[((b - 1) & 1) * 32 + r32] = l_reg; m_reg = 0.f; l_reg = 0.f; }
            MASKT(pA0, pA1, (cur.desc ? NT - 1 - t : t)); partialSM2(pA0, pA1, m_reg, alA);
            BARL();
            if (have0) WRITEK(0, sk0);
            have0 = gl < G; if (have0) { LOADK(sk0, lk.K, TIDX(lk) * KVBLK); ADVANCE(lk); } ++gl;
            if (hw0) WRITEW(0, sw0);
            hw0 = gw < G; if (hw0) { LOADW(sw0, lw.V, TIDX(lw) * KVBLK); ADVANCE(lw); } ++gw;
            SBAR(); qkt_pref<1>(pB0, pB1, K_lds, r32, hi, qr, -m_reg);
            att::finishSM(pA0, pA1, alA, l_reg, pa0, pa1, pa2, pa3); SBAR(); PUBLISH(0, alA);
            if (t + 2 == NT) {
#pragma unroll
                for (int d0 = 0; d0 < 8; ++d0) qr[d0] = ld16(qbase + d0 * 32, nxt.qoff); }
            MASKT(pB0, pB1, (cur.desc ? NT - 2 - t : t + 1)); partialSM2(pB0, pB1, m_reg, alB);
            BARL();
        }
#undef MASKT
        cur = nxt;
    }
    att::finishSM(pB0, pB1, alB, l_reg, pa0, pa1, pa2, pa3); SBAR(); PUBLISH(1, alB);
    if (hi == 0) ws[((nblk - 1) & 1) * 32 + r32] = l_reg;
    if (hw1) WRITEW(1, sw1);
    BARL();
    BARL();
    __builtin_amdgcn_s_setprio(0);
#undef PUBLISH
#undef LOADK
#undef WRITEK
#undef LOADW
#undef WRITEW
}
template <class RefFn>
__device__ __forceinline__ void helper_stream(const RefFn& ref, int nblk, int G, char* lds, const int tid) {
    const int wid = __builtin_amdgcn_readfirstlane(tid >> 6), lane = tid & 63, r32 = lane & 31, hi = lane >> 5, s = wid & 3;
    char* Pb = lds + OFF_P + s * 4096 + lane * 16;
    float* ws = (float*)(lds + OFF_WS) + s * 128;
    const int vb0 = (int)(uintptr_t)(lds + OFF_V0) + v_rd_base(lane);
    const int t2 = tid & 255, sr = t2 >> 4, sc = (t2 & 15) * 8, vst = v_st(sr, sc);
    const unsigned kvoff = (unsigned)(sr * ldkv + sc) * 2u;
    bf16x8 sv0[4], sv1[4], pa0, pa1, pa2, pa3; f32x16 o[8];
#define LOADV(dst, Vp, k0) do { _Pragma("unroll") for (int i_ = 0; i_ < 4; ++i_) dst[i_] = ld16((const char*)(Vp) + (size_t)((k0) + 16 * i_) * (ldkv * 2), kvoff); } while (0)
#define WRITEV(bf, src) do { _Pragma("unroll") for (int i_ = 0; i_ < 4; ++i_) *(bf16x8*)(lds + OFF_V0 + (bf) * SHM_V + vst + i_ * 4096) = src[i_]; } while (0)
    Cursor lv, cc; { const Ref r0 = ref(0); lv.b = 0; lv.t = 0; lv.NT = r0.NT; lv.desc = r0.desc; lv.K = r0.K; lv.V = r0.V; lv.O = r0.O; cc = lv; }
    LOADV(sv0, lv.V, TIDX(lv) * KVBLK); ADVANCE(lv);
    bool have0 = true, have1 = false; int gl = 1;
    BARL();
    char* prevO = nullptr; int prevb = 0;
#define INTERVAL(i, CB, SWSET, SWBUF, HAVE) do {                                                                                        \
        if (HAVE) WRITEV(SWBUF, SWSET);                                                                                                 \
        HAVE = gl < G; if (HAVE) { LOADV(SWSET, lv.V, TIDX(lv) * KVBLK); ADVANCE(lv); } ++gl;                                               \
        if ((i) >= 2 && (i) - 2 < G) {                                                                                                  \
            if (cc.t == 0) { if (prevO) { store_o(o, prevO, ws + (prevb & 1) * 32, s, r32, hi, 0u); store_o(o + 4, prevO, ws + (prevb & 1) * 32, s, r32, hi, 256u); } \
                _Pragma("unroll") for (int d_ = 0; d_ < 8; ++d_) o[d_] = f32x16{}; prevO = cc.O; prevb = cc.b; }                         \
            pa0 = *(const bf16x8*)(Pb + (CB) * 16384); pa1 = *(const bf16x8*)(Pb + (CB) * 16384 + 1024); pa2 = *(const bf16x8*)(Pb + (CB) * 16384 + 2048); pa3 = *(const bf16x8*)(Pb + (CB) * 16384 + 3072); \
            { const float* al_ = ws + 64 + (CB) * 32; const float a_ = al_[r32];                                                        \
              if (__any(a_ < 1.f)) { for (int d_ = 0; d_ < 8; ++d_) for (int r = 0; r < 16; ++r) o[d_][r] *= al_[crow(r, hi)]; } }       \
            pv256<CB>(o, vb0, pa0, pa1, pa2, pa3);                      \
            ADVANCE(cc); }                                                                                                              \
        BARL(); } while (0)
    for (int i = 0; i < G + 2; i += 2) { INTERVAL(i, 0, sv1, 1, have1); INTERVAL(i + 1, 1, sv0, 0, have0); }
    store_o(o, prevO, ws + (prevb & 1) * 32, s, r32, hi, 0u); store_o(o + 4, prevO, ws + (prevb & 1) * 32, s, r32, hi, 256u);
#undef INTERVAL
#undef LOADV
#undef WRITEV
}
#undef ADVANCE
#undef TIDX
}

#define XB_TMO      128
#define XB_XCNT(j)  (256  + 64 * (j))
#define XB_XSUB(j)  (1280 + 64 * (j))
#define XB_XGEN(j)  (2304 + 64 * (j))
#define XB_TOP      3328
#define XB_TOPGEN   3392
#define XCD_BAR_WORDS 3456
#define XB_SPIN_CAP (1u << 18)
__device__ __forceinline__ unsigned xb_ld(unsigned* p)              { return __hip_atomic_load(p, __ATOMIC_RELAXED, __HIP_MEMORY_SCOPE_AGENT); }
__device__ __forceinline__ unsigned xb_add(unsigned* p, unsigned v) { return __hip_atomic_fetch_add(p, v, __ATOMIC_RELAXED, __HIP_MEMORY_SCOPE_AGENT); }
__device__ __forceinline__ unsigned xb_xcc_id() { return (unsigned)__builtin_amdgcn_s_getreg((3 << 11) | 20) & 0xFu; }
#define XB_SPIN(cond, bar) do { unsigned _sp = 0; while (cond) { __builtin_amdgcn_s_sleep(1); \
    if ((++_sp & 255u) == 0u) { if (xb_ld(&(bar)[XB_TMO])) break; if (_sp > XB_SPIN_CAP) { atomicAdd(&(bar)[XB_TMO], 1u); break; } } } } while (0)
struct XcdBarrier { unsigned* bar; unsigned x; volatile LAS unsigned* st; };
__device__ __forceinline__ XcdBarrier xcd_barrier_post(unsigned* bar, volatile LAS unsigned* st) {
    XcdBarrier b; b.bar = bar; b.x = xb_xcc_id(); b.st = st;
    if (threadIdx.x == 0) (void)xb_add(&bar[XB_XCNT(b.x)], 1u);
    return b;
}
__device__ __forceinline__ void xcd_barrier_complete(unsigned* bar, unsigned x, unsigned& nloc, unsigned& nx) {
    const unsigned G = gridDim.x * gridDim.y * gridDim.z;
    unsigned sum, cnt, mine, sp = 0u;
    for (;;) {
        sum = 0u; cnt = 0u; mine = 0u;
#pragma unroll
        for (unsigned j = 0; j < 16; ++j) { const unsigned c = xb_ld(&bar[XB_XCNT(j)]); sum += c; cnt += (c > 0u) ? 1u : 0u; mine = (j == x) ? c : mine; }
        if (sum == G) break;
        __builtin_amdgcn_s_sleep(1);
        if ((++sp & 255u) == 0u) { if (xb_ld(&bar[XB_TMO])) break; if (sp > XB_SPIN_CAP) { atomicAdd(&bar[XB_TMO], 1u); break; } }
    }
    nloc = mine > 0u ? mine : 1u; nx = cnt > 0u ? cnt : 1u;
}
__device__ __forceinline__ void xcd_barrier(const XcdBarrier& b) {
    asm volatile("s_waitcnt vmcnt(0)" ::: "memory");
    __syncthreads();
    if (threadIdx.x == 0) {
        unsigned* bar = b.bar;
        __builtin_amdgcn_s_waitcnt(0);
        unsigned nloc = b.st[0], nx = b.st[1];
        if (nloc == 0u) { xcd_barrier_complete(bar, b.x, nloc, nx); b.st[0] = nloc; b.st[1] = nx; }
        const unsigned old = xb_add(&bar[XB_XSUB(b.x)], 1u);
        const unsigned gen = old / nloc;
        if (old + 1u == (gen + 1u) * nloc) {
            __builtin_amdgcn_fence(__ATOMIC_RELEASE, "agent");
            asm volatile("s_waitcnt vmcnt(0)" ::: "memory");
            const unsigned og = xb_add(&bar[XB_TOP], 1u);
            const unsigned tg = og / nx;
            if (og + 1u == (tg + 1u) * nx) xb_add(&bar[XB_TOPGEN], 1u);
            else XB_SPIN(xb_ld(&bar[XB_TOPGEN]) == tg, bar);
            __builtin_amdgcn_fence(__ATOMIC_ACQUIRE, "agent");
            xb_add(&bar[XB_XGEN(b.x)], 1u);
            asm volatile("s_waitcnt vmcnt(0)" ::: "memory");
        } else {
            XB_SPIN(xb_ld(&bar[XB_XGEN(b.x)]) == gen, bar);
            __builtin_amdgcn_fence(__ATOMIC_ACQUIRE, "agent");
            asm volatile("s_waitcnt vmcnt(0)" ::: "memory");
        }
    }
    __syncthreads();
}

__device__ __forceinline__ unsigned xg_ld(gu32* p)              { return __hip_atomic_load(p, __ATOMIC_RELAXED, __HIP_MEMORY_SCOPE_AGENT); }
__device__ __forceinline__ unsigned xg_add(gu32* p, unsigned v) { return __hip_atomic_fetch_add(p, v, __ATOMIC_RELAXED, __HIP_MEMORY_SCOPE_AGENT); }
#define XG_SPIN(cond, bar) do { unsigned _sp = 0; while (cond) { __builtin_amdgcn_s_sleep(1); \
    if ((++_sp & 255u) == 0u) { if (xg_ld(&(bar)[XB_TMO])) break; if (_sp > XB_SPIN_CAP) { xg_add(&(bar)[XB_TMO], 1u); break; } } } } while (0)
__device__ __attribute__((noinline)) void xcd_barrier_slim(gu32* bar, unsigned x, volatile LAS unsigned* st, bool leader) {
    asm volatile("s_waitcnt vmcnt(0)" ::: "memory");
    __syncthreads();
    if (leader) {
        __builtin_amdgcn_s_waitcnt(0);
        unsigned nloc = st[0], nx = st[1];
        if (nloc == 0u || nx == 0u) { xg_add(&bar[XB_TMO], 1u); nloc = 1u; nx = 1u; }
        const unsigned old = xg_add(&bar[XB_XSUB(x)], 1u);
        const unsigned gen = old / nloc;
        if (old + 1u == (gen + 1u) * nloc) {
            __builtin_amdgcn_fence(__ATOMIC_RELEASE, "agent");
            asm volatile("s_waitcnt vmcnt(0)" ::: "memory");
            const unsigned og = xg_add(&bar[XB_TOP], 1u);
            const unsigned tg = og / nx;
            if (og + 1u == (tg + 1u) * nx) xg_add(&bar[XB_TOPGEN], 1u);
            else XG_SPIN(xg_ld(&bar[XB_TOPGEN]) == tg, bar);
            __builtin_amdgcn_fence(__ATOMIC_ACQUIRE, "agent");
            xg_add(&bar[XB_XGEN(x)], 1u);
            asm volatile("s_waitcnt vmcnt(0)" ::: "memory");
        } else {
            XG_SPIN(xg_ld(&bar[XB_XGEN(x)]) == gen, bar);
            __builtin_amdgcn_fence(__ATOMIC_ACQUIRE, "agent");
            asm volatile("s_waitcnt vmcnt(0)" ::: "memory");
        }
    }
    __syncthreads();
}

constexpr int NWAVES = 8;
struct Args { const void* in[N_IN]; float* out; unsigned char* ws; int ph_lo, ph_hi; };
static_assert(sizeof(Args) == (N_IN + 2) * 8 + 8, "Args has no padding");

struct Frame {
    LAS unsigned char* lds; char* ldsg; unsigned char* ws; int tid, lane, wave, vcu, G;
};
__device__ __forceinline__ int lane_id_now() { int l; asm volatile("v_mbcnt_lo_u32_b32 %0, -1, 0\n\tv_mbcnt_hi_u32_b32 %0, -1, %0" : "=v"(l)); return l; }
__device__ __forceinline__ Frame phase_frame(const Frame& F0) {
    Frame F = F0; int t = F0.wave * 64 + lane_id_now(); size_t z = 0; asm volatile("" : "+s"(z));
    F.tid = t; F.lane = t & 63; F.wave = __builtin_amdgcn_readfirstlane(t >> 6); F.ws = F0.ws + z; return F;
}

__device__ __forceinline__ void p0_transpose_item(const float* W, const float* gk, int K, int N, bf16* WT, int rowmode, LAS float* scr, int item, int lane) {
    const int nblk = N / 64, kb = item / nblk, nb = item - kb * nblk, k0 = 64 * kb, n0 = 64 * nb;
    const int kk4 = lane >> 4, nq = lane & 15;
    f32x4 v[16];
#pragma unroll
    for (int i = 0; i < 16; ++i) v[i] = *(const GAS f32x4*)(W + (size_t)(k0 + 4 * i + kk4) * N + n0 + 4 * nq);
#pragma unroll
    for (int i = 0; i < 16; ++i) { const int k = 4 * i + kk4; f32x4 w = v[i]; if (gk) w = w * gk[k0 + k];
        *(LAS f32x4*)(scr + k * 64 + ((4 * nq) ^ (k & 0x38))) = w; }
    LDS_WAIT(); asm volatile("" ::: "memory");
    const int r = lane >> 3, c = lane & 7;
    const int rbase = rowmode == 0 ? n0 : ((n0 >> 7) * 256 + (n0 & 127) + (rowmode == 2 ? 128 : 0));
#pragma unroll
    for (int i = 0; i < 8; ++i) { const int n = 8 * i + r; const LAS float* sp = scr + (8 * c) * 64 + (n ^ (8 * c));
        v4u o; o.x = cvt_pk_bf16(sp[0 * 64], sp[1 * 64]); o.y = cvt_pk_bf16(sp[2 * 64], sp[3 * 64]); o.z = cvt_pk_bf16(sp[4 * 64], sp[5 * 64]); o.w = cvt_pk_bf16(sp[6 * 64], sp[7 * 64]);
        *(GAS v4u*)(WT + (size_t)(rbase + n) * K + k0 + 8 * c) = o; }
    LDS_WAIT(); asm volatile("" ::: "memory");
}

struct P0Item { const float* W; const float* gk; bf16* WT; int K, N, rowmode, item; };
__device__ __forceinline__ void p0_item_load(const P0Item& d, int lane, f32x4 (&v)[16]) {
    const int nch = d.N / 256, kb = d.item / nch, nc = d.item - kb * nch, k0 = 16 * kb, n0 = 256 * nc + 4 * lane;
#pragma unroll
    for (int i = 0; i < 16; ++i) v[i] = *(const GAS f32x4*)(d.W + (size_t)(k0 + i) * d.N + n0);
}
__device__ __forceinline__ void p0_item_finish(const P0Item& d, const f32x4 (&v)[16], int lane) {
    const int nch = d.N / 256, kb = d.item / nch, nc = d.item - kb * nch, k0 = 16 * kb, n0 = 256 * nc + 4 * lane;
    const int nrow = d.rowmode == 0 ? n0 : ((n0 >> 7) * 256 + (n0 & 127) + (d.rowmode == 2 ? 128 : 0)), NR = d.rowmode == 0 ? d.N : 2 * d.N;
    float g[16];
#pragma unroll
    for (int i = 0; i < 16; ++i) g[i] = d.gk ? d.gk[k0 + i] : 1.f;
    char* dst = (char*)d.WT + ((size_t)(k0 >> 3) * NR + nrow) * 16;
#pragma unroll
    for (int o = 0; o < 2; ++o)
#pragma unroll
        for (int j = 0; j < 4; ++j) { v4u w;
            w.x = cvt_pk_bf16(v[8 * o + 0][j] * g[8 * o + 0], v[8 * o + 1][j] * g[8 * o + 1]); w.y = cvt_pk_bf16(v[8 * o + 2][j] * g[8 * o + 2], v[8 * o + 3][j] * g[8 * o + 3]);
            w.z = cvt_pk_bf16(v[8 * o + 4][j] * g[8 * o + 4], v[8 * o + 5][j] * g[8 * o + 5]); w.w = cvt_pk_bf16(v[8 * o + 6][j] * g[8 * o + 6], v[8 * o + 7][j] * g[8 * o + 7]);
            *(GAS v4u*)(dst + ((size_t)o * NR + j) * 16) = w; }
}
__device__ __forceinline__ void p0a_prologue(const Frame& F0, const Args& a) {
    const Frame F = phase_frame(F0);
    LAS float* scr = (LAS float*)(F.lds + F.wave * 16384);
    const int gw = F.vcu * NWAVES + F.wave, NGW = F.G * NWAVES;
    constexpr int I_MK = (DM / 64) * (2 * MEM_W / 64);
    for (int it = gw; it < I_MK; it += NGW) p0_transpose_item((const float*)a.in[IN_WMEMKV], nullptr, DM, 2 * MEM_W, (bf16*)(F.ws + WS_WMK), 0, scr, it, F.lane);
    { const float* x = (const float*)a.in[IN_X]; char* xb = (char*)(F.ws + WS_XB); float* ssb = (float*)(F.ws + WS_SSB);
      for (int t = gw; t < (SEQ / 16) * 4; t += NGW) {
          const int rg = t >> 2, cq = t & 3, r = F.lane & 15, sb = F.lane >> 4, m = rg * 16 + r; float s = 0.f;
          const float* xr = x + (size_t)m * DM + cq * 1024 + sb * 8;
#pragma unroll 4
          for (int j = 0; j < 32; ++j) { const f32x4 v0 = *(const GAS f32x4*)(xr + 32 * j), v1 = *(const GAS f32x4*)(xr + 32 * j + 4);
              s += ((v0[0] * v0[0] + v0[1] * v0[1]) + (v0[2] * v0[2] + v0[3] * v0[3])) + ((v1[0] * v1[0] + v1[1] * v1[1]) + (v1[2] * v1[2] + v1[3] * v1[3]));
              v4u w; w.x = cvt_pk_bf16(v0[0], v0[1]); w.y = cvt_pk_bf16(v0[2], v0[3]); w.z = cvt_pk_bf16(v1[0], v1[1]); w.w = cvt_pk_bf16(v1[2], v1[3]);
              *(GAS v4u*)(xb + ((size_t)(cq * 128 + 4 * j + sb) * SEQ + m) * 16) = w; }
          s += __shfl_xor(s, 16); s += __shfl_xor(s, 32);
          ssb[(size_t)m * 16 + 4 * sb + cq] = sb == 0 ? s : 0.f; } }
    { const int* pos = (const int*)a.in[IN_POS]; float* cs = (float*)(F.ws + WS_CS);
      const float INV[16] = {1.000000000e+00f, 4.403665960e-01f, 1.939227432e-01f, 8.539710194e-02f, 3.760603070e-02f, 1.656043902e-02f, 7.292664610e-03f, 3.211445874e-03f,
                             1.414213562e-03f, 6.227723788e-04f, 2.742481884e-04f, 1.207697351e-04f, 5.318296098e-05f, 2.341999971e-05f, 1.031338616e-05f, 4.541670478e-06f};
      for (int idx = F.vcu * 512 + F.tid; idx < SEQ * 16; idx += F.G * 512) {
          const int row = idx >> 4, i = idx & 15; float inv = INV[0];
#pragma unroll
          for (int k = 1; k < 16; ++k) inv = (i == k) ? INV[k] : inv;
          const float angf = (float)pos[row] * inv; const double ang = (double)angf;
          const double qd = __builtin_rint(ang * 0.63661977236758134308); const int qi = (int)qd;
          double r = __builtin_fma(-qd, 1.57079632679489655800e+00, ang); r = __builtin_fma(-qd, 6.12323399573676603587e-17, r);
          const double r2 = r * r;
          double sp = -2.5052108385441718775e-08; sp = sp * r2 + 2.7557319223985890653e-06; sp = sp * r2 - 1.9841269841269841253e-04; sp = sp * r2 + 8.3333333333333332177e-03; sp = sp * r2 - 1.6666666666666665741e-01;
          const double sn = r + r * r2 * sp;
          double cp = 2.0876756987868098979e-09; cp = cp * r2 - 2.7557319223985888276e-07; cp = cp * r2 + 2.4801587301587301566e-05; cp = cp * r2 - 1.3888888888888889419e-03; cp = cp * r2 + 4.1666666666666664354e-02; cp = cp * r2 - 0.5;
          const double cn = 1.0 + r2 * cp;
          const int q4 = qi & 3;
          const double c = (q4 == 0) ? cn : (q4 == 1) ? -sn : (q4 == 2) ? -cn : sn;
          const double s = (q4 == 0) ? sn : (q4 == 1) ? cn : (q4 == 2) ? -sn : -cn;
          cs[(size_t)row * 32 + i] = (float)c; cs[(size_t)row * 32 + 16 + i] = (float)s; } }
    { const float* mem = (const float*)a.in[IN_MEM]; const float* gm = (const float*)a.in[IN_GMEM]; bf16* mb = (bf16*)(F.ws + WS_MEMB); float* rsm = (float*)(F.ws + WS_RSM);
      for (int m = gw; m < MEML; m += NGW) {
          const GAS f32x4* xr = (const GAS f32x4*)(mem + (size_t)m * DM) + F.lane; const GAS f32x4* gr = (const GAS f32x4*)gm + F.lane; GAS v2u* o8 = (GAS v2u*)(mb + (size_t)m * DM) + F.lane; float s = 0.f;
#pragma unroll 4
          for (int j = 0; j < 16; ++j) { const f32x4 v = xr[64 * j]; const f32x4 g = gr[64 * j]; s += (v[0] * v[0] + v[1] * v[1]) + (v[2] * v[2] + v[3] * v[3]);
              v2u w; w.x = cvt_pk_bf16(v[0] * g[0], v[1] * g[1]); w.y = cvt_pk_bf16(v[2] * g[2], v[3] * g[3]); o8[64 * j] = w; }
          s = wave_sum(s);
          if (F.lane == 0) rsm[m] = __builtin_amdgcn_rsqf(s * (1.0f / DM) + NORM_EPS); } }
}
__device__ __forceinline__ void p0b_weights(const Frame& F0, const Args& a, int skip) {
    const Frame F = phase_frame(F0);
    if (F.vcu < skip) return;
    LAS float* scr = (LAS float*)(F.lds + F.wave * 16384);
    const int gw = (F.vcu - skip) * NWAVES + F.wave, NGW = (F.G - skip) * NWAVES;
    constexpr int I_IN = (DM / 64) * (PW / 64), I_OUT = (DM / 64) * (DM / 64), I_G = (DM / 64) * (DFF / 64), I_D = (DFF / 64) * (DM / 64);
    constexpr int I_LAYER = I_IN + I_OUT + 2 * I_G + I_D;
    auto desc = [&](int it) -> P0Item {
        const int l = it >= I_LAYER ? 1 : 0; int r = it - l * I_LAYER;
        if (r < I_IN) return P0Item{(const float*)a.in[IN_WIN] + (size_t)l * DM * PW, (const float*)a.in[IN_GATTN] + l * DM, (bf16*)(F.ws + WS_WIN + l * SZ_WIN), DM, PW, 0, r};
        r -= I_IN;
        if (r < I_OUT) return P0Item{(const float*)a.in[IN_WOUT] + (size_t)l * DM * DM, nullptr, (bf16*)(F.ws + WS_WOUT + l * SZ_WOUT), DM, DM, 0, r};
        r -= I_OUT;
        if (r < I_G) return P0Item{(const float*)a.in[IN_WGATE] + (size_t)l * DM * DFF, (const float*)a.in[IN_GFFN] + l * DM, (bf16*)(F.ws + WS_WGU + l * SZ_WGU), DM, DFF, 1, r};
        r -= I_G;
        if (r < I_G) return P0Item{(const float*)a.in[IN_WUP] + (size_t)l * DM * DFF, (const float*)a.in[IN_GFFN] + l * DM, (bf16*)(F.ws + WS_WGU + l * SZ_WGU), DM, DFF, 2, r};
        r -= I_G;
        return P0Item{(const float*)a.in[IN_WDOWN] + (size_t)l * DFF * DM, nullptr, (bf16*)(F.ws + WS_WDN + l * SZ_WDN), DFF, DM, 0, r}; };
    int it = gw;
    if (it < 2 * I_LAYER) {
        f32x4 va[16], vb[16];
        P0Item da = desc(it); p0_item_load(da, F.lane, va);
        for (;;) {
            const int itn = it + NGW; const bool more = itn < 2 * I_LAYER;
            P0Item db = da;
            if (more) { db = desc(itn); p0_item_load(db, F.lane, vb); }
            p0_item_finish(da, va, F.lane);
            if (!more) break;
            it = itn; da = db;
#pragma unroll
            for (int i = 0; i < 16; ++i) va[i] = vb[i];
        }
    }
}

__device__ __forceinline__ void memprep_phase(const Frame& F0, const Args& a, int layer) {
    const Frame F = phase_frame(F0);
    { const float* mkv = (const float*)(F.ws + WS_MKV); bf16* kmn = (bf16*)(F.ws + WS_KMN + (size_t)layer * 524288); bf16* vt = (bf16*)(F.ws + WS_VT);
      const float* gk = (const float*)a.in[IN_GMK] + layer * 256; const float* gq = (const float*)a.in[IN_GMQ] + layer * 256;
      const int gw = F.vcu * NWAVES + F.wave, NGW = F.G * NWAVES;
      for (int t = gw; t < 4 * MEML; t += NGW) { const int h = t >> 8, key = t & 255;
          const f32x4 v = *(const f32x4*)(mkv + (size_t)key * 2048 + h * 256 + F.lane * 4);
          float s = (v[0] * v[0] + v[1] * v[1]) + (v[2] * v[2] + v[3] * v[3]); s = wave_sum(s);
          const float rs = __builtin_amdgcn_rsqf(s * (1.0f / 256.0f) + NORM_EPS);
          const f32x4 g1 = *(const f32x4*)(gk + F.lane * 4), g2 = *(const f32x4*)(gq + F.lane * 4);
          v2u o; o.x = cvt_pk_bf16(v[0] * rs * g1[0] * g2[0], v[1] * rs * g1[1] * g2[1]); o.y = cvt_pk_bf16(v[2] * rs * g1[2] * g2[2], v[3] * rs * g1[3] * g2[3]);
          *(v2u*)(kmn + (size_t)t * 256 + F.lane * 4) = o; }
      for (int idx = F.vcu * 512 + F.tid; idx < 4 * 256 * 256; idx += F.G * 512) { const int hd = idx >> 8, key = idx & 255;
          const float v = mkv[(size_t)key * 2048 + 1024 + hd]; vt[idx] = (bf16)(cvt_pk_bf16(v, 0.f) & 0xffffu); } }
}

__device__ __forceinline__ void gate_phase(const Frame& F0) {
    const Frame F = phase_frame(F0);
    const bf16* proj = (const bf16*)(F.ws + WS_PROJ); const float* ksum = (const float*)(F.ws + WS_KSUM);
    unsigned short* seg = (unsigned short*)(F.ws + WS_SEG); unsigned* cnt = (unsigned*)(F.ws + WS_CNT);
    LAS float* km = (LAS float*)F.lds;
    LAS unsigned* wc = (LAS unsigned*)(F.lds + 16384);
    gu32* qcur = (gu32*)(F.ws + WS_CTL) + CW_GATEQ; volatile LAS int* qit = (volatile LAS int*)(F.lds + 16384 + 1024);
    for (;;) {
        __syncthreads();
        if (F.tid == 0) *qit = (int)__hip_atomic_fetch_add(qcur, 1u, __ATOMIC_RELAXED, __HIP_MEMORY_SCOPE_AGENT);
        __syncthreads();
        const int it = __builtin_amdgcn_readfirstlane(*qit);
        if (it >= NHEAD * (NBLK - 1)) break;
        const int h = it % NHEAD, b0 = NBLK - 1 - it / NHEAD;
        for (int e = F.tid; e < b0 * HD; e += 512) { const int blk = e >> 7, dim = e & 127; const float* kp = ksum + ((size_t)(h * NBLK + blk) * 2) * HD + dim;
            km[e] = (kp[0] + kp[HD]) * (1.0f / 256.0f); }
        __syncthreads();
        int i1 = 32, i2 = 32, i3 = 32;
        const int rib = F.tid >> 1, half = F.tid & 1;
        {
            const int row = b0 * 256 + rib;
            const v4u* qp = (const v4u*)(proj + (size_t)row * PW + h * HD + half * 64);
            v4u q[8];
#pragma unroll
            for (int j = 0; j < 8; ++j) q[j] = qp[j];
            float v1 = -__builtin_inff(), v2 = v1, v3 = v1;
            for (int blk = 0; blk < b0; ++blk) {
                const LAS f32x4* kr = (const LAS f32x4*)(km + blk * HD + half * 64); float g0 = 0.f, g1 = 0.f;
#pragma unroll
                for (int j = 0; j < 8; ++j) { const f32x4 ka = kr[2 * j], kb = kr[2 * j + 1];
                    g0 += bf_lo(q[j].x) * ka[0] + bf_hi(q[j].x) * ka[1] + bf_lo(q[j].y) * ka[2] + bf_hi(q[j].y) * ka[3];
                    g1 += bf_lo(q[j].z) * kb[0] + bf_hi(q[j].z) * kb[1] + bf_lo(q[j].w) * kb[2] + bf_hi(q[j].w) * kb[3]; }
                float gt = g0 + g1; gt += __shfl_xor(gt, 1);
                if (gt > v1) { v3 = v2; i3 = i2; v2 = v1; i2 = i1; v1 = gt; i1 = blk; }
                else if (gt > v2) { v3 = v2; i3 = i2; v2 = gt; i2 = blk; }
                else if (gt > v3) { v3 = gt; i3 = blk; }
            }
            for (int j = 0; j < b0; ++j) { const bool sj = (half == 0) && ((i1 == j) | (i2 == j) | (i3 == j)); const unsigned long long b = __ballot(sj); if (F.lane == 0) wc[j * 8 + F.wave] = (unsigned)__popcll(b); }
        }
        __syncthreads();
        {
            const unsigned long long lt = (1ull << F.lane) - 1ull;
            for (int j = 0; j < b0; ++j) { const bool sj = (half == 0) && ((i1 == j) | (i2 == j) | (i3 == j)); const unsigned long long b = __ballot(sj);
                unsigned base = 0; for (int w = 0; w < F.wave; ++w) base += wc[j * 8 + w];
                if (sj) { const unsigned rank = base + (unsigned)__popcll(b & lt); const unsigned pk = (i1 == j) ? 0u : (i2 == j) ? 1u : 2u;
                    seg[((size_t)(h * 32 + j) * 32 + b0) * 256 + rank] = (unsigned short)((unsigned)rib | (pk << 8)); }
                if (F.tid == 0) { unsigned t = 0; for (int w = 0; w < 8; ++w) t += wc[j * 8 + w]; cnt[(h * 32 + j) * 32 + b0] = t; } }
        }
    }
    __syncthreads();
}
__device__ __forceinline__ void flatten_phase(const Frame& F0) {
    const Frame F = phase_frame(F0);
    const unsigned short* seg = (const unsigned short*)(F.ws + WS_SEG); const unsigned* cnt = (const unsigned*)(F.ws + WS_CNT);
    unsigned short* flat = (unsigned short*)(F.ws + WS_FLAT); unsigned* rj = (unsigned*)(F.ws + WS_RJ);
    const int gw = F.vcu * NWAVES + F.wave, NGW = F.G * NWAVES;
    for (int v = gw; v < NHEAD * 31 * 4; v += NGW) {
        const int ch = v / (NHEAD * 31), it = v - ch * (NHEAD * 31);
        const int h = it / 31, j = it % 31;
        const int gbeg = j + 1 + 8 * ch, gend = (gbeg + 8 < 32) ? gbeg + 8 : 32;
        if (gbeg >= 32) continue;
        const unsigned c = (F.lane < 32 && F.lane > j) ? cnt[(h * 32 + j) * 32 + F.lane] : 0u, pc = (c + 31u) & ~31u;
        unsigned inc = pc;
#pragma unroll
        for (int o = 1; o < 32; o <<= 1) { const unsigned n = __shfl_up(inc, o); if (F.lane >= o) inc += n; }
        const unsigned offl = inc - pc;
        const unsigned total = (unsigned)__builtin_amdgcn_readlane((int)inc, 31), rounds = (total + 255u) >> 8;
        const unsigned long long nz = __ballot(c > 0u);
        unsigned short* fl = flat + (size_t)it * 8192;
        const unsigned short* sbase = seg + (size_t)(h * 32 + j) * 32 * 256;
        for (int g0 = gbeg; g0 < gend; g0 += 4) {
            unsigned ev[4][4];
#pragma unroll
            for (int k = 0; k < 4; ++k) { const int b0 = (g0 + k < gend) ? g0 + k : 31; const unsigned cb = (g0 + k < gend) ? (unsigned)__builtin_amdgcn_readlane((int)c, b0) : 0u, cpb = (cb + 31u) & ~31u;
#pragma unroll
                for (int q = 0; q < 4; ++q) { const unsigned t = (unsigned)F.lane + 64u * q; ev[k][q] = 0u;
                    if (t < cpb) ev[k][q] = (t < cb) ? (unsigned)sbase[b0 * 256 + t] : ((unsigned)sbase[b0 * 256 + (t & ~31u)] | 0x10000u); } }
#pragma unroll
            for (int k = 0; k < 4; ++k) { const int b0 = (g0 + k < gend) ? g0 + k : 31; const unsigned cb = (g0 + k < gend) ? (unsigned)__builtin_amdgcn_readlane((int)c, b0) : 0u, cpb = (cb + 31u) & ~31u;
                const unsigned ob = (unsigned)__builtin_amdgcn_readlane((int)offl, b0);
#pragma unroll
                for (int q = 0; q < 4; ++q) { const unsigned t = (unsigned)F.lane + 64u * q;
                    if (t < cpb) { const unsigned e = ev[k][q]; fl[ob + t] = (unsigned short)((e & 255u) | ((unsigned)b0 << 8) | (((e >> 8) & 3u) << 13) | ((e >> 16) << 15)); } } }
        }
        if (ch != 0) continue;
        if (total > 0u) { const unsigned bf = (unsigned)__builtin_ctzll(nz); const unsigned e0 = sbase[bf * 256];
            const unsigned short fill = (unsigned short)((e0 & 255u) | (bf << 8) | (((e0 >> 8) & 3u) << 13) | 0x8000u);
            for (unsigned idx = total + (unsigned)F.lane; idx < rounds * 256u; idx += 64u) fl[idx] = fill; }
        if (F.lane == 0) rj[it] = rounds;
    }
}

__device__ __forceinline__ att::BlockRef attn_ref_moba(const Frame& F, LAS unsigned* PT, int u, int ug, int wid, int r32, int hi) {
    const bf16* proj = (const bf16*)(F.ws + WS_PROJ); att::BlockRef r; int h, kb; unsigned row, pk, inact;
    if (u < ug) { int lo = 0, hiI = NHEAD * 31;
        while (hiI - lo > 1) { const int mid = (lo + hiI) >> 1; if ((int)PT[mid] <= u) lo = mid; else hiI = mid; }
        const unsigned short* fl = (const unsigned short*)(F.ws + WS_FLAT) + (size_t)lo * 8192;
        const unsigned ent = fl[(unsigned)(u - (int)PT[lo]) * 256u + (unsigned)(wid * 32 + r32)];
        h = lo / 31; kb = lo % 31; row = ent & 0x1fffu; pk = (ent >> 13) & 3u; inact = ent >> 15; r.flags = 3;
    } else { const int v = u - ug; h = v >> 5; kb = v & 31; row = (unsigned)(kb * 256 + wid * 32 + r32); pk = 3u; inact = 0u; r.flags = 2; }
    r.K = proj + (size_t)(kb * 256) * PW + SELF_W + h * HD; r.V = proj + (size_t)(kb * 256) * PW + 2 * SELF_W + h * HD;
    r.O = (char*)(F.ws + WS_PARTO) + (size_t)h * SEQ * 4 * HD * 2; r.ML = (float*)(F.ws + WS_PARTML) + (size_t)h * SEQ * 4 * 2;
    r.qoff = (unsigned)(row * PW + h * HD + hi * 8) * 2u; r.pinfo = (row * 4u + pk) | (inact << 31);
    r.P0 = 0; r.NT = 4;
    return r;
}
__device__ __forceinline__ void attn_phase_moba(const Frame& F0) {
    if (F0.G != 256) return;
    const Frame F = phase_frame(F0);
    char* lds = F.ldsg; const char* qbase = (const char*)(F.ws + WS_PROJ);
    const int wid = F.wave, r32 = F.lane & 31, hi = F.lane >> 5;
    LAS unsigned* PT = (LAS unsigned*)(F.lds + 73728);
    { const unsigned* rj = (const unsigned*)(F.ws + WS_RJ);
      for (int i = F.tid; i < NHEAD * 31; i += 512) PT[i + 1] = rj[i];
      __syncthreads();
      if (F.wave == 0) {
          unsigned v[12], t = 0u;
#pragma unroll
          for (int k = 0; k < 12; ++k) { const int i = F.lane * 12 + k; v[k] = (i < NHEAD * 31) ? PT[i + 1] : 0u; t += v[k]; }
          unsigned inc = t;
#pragma unroll
          for (int o = 1; o < 64; o <<= 1) { const unsigned n = __shfl_up(inc, o); if (F.lane >= o) inc += n; }
          unsigned a = inc - t;
#pragma unroll
          for (int k = 0; k < 12; ++k) { const int i = F.lane * 12 + k; a += v[k]; if (i < NHEAD * 31) PT[i + 1] = a; }
          if (F.lane == 0) PT[0] = 0u; }
      __syncthreads(); }
    const int ug = (int)PT[NHEAD * 31], U = ug + NHEAD * NBLK;
    int u = ((F.vcu & 31) >= 16) ? (F.vcu >> 5) * 16 + (F.vcu & 31) - 16 : 128 + (F.vcu >> 5) * 16 + (F.vcu & 31);
    att::Seam S;
    att::BlockRef cur = attn_ref_moba(F, PT, u, ug, wid, r32, hi);
    att::attn_prime(cur, qbase, lds, S, F.tid);
    for (;;) {
        const int un = u + F.G; const bool more = un < U;
        att::BlockRef nxt = cur;
        if (more) nxt = attn_ref_moba(F, PT, un, ug, wid, r32, hi);
        att::attn_block(cur, nxt, qbase, lds, S, F.tid);
        if (!more) break;
        cur = nxt; u = un;
    }
    VM_WAIT(); __builtin_amdgcn_s_waitcnt(0); __syncthreads();
}
__device__ __forceinline__ att2::Ref attn_ref_diff(const Frame& F, int i, int s, int r32, int hi) {
    const bf16* proj = (const bf16*)(F.ws + WS_PROJ); att2::Ref r;
    const int sh = (F.vcu >> 5) * 3 + (i >> 1), pr = F.vcu & 31, x = (i & 1) ? pr : 63 - pr;
    r.K = proj + SELF_W + sh * HD; r.V = proj + 2 * SELF_W + (sh >> 1) * 256;
    r.O = (char*)((bf16*)(F.ws + WS_OP) + (size_t)(x * 128) * OPW + sh * 256);
    r.qoff = (unsigned)((x * 128 + s * 32 + r32) * PW + sh * HD + hi * 8) * 2u; r.P0 = x * 128; r.NT = 2 * x + 2; r.desc = i & 1;
    return r;
}
__device__ __forceinline__ void attn_phase_diff(const Frame& F0) {
    if (F0.G != 256) return;
    const Frame F = phase_frame(F0);
    char* lds = F.ldsg; const char* qbase = (const char*)(F.ws + WS_PROJ);
    const int s = F.wave & 3, r32 = F.lane & 31, hi = F.lane >> 5;
    auto ref = [&](int i) { return attn_ref_diff(F, i, s, r32, hi); };
    int G = 0; for (int i = 0; i < 6; ++i) G += attn_ref_diff(F, i, s, r32, hi).NT;
    if (F.wave < 4) att2::score_stream(ref, 6, G, qbase, lds, F.tid);
    else att2::helper_stream(ref, 6, G, lds, F.tid);
    VM_WAIT(); __builtin_amdgcn_s_waitcnt(0); __syncthreads();
}
__device__ __forceinline__ void moba_merge_phase(const Frame& F0) {
    const Frame F = phase_frame(F0);
    const bf16* po = (const bf16*)(F.ws + WS_PARTO); const float* pml = (const float*)(F.ws + WS_PARTML); bf16* att_o = (bf16*)(F.ws + WS_ATT);
    constexpr float C2 = 1.4426950408889634f * att::SCALE;
    const int gw = F.vcu * NWAVES + F.wave, NGW = F.G * NWAVES, hq = F.lane >> 4, d8 = (F.lane & 15) * 8;
    for (int it = gw; it < SEQ * 2; it += NGW) {
        const int row = it >> 1, hb = (it & 1) * 3, nv = (row >> 8) < 3 ? (row >> 8) : 3;
        f32x4 ml01[3], ml23[3]; v4u ov[3][4];
#pragma unroll
        for (int q = 0; q < 3; ++q) { const size_t slot = ((size_t)((hb + q) * 4 + hq) * SEQ + row) * 4;
            ml01[q] = *(const f32x4*)(pml + slot * 2); ml23[q] = *(const f32x4*)(pml + slot * 2 + 4);
#pragma unroll
            for (int p4 = 0; p4 < 4; ++p4) ov[q][p4] = *(const v4u*)(po + (slot + p4) * HD + d8); }
#pragma unroll
        for (int q = 0; q < 3; ++q) { const int h = (hb + q) * 4 + hq;
            const float mp[4] = {ml01[q][0], ml01[q][2], ml23[q][0], ml23[q][2]}, lp[4] = {ml01[q][1], ml01[q][3], ml23[q][1], ml23[q][3]};
            float M = mp[3];
#pragma unroll
            for (int p4 = 0; p4 < 3; ++p4) M = (p4 < nv) ? fmaxf(M, mp[p4]) : M;
            float w[4], ws = 0.f;
#pragma unroll
            for (int p4 = 0; p4 < 4; ++p4) { w[p4] = (p4 == 3 || p4 < nv) ? lp[p4] * __builtin_amdgcn_exp2f((mp[p4] - M) * C2) : 0.f; ws += w[p4]; }
            const float rw = 1.0f / ws; float acc[8];
#pragma unroll
            for (int k = 0; k < 8; ++k) acc[k] = 0.f;
#pragma unroll
            for (int p4 = 0; p4 < 4; ++p4) { if (p4 == 3 || p4 < nv) { const float wp = w[p4] * rw; const v4u x = ov[q][p4];
                acc[0] += wp * bf_lo(x.x); acc[1] += wp * bf_hi(x.x); acc[2] += wp * bf_lo(x.y); acc[3] += wp * bf_hi(x.y);
                acc[4] += wp * bf_lo(x.z); acc[5] += wp * bf_hi(x.z); acc[6] += wp * bf_lo(x.w); acc[7] += wp * bf_hi(x.w); } }
            v4u o; o.x = cvt_pk_bf16(acc[0], acc[1]); o.y = cvt_pk_bf16(acc[2], acc[3]); o.z = cvt_pk_bf16(acc[4], acc[5]); o.w = cvt_pk_bf16(acc[6], acc[7]);
            *(v4u*)(att_o + (size_t)row * OPW + h * HD + d8) = o; }
    }
}

__device__ __forceinline__ void diff_combine_phase(const Frame& F0, const Args& a) {
    const Frame F = phase_frame(F0);
    const bf16* op = (const bf16*)(F.ws + WS_OP); bf16* att_o = (bf16*)(F.ws + WS_ATT);
    float d1 = 0.f, d2 = 0.f;
    { const float* q1 = (const float*)a.in[IN_LQ1]; const float* k1 = (const float*)a.in[IN_LK1]; const float* q2 = (const float*)a.in[IN_LQ2]; const float* k2 = (const float*)a.in[IN_LK2];
      d1 = q1[F.lane] * k1[F.lane] + q1[F.lane + 64] * k1[F.lane + 64]; d2 = q2[F.lane] * k2[F.lane] + q2[F.lane + 64] * k2[F.lane + 64];
      d1 = wave_sum(d1); d2 = wave_sum(d2); }
    const float lam = __expf(d1) - __expf(d2) + LAM_INIT;
    const f32x4 gs = *(const f32x4*)((const float*)a.in[IN_GSUB] + F.lane * 4);
    const int gw = F.vcu * NWAVES + F.wave, NGW = F.G * NWAVES;
    v2u w0[12], w1[12], n0[12], n1[12];
    if (gw < SEQ) { const bf16* orow = op + (size_t)gw * OPW + F.lane * 4;
#pragma unroll
        for (int h = 0; h < 12; ++h) { w0[h] = *(const v2u*)(orow + (h * 2 + 0) * 256); w1[h] = *(const v2u*)(orow + (h * 2 + 1) * 256); } }
    for (int row = gw; row < SEQ; row += NGW) {
        { const int nr = (row + NGW < SEQ) ? row + NGW : row; const bf16* orow = op + (size_t)nr * OPW + F.lane * 4;
#pragma unroll
          for (int h = 0; h < 12; ++h) { n0[h] = *(const v2u*)(orow + (h * 2 + 0) * 256); n1[h] = *(const v2u*)(orow + (h * 2 + 1) * 256); } }
#pragma unroll
        for (int h = 0; h < 12; ++h) {
            float o[4] = {bf_lo(w0[h].x) - lam * bf_lo(w1[h].x), bf_hi(w0[h].x) - lam * bf_hi(w1[h].x), bf_lo(w0[h].y) - lam * bf_lo(w1[h].y), bf_hi(w0[h].y) - lam * bf_hi(w1[h].y)};
            float s = (o[0] * o[0] + o[1] * o[1]) + (o[2] * o[2] + o[3] * o[3]); s = wave_sum(s);
            const float rs = __builtin_amdgcn_rsqf(s * (1.0f / 256.0f) + SUBLN_EPS) * (1.0f - LAM_INIT);
            v2u r; r.x = cvt_pk_bf16(o[0] * rs * gs[0], o[1] * rs * gs[1]); r.y = cvt_pk_bf16(o[2] * rs * gs[2], o[3] * rs * gs[3]);
            *(v2u*)(att_o + (size_t)row * OPW + h * 256 + F.lane * 4) = r;
        }
#pragma unroll
        for (int h = 0; h < 12; ++h) { w0[h] = n0[h]; w1[h] = n1[h]; }
    }
}

constexpr int N_PHASES = 2 + 2 * 9;
__global__ void __launch_bounds__(NWAVES * 64, 2) hybrid_fwd(Args args) {
    extern __shared__ __attribute__((aligned(16))) unsigned char lds[];
    Frame F;
    F.lds = (LAS unsigned char*)lds; F.ldsg = (char*)lds; F.ws = args.ws;
    F.tid = threadIdx.x; F.lane = F.tid & 63; F.wave = __builtin_amdgcn_readfirstlane(F.tid >> 6);
    asm volatile("" : "+s"(F.wave));
    F.G = gridDim.x; { const int bx = blockIdx.x; F.vcu = (F.G % 8 == 0) ? (bx % 8) * (F.G / 8) + bx / 8 : bx; }
    volatile LAS unsigned* MISC = (volatile LAS unsigned*)(F.lds + MISC_OFF);
    for (int u = F.tid; u < 64; u += NWAVES * 64) MISC[u] = 0u;
    __syncthreads();
    const int lo = args.ph_lo, hi = args.ph_hi;
    const bool one = (hi - lo) > 1;
    gu32* ctl = (gu32*)(args.ws + WS_CTL);
    XcdBarrier bar; bar.bar = (unsigned*)(ctl + CW_BAR); bar.x = 0; bar.st = nullptr;
    if (one) bar = xcd_barrier_post((unsigned*)(ctl + CW_BAR), MISC + 8);
#ifndef PH_MASK
#define PH_MASK 0xffff
#endif
#define IN(k) (lo <= (k) && (k) < hi)
#define EN(b) ((PH_MASK >> (b)) & 1)
#ifndef PROBE_ATT
#define PROBE_ATT -1
#endif
#ifndef PROBE_OUT
#define PROBE_OUT 0
#endif
#ifndef PROBE_DUP
#define PROBE_DUP 0
#endif
#ifndef PROBE_ID
#define PROBE_ID 0
#endif
#define DUP(id) _Pragma("unroll") for (int rp_ = 0; rp_ < ((PROBE_ID == (id)) ? 2 : 1); ++rp_)
#define REP(b) _Pragma("unroll") for (int rep_ = 0; rep_ < (((PROBE_DUP >> (b)) & 1) ? 2 : 1); ++rep_)
#define SEAM0(k) do { if (IN(k) && IN((k) + 1)) { XcdBarrier b2_ = bar; size_t bz_ = 0; asm volatile("" : "+s"(bz_)); b2_.bar = bar.bar + bz_; xcd_barrier(b2_); } } while (0)
#define SEAM(k) do { if (IN(k) && IN((k) + 1)) xcd_barrier_slim((gu32*)bar.bar, bar.x, bar.st, F.wave == 0 && lane_id_now() == 0); } while (0)
    float* xout = args.out;
    PG8_LAS float* exch = (PG8_LAS float*)(F.lds + EXCH_OFF);
#define WSP(T, off) ((T*)(wsl + (off)))
#define WS_LOCAL() size_t wz_ = 0; asm volatile("" : "+s"(wz_)); unsigned char* wsl = args.ws + wz_

    if (EN(0) && IN(0)) { p0a_prologue(F, args); }
    SEAM0(0);
    if (EN(0) && IN(1)) {
        const int skip = F.G > 16 ? 8 : 0;
        { WS_LOCAL();
          pg8::Gemm g{WSP(bf16, WS_MEMB), WSP(const bf16, WS_WMK), MEML, 2 * MEM_W, DM, DM, DM, 0}; pg8::StaticOrder S; S.init(MEML, 2 * MEM_W, F.G, F.vcu);
          pg8::EpiMKV E{WSP(float, WS_MKV), 2 * MEM_W, WSP(const float, WS_RSM)};
          pg8::gemm_phase<pg8::EpiMKV, pg8::StaticOrder>(F.lds, g, S, E, F.wave); }
        __syncthreads();
        DUP(1) p0b_weights(F, args, skip);
    }
    SEAM(1);
#pragma unroll 1
    for (int l = 0; l < 2; ++l) {
        const int pb = 2 + 9 * l;
        if (EN(1) && IN(pb + 0)) DUP(2) {
            WS_LOCAL();
            pg8::Gemm g{WSP(bf16, WS_XB), WSP(const bf16, WS_WIN + l * SZ_WIN), SEQ, PW, DM, DM, DM, 0, 1}; pg8::StaticOrder S; S.init(SEQ, PW, F.G, (int)blockIdx.x);
            pg8::EpiProjN E{WSP(bf16, WS_PROJ), PW, WSP(float, WS_SSB), 1.0f / DM, NORM_EPS, exch, (PG8_LAS float*)(F.lds + MISC_OFF + 256), (const float*)args.in[IN_GQ] + l * HD, (const float*)args.in[IN_GK] + l * HD,
                            (const int*)args.in[IN_POS], l == 0 ? WSP(float, WS_KSUM) : nullptr};
            pg8::gemm_phase<pg8::EpiProjN, pg8::StaticOrder>(F.lds, g, S, E, F.wave);
        }
        SEAM(pb + 0);
        if (l == 0) {
            if (EN(3) && IN(pb + 2)) DUP(3) { memprep_phase(F, args, 0); memprep_phase(F, args, 1); gate_phase(F); }
            SEAM(pb + 2);
        }
        if (l == 0) { if (IN(pb + 3)) DUP(4) flatten_phase(F); SEAM(pb + 3); }
        if (IN(pb + 4)) {
            if (EN(4)) DUP(5) { WS_LOCAL();
              pg8::Gemm g{WSP(bf16, WS_PROJ) + 3 * SELF_W, WSP(const bf16, WS_KMN + l * 524288), SEQ, MEM_W, 256, PW, 256, 256}; pg8::StaticOrder S; S.init(SEQ, MEM_W, F.G, (int)blockIdx.x);
              pg8::EpiMemS E{WSP(bf16, WS_PM), WSP(float, WS_PS)};
              pg8::gemm_phase<pg8::EpiMemS, pg8::StaticOrder>(F.lds, g, S, E, F.wave); }
            __syncthreads();
            if (EN(5)) { if (l == 0) DUP(6) attn_phase_moba(F); else DUP(7) attn_phase_diff(F); }
        }
        SEAM(pb + 4);
        if (IN(pb + 5)) {
            if (EN(6)) DUP(8) { WS_LOCAL();
              pg8::Gemm g{WSP(bf16, WS_PM), WSP(const bf16, WS_VT), SEQ, MEM_W, 256, MEM_W, 256, 256}; pg8::StaticOrder S; S.init(SEQ, MEM_W, F.G, (int)blockIdx.x);
              pg8::EpiMemO E{WSP(bf16, WS_ATT), WSP(float, WS_PS)};
              pg8::gemm_phase<pg8::EpiMemO, pg8::StaticOrder>(F.lds, g, S, E, F.wave); }
            if (EN(7)) { if (l == 0) DUP(9) moba_merge_phase(F); else DUP(10) diff_combine_phase(F, args); }
        }
        SEAM(pb + 5);
        if (EN(8) && IN(pb + 6)) {
            WS_LOCAL();
            pg8::Gemm g{WSP(bf16, WS_ATT), WSP(const bf16, WS_WOUT + l * SZ_WOUT), SEQ, DM, DM, OPW, DM, 0, 1}; pg8::StaticOrder S; S.init(SEQ, DM, F.G, (int)blockIdx.x);
            pg8::EpiRes<false> E{nullptr, nullptr, WSP(bf16, WS_XB), WSP(float, WS_SSA), DM, exch};
            pg8::gemm_phase<pg8::EpiRes<false>, pg8::StaticOrder>(F.lds, g, S, E, F.wave);
        }
        SEAM(pb + 6);
        if (EN(9) && IN(pb + 7)) REP(9) {
            WS_LOCAL();
            pg8::Gemm g{WSP(bf16, WS_XB), WSP(const bf16, WS_WGU + l * SZ_WGU), SEQ, NGU, DM, DM, DM, 0, 1}; pg8::StaticOrder S; S.init(SEQ, NGU, F.G, (int)blockIdx.x);
            pg8::EpiGU E{WSP(bf16, WS_HID), DFF, WSP(float, WS_SSA), 1.0f / DM, NORM_EPS, (PG8_LAS float*)(F.lds + MISC_OFF + 256)};
            pg8::gemm_phase<pg8::EpiGU, pg8::StaticOrder>(F.lds, g, S, E, F.wave);
        }
        SEAM(pb + 7);
        if (EN(10) && IN(pb + 8)) {
            WS_LOCAL();
            pg8::Gemm g{WSP(bf16, WS_HID), WSP(const bf16, WS_WDN + l * SZ_WDN), SEQ, DM, DFF, DFF, DFF, 0, 1}; pg8::StaticOrder S; S.init(SEQ, DM, F.G, (int)blockIdx.x);
            pg8::EpiRes<true> E{nullptr, l == 1 ? xout : (float*)nullptr, WSP(bf16, WS_XB), WSP(float, WS_SSB), DM, exch};
            pg8::gemm_phase<pg8::EpiRes<true>, pg8::StaticOrder>(F.lds, g, S, E, F.wave);
        }
        SEAM(pb + 8);
    }
#undef IN
#undef SEAM
#undef SEAM0
}

extern "C" void kernel_launch(void* const* d_in, const int* in_sizes, int n_in, void* d_out, int out_size, void* d_ws, size_t ws_size, hipStream_t stream) {
    static int grid = 0;
    if (grid == 0) {
        if (n_in != N_IN || in_sizes[0] != SEQ * DM || out_size != SEQ * DM || ws_size < WS_END) {
            fprintf(stderr, "kernel_launch: unexpected shapes (n_in %d, in0 %d, out %d, ws %zu < %zu); nothing launched\n", n_in, n_in > 0 ? in_sizes[0] : -1, out_size, ws_size, (size_t)WS_END); grid = -1; return; }
        int dev = 0, cus = 0, per_cu = 0;
        if (hipGetDevice(&dev) != hipSuccess || hipDeviceGetAttribute(&cus, hipDeviceAttributeMultiprocessorCount, dev) != hipSuccess) { grid = -1; return; }
        if (hipFuncSetAttribute((const void*)hybrid_fwd, hipFuncAttributeMaxDynamicSharedMemorySize, LDS_BYTES) != hipSuccess) { fprintf(stderr, "kernel_launch: hipFuncSetAttribute failed\n"); grid = -1; return; }
        if (hipOccupancyMaxActiveBlocksPerMultiprocessor(&per_cu, (const void*)hybrid_fwd, NWAVES * 64, LDS_BYTES) != hipSuccess || per_cu < 1)
            fprintf(stderr, "kernel_launch: note: occupancy query reports %d workgroups per CU\n", per_cu);
        (void)hipGetLastError();
        grid = cus;
        if (grid != 256) fprintf(stderr, "kernel_launch: %d CUs; the attention phase is dealt for 256\n", grid);
    }
    if (grid < 0) return;
    if (hipMemsetAsync((char*)d_ws + WS_CTL, 0, CTL_ZERO_BYTES, stream) != hipSuccess) return;
    Args a{};
    for (int i = 0; i < N_IN; ++i) a.in[i] = d_in[i];
    a.out = (float*)d_out; a.ws = (unsigned char*)d_ws;
#if MK_ONE_LAUNCH
    a.ph_lo = 0; a.ph_hi = N_PHASES;
    hipLaunchKernelGGL(hybrid_fwd, dim3(grid), dim3(NWAVES * 64), LDS_BYTES, stream, a);
#else
    for (int p = 0; p < N_PHASES; ++p) {
        if (p == 2 + 1 || p == 2 + 9 + 1 || p == 2 + 9 + 3) continue;
        a.ph_lo = p; a.ph_hi = p + 1;
        hipLaunchKernelGGL(hybrid_fwd, dim3(grid), dim3(NWAVES * 64), LDS_BYTES, stream, a);
    }
#endif
}
```

```cpp
#include <hip/hip_runtime.h>
#include <cstdio>
#include <cstdint>

#ifndef MK_ONE_LAUNCH
#define MK_ONE_LAUNCH 1
#endif

constexpr int SEQ = 8192, DM = 4096, PW = 10240, SELF_W = 3072, MEM_W = 1024, DFF = 11008, NGU = 2 * DFF, MEML = 256, HD = 128;
constexpr int NHEAD = 24;
constexpr int NBLK = SEQ / 256;
constexpr int OPW = 48 * HD;
constexpr float NORM_EPS = 1e-6f, SUBLN_EPS = 1e-5f;
constexpr float LAM_INIT = 0.35550906759096934f;

enum { IN_X = 0, IN_MEM, IN_POS, IN_GATTN, IN_WIN, IN_WOUT, IN_GQ, IN_GK, IN_GMQ, IN_GMK, IN_GMEM, IN_WMEMKV, IN_LQ1, IN_LK1, IN_LQ2, IN_LK2, IN_GSUB, IN_GFFN, IN_WGATE, IN_WUP, IN_WDOWN, N_IN };

constexpr size_t MiB = 1u << 20;
constexpr size_t SZ_WIN = (size_t)PW * DM * 2, SZ_WOUT = (size_t)DM * DM * 2, SZ_WGU = (size_t)NGU * DM * 2, SZ_WDN = (size_t)DM * DFF * 2;
constexpr size_t WS_CTL = 0, CTL_ZERO_BYTES = 64 * 1024;
constexpr size_t WS_WIN = 1 * MiB;
constexpr size_t WS_WOUT = WS_WIN + 2 * SZ_WIN;
constexpr size_t WS_WGU = WS_WOUT + 2 * SZ_WOUT;
constexpr size_t WS_WDN = WS_WGU + 2 * SZ_WGU;
constexpr size_t WS_XB = WS_WDN + 2 * SZ_WDN;
constexpr size_t WS_PROJ = WS_XB + (size_t)SEQ * DM * 2;
constexpr size_t WS_ATT = WS_PROJ + (size_t)SEQ * PW * 2;
constexpr size_t WS_HID = WS_ATT + (size_t)SEQ * OPW * 2;
constexpr size_t WS_OP = WS_HID + (size_t)SEQ * DFF * 2;
constexpr size_t WS_PM = WS_OP + (size_t)SEQ * OPW * 2;
constexpr size_t WS_SSA = WS_PM + (size_t)SEQ * MEM_W * 2;
constexpr size_t WS_SSB = WS_SSA + 1 * MiB;
constexpr size_t WS_CS = WS_SSB + 1 * MiB;
constexpr size_t WS_MKV = WS_CS + 1 * MiB;
constexpr size_t WS_KMN = WS_MKV + 2 * MiB;
constexpr size_t WS_VT = WS_KMN + 1 * MiB;
constexpr size_t WS_KSUM = WS_VT + 1 * MiB;
constexpr size_t WS_SEG = WS_KSUM + 2 * MiB;
constexpr size_t WS_CNT = WS_SEG + (size_t)NHEAD * 32 * 32 * 256 * 2;
constexpr size_t WS_FLAT = WS_CNT + 1 * MiB;
constexpr size_t WS_RJ = WS_FLAT + (size_t)NHEAD * 31 * 8192 * 2;
constexpr size_t WS_PARTO = WS_RJ + 1 * MiB;
constexpr size_t WS_PARTML = WS_PARTO + (size_t)NHEAD * SEQ * 4 * HD * 2;
constexpr size_t WS_PS = WS_PARTML + (size_t)NHEAD * SEQ * 4 * 2 * 4;
constexpr size_t WS_WMK = WS_PS + 1 * MiB;
constexpr size_t WS_MEMB = WS_WMK + (size_t)2 * MEM_W * DM * 2;
constexpr size_t WS_RSM = WS_MEMB + (size_t)MEML * DM * 2;
constexpr size_t WS_END = WS_RSM + 1 * MiB;
constexpr int CW_TMO = 0, CW_GATEQ = 64, CW_BAR = 4096;

constexpr int RING_BYTES = 131072;
constexpr int EXCH_OFF = RING_BYTES;
constexpr int MISC_OFF = EXCH_OFF + 8192;
constexpr int LDS_BYTES = 147456;
static_assert(MISC_OFF + 256 + 2048 <= LDS_BYTES, "LDS map");

#define GAS __attribute__((address_space(1)))
#define LAS __attribute__((address_space(3)))
typedef unsigned short bf16;
typedef unsigned v4u __attribute__((ext_vector_type(4)));
typedef unsigned v2u __attribute__((ext_vector_type(2)));
typedef float f32x4 __attribute__((ext_vector_type(4)));
typedef float f32x2 __attribute__((ext_vector_type(2)));
typedef float f32x16 __attribute__((ext_vector_type(16)));
typedef short bf16x8 __attribute__((ext_vector_type(8)));
typedef short s16x4 __attribute__((ext_vector_type(4)));
typedef GAS unsigned gu32;
#define RLX_AGENT __ATOMIC_RELAXED, __HIP_MEMORY_SCOPE_AGENT
#define LDS_WAIT() asm volatile("s_waitcnt lgkmcnt(0)" ::: "memory")
#define VM_WAIT() asm volatile("s_waitcnt vmcnt(0)" ::: "memory")

__device__ __forceinline__ unsigned cvt_pk_bf16(float lo, float hi) { unsigned r; asm volatile("v_cvt_pk_bf16_f32 %0, %1, %2" : "=v"(r) : "v"(lo), "v"(hi)); return r; }
__device__ __forceinline__ float bf_lo(unsigned w) { return __uint_as_float(w << 16); }
__device__ __forceinline__ float bf_hi(unsigned w) { return __uint_as_float(w & 0xffff0000u); }
__device__ __forceinline__ float wave_sum(float v) {
#pragma unroll
    for (int o = 1; o < 64; o <<= 1) v += __shfl_xor(v, o);
    return v;
}

namespace pg8 {
#define PG8_LAS __attribute__((address_space(3)))
typedef unsigned short bf16_t;
typedef unsigned u32x4 __attribute__((ext_vector_type(4)));
constexpr int BM = 256, BK = 64, HALF = 128, HTB = HALF * BK * 2, STAGE_BYTES = 8 * HTB, NXCD = 8, WGM = 8;

__host__ __device__ __forceinline__ int lds_byte(int r, int c) { const int st = (r >> 4) * 2 + (c >> 5), rr = r & 15, cc = c & 31, ob = rr * 64 + cc * 2; return st * 1024 + (ob ^ (((ob >> 9) & 1) << 5)); }
__host__ __device__ __forceinline__ void stage_rc(int b, int& R, int& C) { const int st = b / 1024, sb = b % 1024, swz = sb ^ (((sb >> 9) & 1) << 5); R = (st >> 1) * 16 + swz / 64; C = (st & 1) * 32 + (swz % 64) / 2; }
__host__ __device__ __forceinline__ int perm32(int rho) { const int n = rho >> 4, i = rho & 15; return 8 * (i >> 2) + 4 * n + (i & 3); }

struct Unit { int pm, pn; };
struct Gemm { const bf16_t* A; const bf16_t* Bt; int M, N, K, lda, ldb, a_pn_step, b_oct; };

struct StaticOrder {
    int nM, nN, nwg, G, c;
    __host__ __device__ void init(int M, int N, int G_, int c_) { nM = M / BM; nN = N / BM; nwg = nM * nN; G = G_; c = c_; }
    __host__ __device__ bool next(int i, Unit& u) const {
        const long L = (long)i * G + c; if (L >= nwg) return false;
        int wgid = (int)L; { const int q = nwg / NXCD, r = nwg % NXCD, xcd = wgid % NXCD, off = wgid / NXCD; wgid = (xcd < r ? xcd * (q + 1) : r * (q + 1) + (xcd - r) * q) + off; }
        const int nig = WGM * nN, gid = wgid / nig, fm = gid * WGM, gsz = (nM - fm) < WGM ? (nM - fm) : WGM;
        u.pm = fm + ((wgid % nig) % gsz); u.pn = (wgid % nig) / gsz; return true;
    }
    __device__ __forceinline__ void a_ready(const Unit&) const {}
    __device__ __forceinline__ void done(const Unit&) const {}
};

__device__ __forceinline__ float row_rstd(const float* ss, int row, float inv_d, float eps) {
    const f32x4* sp = (const f32x4*)(ss + (size_t)row * 16);
    const f32x4 a = sp[0], b = sp[1], c = sp[2], d = sp[3];
    const float t = ((a[0] + a[1]) + (a[2] + a[3])) + ((b[0] + b[1]) + (b[2] + b[3])) + ((c[0] + c[1]) + (c[2] + c[3])) + ((d[0] + d[1]) + (d[2] + d[3]));
    return __builtin_amdgcn_rsqf(t * inv_d + eps);
}
struct EpiProj {
    static constexpr bool PERM = true, AFTER_DRAIN = false, BOCT = false, AOCT = false;
    bf16_t* O; int ldc; const float* ss; float inv_d, eps;
    __device__ __forceinline__ void operator()(const f32x4 (&acc)[2][2][4][2], const Unit& u, int wr, int wc, int fr, int fq) const {
        const int row0 = u.pm * BM + wr * 64 + fr, col0 = u.pn * BM + wc * 32 + 8 * fq;
#pragma unroll
        for (int ai = 0; ai < 2; ++ai)
#pragma unroll
            for (int m = 0; m < 4; ++m) { const int row = row0 + ai * HALF + m * 16; const float rs = row_rstd(ss, row, inv_d, eps);
                bf16_t* rowp = O + (size_t)row * ldc + col0;
#pragma unroll
                for (int bj = 0; bj < 2; ++bj) { const f32x4 v0 = acc[ai][bj][m][0] * rs, v1 = acc[ai][bj][m][1] * rs;
                    u32x4 w; w.x = cvt_pk_bf16(v0[0], v0[1]); w.y = cvt_pk_bf16(v0[2], v0[3]); w.z = cvt_pk_bf16(v1[0], v1[1]); w.w = cvt_pk_bf16(v1[2], v1[3]);
                    *(u32x4*)(rowp + bj * HALF) = w; } }
    }
};
struct EpiProjN {
    static constexpr bool PERM = true, AFTER_DRAIN = false, BOCT = true, AOCT = true;
    bf16_t* O; int ldc; const float* ss; float inv_d, eps; PG8_LAS float* exch; PG8_LAS float* tab; const float* gq; const float* gk; const int* pos; float* ksum;
    static __device__ __forceinline__ float shx(float x, int lane_, int mask) { return __builtin_bit_cast(float, __builtin_amdgcn_ds_bpermute((lane_ ^ mask) << 2, __builtin_bit_cast(int, x))); }
    __device__ __forceinline__ void operator()(const f32x4 (&acc)[2][2][4][2], const Unit& u, int wr, int wc, int fr_in, int fq_in) const {
        int fr = fr_in, fq = fq_in; asm volatile("" : "+v"(fr), "+v"(fq));
        const int lane_ = fr + 16 * fq;
        const int row0 = u.pm * BM + wr * 64 + fr, col0 = u.pn * BM + wc * 32 + 8 * fq;
        char* Ob = (char*)O; const unsigned off0 = (unsigned)(row0 * PW + col0) * 2u;
        const int typ = u.pn < 12 ? 0 : u.pn < 24 ? 1 : u.pn < 36 ? 2 : 3;
        if (typ == 2) {
#pragma unroll
            for (int ai = 0; ai < 2; ++ai)
#pragma unroll
                for (int m = 0; m < 4; ++m) { const int row = row0 + ai * HALF + m * 16; const float rs = row_rstd(ss, row, inv_d, eps);
#pragma unroll
                    for (int bj = 0; bj < 2; ++bj) { const f32x4 v0 = acc[ai][bj][m][0] * rs, v1 = acc[ai][bj][m][1] * rs;
                        u32x4 w; w.x = cvt_pk_bf16(v0[0], v0[1]); w.y = cvt_pk_bf16(v0[2], v0[3]); w.z = cvt_pk_bf16(v1[0], v1[1]); w.w = cvt_pk_bf16(v1[2], v1[3]);
                        *(u32x4*)(Ob + (off0 + (unsigned)(((ai * HALF + m * 16) * PW + bj * HALF) * 2))) = w; } }
            return;
        }
#pragma unroll
        for (int ai = 0; ai < 2; ++ai)
#pragma unroll
            for (int m = 0; m < 4; ++m)
#pragma unroll
                for (int bj = 0; bj < 2; ++bj) { const f32x4 v0 = acc[ai][bj][m][0], v1 = acc[ai][bj][m][1];
                    float q = (v0[0] * v0[0] + v0[1] * v0[1]) + (v0[2] * v0[2] + v0[3] * v0[3]) + (v1[0] * v1[0] + v1[1] * v1[1]) + (v1[2] * v1[2] + v1[3] * v1[3]);
                    q += shx(q, lane_, 16); q += shx(q, lane_, 32);
                    if (fq == 0) exch[((ai * HALF + wr * 64 + m * 16 + fr) * 2 + bj) * 4 + wc] = q; }
        { const int t = (wr * 4 + wc) * 64 + fq * 16 + fr;
          if (t < 256) { tab[t] = row_rstd(ss, u.pm * BM + t, inv_d, eps); tab[256 + t] = __int_as_float(pos[u.pm * BM + t]); } }
        asm volatile("s_waitcnt lgkmcnt(0)" ::: "memory"); __builtin_amdgcn_s_barrier(); asm volatile("" ::: "memory");
        f32x4 g0 = {1.f, 1.f, 1.f, 1.f}, g1 = g0;
        if (typ < 2) { const float* gp = (typ == 0 ? gq : gk) + wc * 32 + 8 * fq; g0 = *(const f32x4*)gp; g1 = *(const f32x4*)(gp + 4); }
        if (typ == 0 && ksum == nullptr) { constexpr float QS = 0.08838834764831845f * 1.4426950408889634f; g0 = g0 * QS; g1 = g1 * QS; }
        const bool hi8 = (fq & 1) != 0;
        float ks[2][8];
#pragma unroll
        for (int bj = 0; bj < 2; ++bj)
#pragma unroll
            for (int k = 0; k < 8; ++k) ks[bj][k] = 0.f;
#pragma unroll
        for (int ai = 0; ai < 2; ++ai)
#pragma unroll
            for (int m = 0; m < 4; ++m) { const int rl = ai * HALF + wr * 64 + m * 16 + fr;
                const f32x4 pa = *(const PG8_LAS f32x4*)(exch + (rl * 2 + 0) * 4), pb = *(const PG8_LAS f32x4*)(exch + (rl * 2 + 1) * 4);
                const float rs = tab[rl], rs2 = rs * rs; const float pf = (float)__float_as_int(tab[256 + rl]);
                float sa = ((pa[0] + pa[1]) + (pa[2] + pa[3])) * rs2, sb = ((pb[0] + pb[1]) + (pb[2] + pb[3])) * rs2;
                if (typ == 3) { sa = sb = (sa + sb) * 0.5f; }
#pragma unroll
                for (int bj = 0; bj < 2; ++bj) {
                    const float sc = rs * __builtin_amdgcn_rsqf((bj == 0 ? sa : sb) * (1.0f / 128.0f) + eps); const f32x4 v0 = acc[ai][bj][m][0] * sc * g0, v1 = acc[ai][bj][m][1] * sc * g1;
                    float y[8] = {v0[0], v0[1], v0[2], v0[3], v1[0], v1[1], v1[2], v1[3]};
                    if (typ < 2 && wc == 0) {
#pragma unroll
                        for (int k = 0; k < 8; ++k) { constexpr float IVL[8] = {1.000000000e+00f, 4.403665960e-01f, 1.939227432e-01f, 8.539710194e-02f, 3.760603070e-02f, 1.656043902e-02f, 7.292664610e-03f, 3.211445874e-03f};
                            constexpr float IVH[8] = {1.414213562e-03f, 6.227723788e-04f, 2.742481884e-04f, 1.207697351e-04f, 5.318296098e-05f, 2.341999971e-05f, 1.031338616e-05f, 4.541670478e-06f};
                            const float ang = pf * (hi8 ? IVH[k] : IVL[k]); float rv = ang * 0.15915494309189535f; rv = rv - __builtin_floorf(rv);
                            const float sn = __builtin_amdgcn_sinf(rv), cn = __builtin_amdgcn_cosf(rv);
                            const float other = shx(y[k], lane_, 32);
                            y[k] = (fq < 2) ? y[k] * cn - other * sn : y[k] * cn + other * sn; } }
#pragma unroll
                    for (int k = 0; k < 8; ++k) ks[bj][k] += y[k];
                    u32x4 w; w.x = cvt_pk_bf16(y[0], y[1]); w.y = cvt_pk_bf16(y[2], y[3]); w.z = cvt_pk_bf16(y[4], y[5]); w.w = cvt_pk_bf16(y[6], y[7]);
                    *(u32x4*)(Ob + (off0 + (unsigned)(((ai * HALF + m * 16) * PW + bj * HALF) * 2))) = w;
                    asm volatile("" : "+v"(ks[bj][0]), "+v"(ks[bj][1]), "+v"(ks[bj][2]), "+v"(ks[bj][3]), "+v"(ks[bj][4]), "+v"(ks[bj][5]), "+v"(ks[bj][6]), "+v"(ks[bj][7]) :: "memory"); } }
        if (typ == 1 && ksum != nullptr) {
#pragma unroll
            for (int bj = 0; bj < 2; ++bj)
#pragma unroll
                for (int k = 0; k < 8; ++k) { float t = ks[bj][k]; t += shx(t, lane_, 1); t += shx(t, lane_, 2); t += shx(t, lane_, 4); t += shx(t, lane_, 8); ks[bj][k] = t; }
            if (fr == 0) {
#pragma unroll
                for (int bj = 0; bj < 2; ++bj) { float* kp = ksum + ((size_t)((2 * (u.pn - 12) + bj) * 32 + u.pm) * 2 + wr) * 128 + wc * 32 + 8 * fq;
                    *(f32x4*)kp = (f32x4){ks[bj][0], ks[bj][1], ks[bj][2], ks[bj][3]}; *(f32x4*)(kp + 4) = (f32x4){ks[bj][4], ks[bj][5], ks[bj][6], ks[bj][7]}; } }
        }
    }
};
__device__ __forceinline__ float silu_mul(float g, float u) { const float e = __builtin_amdgcn_exp2f(-1.4426950408889634f * g); return g * __builtin_amdgcn_rcpf(1.0f + e) * u; }
struct EpiGU {
    static constexpr bool PERM = true, AFTER_DRAIN = false, BOCT = true, AOCT = true;
    bf16_t* O; int ldc; const float* ss; float inv_d, eps; PG8_LAS float* tab;
    __device__ __forceinline__ void operator()(const f32x4 (&acc)[2][2][4][2], const Unit& u, int wr, int wc, int fr_in, int fq_in) const {
        int fr = fr_in, fq = fq_in; asm volatile("" : "+v"(fr), "+v"(fq));
        { const int t = (wr * 4 + wc) * 64 + fq * 16 + fr; if (t < 256) tab[t] = row_rstd(ss, u.pm * BM + t, inv_d, eps); }
        asm volatile("s_waitcnt lgkmcnt(0)" ::: "memory"); __builtin_amdgcn_s_barrier(); asm volatile("" ::: "memory");
        char* Ob = (char*)O; const unsigned off0 = (unsigned)(((u.pn * HALF + wc * 32 + 8 * fq) >> 3) * SEQ + u.pm * BM + wr * 64 + fr) * 16u;
#pragma unroll
        for (int ai = 0; ai < 2; ++ai)
#pragma unroll
            for (int m = 0; m < 4; ++m) { const float rs = tab[ai * HALF + wr * 64 + m * 16 + fr];
                const f32x4 g0 = acc[ai][0][m][0] * rs, g1 = acc[ai][0][m][1] * rs, u0 = acc[ai][1][m][0] * rs, u1 = acc[ai][1][m][1] * rs;
                u32x4 w; w.x = cvt_pk_bf16(silu_mul(g0[0], u0[0]), silu_mul(g0[1], u0[1])); w.y = cvt_pk_bf16(silu_mul(g0[2], u0[2]), silu_mul(g0[3], u0[3]));
                w.z = cvt_pk_bf16(silu_mul(g1[0], u1[0]), silu_mul(g1[1], u1[1])); w.w = cvt_pk_bf16(silu_mul(g1[2], u1[2]), silu_mul(g1[3], u1[3]));
                *(u32x4*)(Ob + (off0 + (unsigned)((ai * HALF + m * 16) * 16))) = w; }
    }
};
template <bool AOCT_> struct EpiRes {
    static constexpr bool PERM = true, AFTER_DRAIN = false, BOCT = true, AOCT = AOCT_;
    const float* base32; float* out32; bf16_t* xb; float* ss; int ldc; PG8_LAS float* exch;
    __device__ __forceinline__ void operator()(const f32x4 (&acc)[2][2][4][2], const Unit& u, int wr, int wc, int fr, int fq) const {
        const int row0 = u.pm * BM + wr * 64 + fr, col0 = u.pn * BM + wc * 32 + 8 * fq;
        const bool fin = out32 != nullptr;
#pragma unroll
        for (int ai = 0; ai < 2; ++ai)
#pragma unroll
            for (int m = 0; m < 4; ++m) { const int row = row0 + ai * HALF + m * 16; const size_t off = (size_t)row * ldc + col0; float q = 0.f;
#pragma unroll
                for (int bj = 0; bj < 2; ++bj) { char* xp = (char*)xb + ((size_t)((col0 + bj * HALF) >> 3) * SEQ + row) * 16;
                    const u32x4 r = *(const u32x4*)xp;
                    const f32x4 b0 = (f32x4){bf_lo(r.x), bf_hi(r.x), bf_lo(r.y), bf_hi(r.y)}, b1 = (f32x4){bf_lo(r.z), bf_hi(r.z), bf_lo(r.w), bf_hi(r.w)};
                    const f32x4 o0 = b0 + acc[ai][bj][m][0], o1 = b1 + acc[ai][bj][m][1];
                    if (fin) { *(f32x4*)(out32 + off + bj * HALF) = o0; *(f32x4*)(out32 + off + bj * HALF + 4) = o1; }
                    else { q += (o0[0] * o0[0] + o0[1] * o0[1]) + (o0[2] * o0[2] + o0[3] * o0[3]) + (o1[0] * o1[0] + o1[1] * o1[1]) + (o1[2] * o1[2] + o1[3] * o1[3]);
                        u32x4 w; w.x = cvt_pk_bf16(o0[0], o0[1]); w.y = cvt_pk_bf16(o0[2], o0[3]); w.z = cvt_pk_bf16(o1[0], o1[1]); w.w = cvt_pk_bf16(o1[2], o1[3]);
                        *(u32x4*)xp = w; } }
                if (!fin) { q += __shfl_xor(q, 16); q += __shfl_xor(q, 32); if (fq == 0) exch[(ai * HALF + wr * 64 + m * 16 + fr) * 4 + wc] = q; }
                asm volatile("" ::: "memory"); }
        if (!fin) {
            asm volatile("s_waitcnt lgkmcnt(0)" ::: "memory"); __builtin_amdgcn_s_barrier(); asm volatile("" ::: "memory");
            const int t = (wr * 4 + wc) * 64 + fq * 16 + fr;
            if (t < 256) { const f32x4 p = *(const PG8_LAS f32x4*)(exch + t * 4); ss[(size_t)(u.pm * BM + t) * 16 + u.pn] = (p[0] + p[1]) + (p[2] + p[3]); }
        }
    }
};
struct EpiMKV {
    static constexpr bool PERM = true, AFTER_DRAIN = false, BOCT = false, AOCT = false;
    float* O; int ldc; const float* rs;
    __device__ __forceinline__ void operator()(const f32x4 (&acc)[2][2][4][2], const Unit& u, int wr, int wc, int fr, int fq) const {
        const int row0 = u.pm * BM + wr * 64 + fr, col0 = u.pn * BM + wc * 32 + 8 * fq;
#pragma unroll
        for (int ai = 0; ai < 2; ++ai)
#pragma unroll
            for (int m = 0; m < 4; ++m) { const int row = row0 + ai * HALF + m * 16; const float r = rs[row]; float* rowp = O + (size_t)row * ldc + col0;
#pragma unroll
                for (int bj = 0; bj < 2; ++bj) { *(f32x4*)(rowp + bj * HALF) = acc[ai][bj][m][0] * r; *(f32x4*)(rowp + bj * HALF + 4) = acc[ai][bj][m][1] * r; } }
    }
};
struct EpiMemS {
    static constexpr bool PERM = true, AFTER_DRAIN = false, BOCT = false, AOCT = false;
    bf16_t* P; float* ps;
    __device__ __forceinline__ void operator()(const f32x4 (&acc)[2][2][4][2], const Unit& u, int wr, int wc, int fr, int fq) const {
        const int row0 = u.pm * BM + wr * 64 + fr, col0 = u.pn * BM + wc * 32 + 8 * fq; constexpr float C = 0.0625f * 1.4426950408889634f;
#pragma unroll
        for (int ai = 0; ai < 2; ++ai)
#pragma unroll
            for (int m = 0; m < 4; ++m) { const int row = row0 + ai * HALF + m * 16;
#pragma unroll
                for (int bj = 0; bj < 2; ++bj) { const f32x4 a0 = acc[ai][bj][m][0], a1 = acc[ai][bj][m][1];
                    u32x4 w; w.x = cvt_pk_bf16(__builtin_amdgcn_exp2f(a0[0] * C), __builtin_amdgcn_exp2f(a0[1] * C)); w.y = cvt_pk_bf16(__builtin_amdgcn_exp2f(a0[2] * C), __builtin_amdgcn_exp2f(a0[3] * C));
                    w.z = cvt_pk_bf16(__builtin_amdgcn_exp2f(a1[0] * C), __builtin_amdgcn_exp2f(a1[1] * C)); w.w = cvt_pk_bf16(__builtin_amdgcn_exp2f(a1[2] * C), __builtin_amdgcn_exp2f(a1[3] * C));
                    *(u32x4*)(P + (size_t)row * MEM_W + col0 + bj * HALF) = w;
                    float q = ((bf_lo(w.x) + bf_hi(w.x)) + (bf_lo(w.y) + bf_hi(w.y))) + ((bf_lo(w.z) + bf_hi(w.z)) + (bf_lo(w.w) + bf_hi(w.w)));
                    q += __shfl_xor(q, 16); q += __shfl_xor(q, 32);
                    if (fq == 0) ps[((size_t)row * 4 + u.pn) * 8 + bj * 4 + wc] = q; } }
    }
};
struct EpiMemO {
    static constexpr bool PERM = true, AFTER_DRAIN = false, BOCT = false, AOCT = false;
    bf16_t* O; const float* ps;
    __device__ __forceinline__ void operator()(const f32x4 (&acc)[2][2][4][2], const Unit& u, int wr, int wc, int fr, int fq) const {
        const int row0 = u.pm * BM + wr * 64 + fr, col0 = SELF_W + u.pn * BM + wc * 32 + 8 * fq;
#pragma unroll
        for (int ai = 0; ai < 2; ++ai)
#pragma unroll
            for (int m = 0; m < 4; ++m) { const int row = row0 + ai * HALF + m * 16;
                const f32x4* lp = (const f32x4*)(ps + ((size_t)row * 4 + u.pn) * 8); const f32x4 la = lp[0], lb = lp[1];
                const float rl = 1.0f / (((la[0] + la[1]) + (la[2] + la[3])) + ((lb[0] + lb[1]) + (lb[2] + lb[3])));
#pragma unroll
                for (int bj = 0; bj < 2; ++bj) { const f32x4 v0 = acc[ai][bj][m][0] * rl, v1 = acc[ai][bj][m][1] * rl;
                    u32x4 w; w.x = cvt_pk_bf16(v0[0], v0[1]); w.y = cvt_pk_bf16(v0[2], v0[3]); w.z = cvt_pk_bf16(v1[0], v1[1]); w.w = cvt_pk_bf16(v1[2], v1[3]);
                    *(u32x4*)(O + (size_t)row * OPW + col0 + bj * HALF) = w; } }
    }
};

template <class Epi, class Sched, bool ALIGN_EPI = true>
__device__ __forceinline__ void gemm_phase(PG8_LAS unsigned char* lds, const Gemm g, const Sched& S, const Epi& E, const int wave0) {
    int lane_; asm volatile("v_mbcnt_lo_u32_b32 %0, -1, 0\n\tv_mbcnt_hi_u32_b32 %0, -1, %0" : "=v"(lane_));
    int tid_ = wave0 * 64 + lane_;
    const int tid = tid_, wid = __builtin_amdgcn_readfirstlane(tid >> 6), lane = tid & 63, wr = wid >> 2, wc = wid & 3, fr = lane & 15, fq = lane >> 4;
    const int K = g.K, nt = K / BK;
    unsigned voffA[2], voffB[2];
#pragma unroll
    for (int i = 0; i < 2; ++i) { int R, C; stage_rc(tid * 16 + i * 8192, R, C); const int Rb = Epi::PERM ? ((R & ~31) + perm32(R & 31)) : R;
        if (Epi::AOCT) { const int b = tid * 16 + i * 8192, oc = b >> 11, Ro = (b & 2047) >> 4; voffA[i] = (unsigned)(Ro * 16 + oc * (g.M * 16)); }
        else voffA[i] = (unsigned)(R * g.lda + C) * 2u;
        if (Epi::BOCT) { const int b = tid * 16 + i * 8192, oc = b >> 11, Ro = (b & 2047) >> 4, Rp = Epi::PERM ? ((Ro & ~31) + perm32(Ro & 31)) : Ro; voffB[i] = (unsigned)(Rp * 16 + oc * (g.N * 16)); }
        else voffB[i] = (unsigned)(Rb * g.ldb + C) * 2u; }
    const size_t kstep = Epi::AOCT ? (size_t)(BK / 8) * g.M * 16 : (size_t)(BK * 2), kstepB = Epi::BOCT ? (size_t)(BK / 8) * g.N * 16 : (size_t)(BK * 2);
    const size_t hstepA = Epi::AOCT ? (size_t)HALF * 16 : (size_t)HALF * g.lda * 2, hstepB = Epi::BOCT ? (size_t)HALF * 16 : (size_t)HALF * g.ldb * 2;
    const size_t tstepA = 2 * hstepA, tstepB = 2 * hstepB, pnstepA = (size_t)g.a_pn_step * 2;
    const unsigned ldsw = (unsigned)wid * 1024u;
    const int aoff = Epi::AOCT ? fq * 2048 + (wr * 64 + fr) * 16 : lds_byte(wr * 64 + fr, fq * 8), boff = Epi::BOCT ? fq * 2048 + (wc * 32 + fr) * 16 : lds_byte(wc * 32 + fr, fq * 8);
#define PG8_SA(b, h) (((b) * 2 + (h)) * HTB)
#define PG8_SB(b, h) ((4 + (b) * 2 + (h)) * HTB)
#define PG8_STAGE(bufoff, gbase, voff) do { _Pragma("unroll") for (int _i = 0; _i < 2; ++_i) \
        __builtin_amdgcn_global_load_lds((const unsigned*)((const char*)(gbase) + (voff)[_i]), (PG8_LAS unsigned*)(lds + (bufoff) + ldsw + _i * 8192), 16, 0, 0); } while (0)
#define PG8_LDA(dst, b, h) do { _Pragma("unroll") for (int m = 0; m < 4; ++m) _Pragma("unroll") for (int k = 0; k < 2; ++k) dst[m][k] = *(const PG8_LAS bf16x8*)(lds + PG8_SA(b, h) + aoff + m * (Epi::AOCT ? 256 : 2048) + k * (Epi::AOCT ? 8192 : 1024)); } while (0)
#define PG8_LDB(dst, b, h) do { _Pragma("unroll") for (int n = 0; n < 2; ++n) _Pragma("unroll") for (int k = 0; k < 2; ++k) dst[n][k] = *(const PG8_LAS bf16x8*)(lds + PG8_SB(b, h) + boff + n * (Epi::BOCT ? 256 : 2048) + k * (Epi::BOCT ? 8192 : 1024)); } while (0)
#define PG8_MMA(ai, bj, At, Bt) do { __builtin_amdgcn_s_setprio(1); _Pragma("unroll") for (int m = 0; m < 4; ++m) _Pragma("unroll") for (int n = 0; n < 2; ++n) _Pragma("unroll") for (int k = 0; k < 2; ++k) \
        acc[ai][bj][m][n] = __builtin_amdgcn_mfma_f32_16x16x32_bf16(Bt[n][k], At[m][k], acc[ai][bj][m][n], 0, 0, 0); __builtin_amdgcn_s_setprio(0); } while (0)
#define PG8_WAIT_V(n) asm volatile("s_waitcnt vmcnt(" #n ")" ::: "memory")
#define PG8_WAIT_L(n) asm volatile("s_waitcnt lgkmcnt(" #n ")" ::: "memory")
#define PG8_BAR __builtin_amdgcn_s_barrier()
#define PG8_SCHED __builtin_amdgcn_sched_barrier(0)
    __builtin_amdgcn_s_waitcnt(0);
    Unit cur, nxt; int ui = 0;
    if (!S.next(0, cur)) return;
    f32x4 acc[2][2][4][2];
#pragma unroll
    for (int a = 0; a < 2; ++a)
#pragma unroll
        for (int b = 0; b < 2; ++b)
#pragma unroll
            for (int m = 0; m < 4; ++m)
#pragma unroll
                for (int n = 0; n < 2; ++n) acc[a][b][m][n] = (f32x4){0.f, 0.f, 0.f, 0.f};
    bf16x8 At[4][2], B0[2][2], B1[2][2];
    const char* cA = (const char*)g.A + (size_t)cur.pm * tstepA + (size_t)cur.pn * pnstepA; const char* cB = (const char*)g.Bt + (size_t)cur.pn * tstepB;
    S.a_ready(cur);
    PG8_STAGE(PG8_SB(0, 0), cB, voffB); PG8_STAGE(PG8_SB(0, 1), cB + hstepB, voffB); PG8_STAGE(PG8_SA(0, 0), cA, voffA); PG8_STAGE(PG8_SA(0, 1), cA + hstepA, voffA);
    if (wr == 1) PG8_BAR;
    PG8_WAIT_V(2); PG8_BAR;
    PG8_STAGE(PG8_SB(1, 0), cB + kstepB, voffB); PG8_STAGE(PG8_SA(1, 0), cA + kstep, voffA); PG8_STAGE(PG8_SB(1, 1), cB + hstepB + kstepB, voffB);
    PG8_WAIT_V(6); PG8_BAR;
    for (;;) {
        const bool has_next = S.next(ui + 1, nxt);
        const char* nA = has_next ? (const char*)g.A + (size_t)nxt.pm * tstepA + (size_t)nxt.pn * pnstepA : cA; const char* nB = has_next ? (const char*)g.Bt + (size_t)nxt.pn * tstepB : cB;
#pragma unroll 1
        for (int t = 0; t < nt; t += 2) {
            const bool last = (t == nt - 2);
            const char* a1 = cA + (size_t)(t + 1) * kstep;
            const char* a2 = last ? nA : cA + (size_t)(t + 2) * kstep; const char* b2 = last ? nB : cB + (size_t)(t + 2) * kstepB;
            const char* a3 = a2 + kstep; const char* b3 = b2 + kstepB;
            if (last && has_next) S.a_ready(nxt);
            PG8_LDB(B0, 0, 0); PG8_LDB(B1, 0, 1); PG8_SCHED; PG8_LDA(At, 0, 0); PG8_STAGE(PG8_SA(1, 1), a1 + hstepA, voffA);
            PG8_WAIT_V(8); PG8_WAIT_L(0); PG8_BAR; PG8_MMA(0, 0, At, B0); PG8_MMA(0, 1, At, B1); PG8_BAR; PG8_SCHED;
            PG8_LDA(At, 0, 1); PG8_STAGE(PG8_SB(0, 0), b2, voffB); PG8_STAGE(PG8_SB(0, 1), b2 + hstepB, voffB); PG8_STAGE(PG8_SA(0, 0), a2, voffA);
            PG8_WAIT_V(8); PG8_WAIT_L(0); PG8_BAR; PG8_MMA(1, 0, At, B0); PG8_MMA(1, 1, At, B1); PG8_BAR; PG8_SCHED;
            PG8_LDB(B0, 1, 0); PG8_LDB(B1, 1, 1); PG8_SCHED; PG8_LDA(At, 1, 0); PG8_STAGE(PG8_SA(0, 1), a2 + hstepA, voffA);
            PG8_WAIT_V(8); PG8_WAIT_L(0); PG8_BAR; PG8_MMA(0, 0, At, B0); PG8_MMA(0, 1, At, B1); PG8_BAR; PG8_SCHED;
            PG8_LDA(At, 1, 1); PG8_STAGE(PG8_SB(1, 0), b3, voffB); PG8_STAGE(PG8_SB(1, 1), b3 + hstepB, voffB); PG8_STAGE(PG8_SA(1, 0), a3, voffA);
            PG8_WAIT_V(8); PG8_WAIT_L(0); PG8_BAR; PG8_MMA(1, 0, At, B0); PG8_MMA(1, 1, At, B1); PG8_BAR; PG8_SCHED;
        }
        if constexpr (ALIGN_EPI) { if (wr == 0) PG8_BAR; }
        E(acc, cur, wr, wc, fr, fq); S.done(cur);
        if (!has_next) break;
#pragma unroll
        for (int a = 0; a < 2; ++a)
#pragma unroll
            for (int b = 0; b < 2; ++b)
#pragma unroll
                for (int m = 0; m < 4; ++m)
#pragma unroll
                    for (int n = 0; n < 2; ++n) acc[a][b][m][n] = (f32x4){0.f, 0.f, 0.f, 0.f};
        cur = nxt; cA = nA; cB = nB; ++ui;
        if constexpr (ALIGN_EPI) { if (wr == 1) PG8_BAR; }
    }
    PG8_WAIT_V(0); __builtin_amdgcn_s_waitcnt(0);
    if constexpr (!ALIGN_EPI) { if (wr == 0) PG8_BAR; }
    PG8_BAR;
#undef PG8_SA
#undef PG8_SB
#undef PG8_STAGE
#undef PG8_LDA
#undef PG8_LDB
#undef PG8_MMA
#undef PG8_WAIT_V
#undef PG8_WAIT_L
#undef PG8_BAR
#undef PG8_SCHED
}
}

namespace att {
constexpr float SCALE = 0.08838834764831845f;
constexpr int NW = 8, QBLK = 32, KVBLK = 64, QB = NW * QBLK, D = 128;
constexpr int SHM_V = KVBLK * D * 2, SHM_K = KVBLK * D * 2;
constexpr int ATT_LDS_BYTES = 2 * SHM_V + 2 * SHM_K + NW * 64 * 4 + NW * 32 * 4;
constexpr int STG_OFF = 77824;
constexpr float THR = 8.f;
#define KSWZ(row, colB) ((row) * 256 + ((colB) ^ (((row) & 7) << 4)))
#define SBAR() __builtin_amdgcn_sched_barrier(0)
__device__ __forceinline__ int v_st(int k, int c) { const int kk = (k & ~0xC) | ((k & 4) << 1) | ((k & 8) >> 1); return ((kk >> 3) * 4 + (c >> 5)) * 512 + ((kk & 7) * 32 + (c & 31)) * 2; }
__device__ __forceinline__ int v_rd_base(int lane) { return ((lane & 3) << 3) | (((lane >> 2) & 3) << 6) | (((lane >> 4) & 1) << 5) | (((lane >> 5) & 1) << 8); }
constexpr int v_rd_off(int d0, int ks, int half) { return d0 * 512 + ks * 4096 + half * 2048; }
__device__ __forceinline__ int crow(int r, int hi) { return (r & 3) + 8 * (r >> 2) + 4 * hi; }
__device__ __forceinline__ unsigned cvtpk(float lo, float hi) { unsigned r; asm volatile("v_cvt_pk_bf16_f32 %0, %1, %2" : "=v"(r) : "v"(lo), "v"(hi)); return r; }
__device__ __forceinline__ bf16x8 load8(const bf16* p) { return *reinterpret_cast<const bf16x8*>(p); }
__device__ __forceinline__ void mask_tile(f32x16& p0, f32x16& p1, int dq) {
    const float NEG = -__builtin_inff();
#pragma unroll
    for (int r = 0; r < 16; ++r) {
        const int c = (r & 3) + 8 * (r >> 2);
        if (dq - c < 0) p0[r] = NEG;
        if (dq - c - 32 < 0) p1[r] = NEG;
    }
}
__device__ __forceinline__ void mask_sel(f32x16& p0, f32x16& p1, unsigned keep) {
    const float NEG = -__builtin_inff();
#pragma unroll
    for (int r = 0; r < 16; ++r) { p0[r] = keep ? p0[r] : NEG; p1[r] = keep ? p1[r] : NEG; }
}
__device__ __forceinline__ void partialSM(f32x16& p0, f32x16& p1, float& m_reg, float& mn, float& alpha) {
    float pmax = p0[0]; for (int r = 1; r < 16; ++r) pmax = fmaxf(pmax, p0[r]); for (int r = 0; r < 16; ++r) pmax = fmaxf(pmax, p1[r]);
    { auto rr = __builtin_amdgcn_permlane32_swap(__float_as_uint(pmax), __float_as_uint(pmax), false, false);
      pmax = fmaxf(__uint_as_float(rr[0]), __uint_as_float(rr[1])); }
    constexpr float C2 = 1.4426950408889634f * SCALE;
    if (__builtin_expect(__all((pmax - m_reg) * SCALE <= THR), 1)) { mn = m_reg; alpha = 1.f; }
    else { mn = fmaxf(m_reg, pmax); alpha = __builtin_amdgcn_exp2f((m_reg - mn) * C2); m_reg = mn; }
    const float mnL = -mn * C2;
    for (int r = 0; r < 16; ++r) p0[r] = fmaf(p0[r], C2, mnL); for (int r = 0; r < 16; ++r) p1[r] = fmaf(p1[r], C2, mnL);
    for (int r = 0; r < 16; ++r) p0[r] = __builtin_amdgcn_exp2f(p0[r]);
}
__device__ __forceinline__ void finishSM(f32x16& p0, f32x16& p1, float alpha, float& l_reg, bf16x8& pa0, bf16x8& pa1, bf16x8& pa2, bf16x8& pa3) {
    for (int r = 0; r < 16; ++r) p1[r] = __builtin_amdgcn_exp2f(p1[r]);
    float ps = 0; for (int r = 0; r < 16; ++r) ps += p0[r]; for (int r = 0; r < 16; ++r) ps += p1[r];
    { auto rr = __builtin_amdgcn_permlane32_swap(__float_as_uint(ps), __float_as_uint(ps), false, false);
      ps = __uint_as_float(rr[0]) + __uint_as_float(rr[1]); }
    l_reg = l_reg * alpha + ps;
#define PK4(P, B_, OUT) do { unsigned a0 = cvtpk(P[B_+0], P[B_+1]), a1 = cvtpk(P[B_+2], P[B_+3]);                          \
        unsigned b0 = cvtpk(P[B_+4], P[B_+5]), b1 = cvtpk(P[B_+6], P[B_+7]);                                             \
        auto r0 = __builtin_amdgcn_permlane32_swap(a0, b0, false, false); auto r1 = __builtin_amdgcn_permlane32_swap(a1, b1, false, false); \
        v4u w = {r0[0], r1[0], r0[1], r1[1]}; OUT = *reinterpret_cast<bf16x8*>(&w); } while (0)
    PK4(p0, 0, pa0); PK4(p0, 8, pa1); PK4(p1, 0, pa2); PK4(p1, 8, pa3);
#undef PK4
}
template <int KB>
__device__ __forceinline__ void qkt(f32x16& p0, f32x16& p1, const char* K_lds, int r32, int hi, const bf16x8* qr) {
    p0 = f32x16{}; p1 = f32x16{};
    const char* kb[4];
#pragma unroll
    for (int dd = 0; dd < 4; ++dd) kb[dd] = K_lds + KB * SHM_K + KSWZ(r32, (dd * 16 + hi * 8) * 2);
#pragma unroll
    for (int d0 = 0; d0 < 8; ++d0) { const char* a = kb[d0 & 3] + (d0 >> 2) * 128;
        bf16x8 b0 = *reinterpret_cast<const bf16x8*>(a);
        bf16x8 b1 = *reinterpret_cast<const bf16x8*>(a + 32 * 256);
        p0 = __builtin_amdgcn_mfma_f32_32x32x16_bf16(b0, qr[d0], p0, 0, 0, 0);
        p1 = __builtin_amdgcn_mfma_f32_32x32x16_bf16(b1, qr[d0], p1, 0, 0, 0); }
}
template <int VB, int EXTRA = 0>
__device__ __forceinline__ void pv_tile(f32x16* o, int vb0, bf16x8 pa0, bf16x8 pa1, bf16x8 pa2, bf16x8 pa3) {
#define TRRD(dst, off) asm volatile("ds_read_b64_tr_b16 %0, %1 offset:%2" : "=&v"(dst) : "v"(vb0), "i"(off) : "memory")
#define PV_D0(d0) do { s16x4 l0, l1, l2, l3, h0, h1, h2, h3; constexpr int b_ = EXTRA + VB * SHM_V + v_rd_off(d0, 0, 0); \
        TRRD(l0, b_); TRRD(h0, b_ + 2048); TRRD(l1, b_ + 4096); TRRD(h1, b_ + 6144); TRRD(l2, b_ + 8192); TRRD(h2, b_ + 10240); TRRD(l3, b_ + 12288); TRRD(h3, b_ + 14336); \
        asm volatile("s_waitcnt lgkmcnt(0)" ::: "memory"); SBAR();   \
        o[d0] = __builtin_amdgcn_mfma_f32_32x32x16_bf16(pa0, (bf16x8){l0[0], l0[1], l0[2], l0[3], h0[0], h0[1], h0[2], h0[3]}, o[d0], 0, 0, 0);   \
        o[d0] = __builtin_amdgcn_mfma_f32_32x32x16_bf16(pa1, (bf16x8){l1[0], l1[1], l1[2], l1[3], h1[0], h1[1], h1[2], h1[3]}, o[d0], 0, 0, 0);   \
        o[d0] = __builtin_amdgcn_mfma_f32_32x32x16_bf16(pa2, (bf16x8){l2[0], l2[1], l2[2], l2[3], h2[0], h2[1], h2[2], h2[3]}, o[d0], 0, 0, 0);   \
        o[d0] = __builtin_amdgcn_mfma_f32_32x32x16_bf16(pa3, (bf16x8){l3[0], l3[1], l3[2], l3[3], h3[0], h3[1], h3[2], h3[3]}, o[d0], 0, 0, 0); } while (0)
    PV_D0(0); PV_D0(1); PV_D0(2); PV_D0(3);
#undef PV_D0
#undef TRRD
}

__device__ __forceinline__ unsigned dpp_x1(unsigned v) { return (unsigned)__builtin_amdgcn_update_dpp(0, (int)v, 0xB1, 0xF, 0xF, true); }
__device__ __forceinline__ unsigned dpp_x2(unsigned v) { return (unsigned)__builtin_amdgcn_update_dpp(0, (int)v, 0x4E, 0xF, 0xF, true); }
__device__ __forceinline__ unsigned dpp_x4(unsigned v) { const int t = __builtin_amdgcn_update_dpp(0, (int)v, 0x141, 0xF, 0xF, true);
    return (unsigned)__builtin_amdgcn_update_dpp(0, t, 0x1B, 0xF, 0xF, true); }
__device__ __forceinline__ v2u quad_rows(const f32x16* o, int g, int d0, const float* rl, bool odd, bool t1) {
    const float a0 = o[d0][4 * g + 0] * rl[0], a1 = o[d0][4 * g + 1] * rl[1], a2 = o[d0][4 * g + 2] * rl[2], a3 = o[d0][4 * g + 3] * rl[3];
    const float rA0 = __uint_as_float(dpp_x1(__float_as_uint(odd ? a0 : a1))), rA1 = __uint_as_float(dpp_x1(__float_as_uint(odd ? a2 : a3)));
    const unsigned u0 = odd ? cvtpk(rA0, a1) : cvtpk(a0, rA0);
    const unsigned u1 = odd ? cvtpk(rA1, a3) : cvtpk(a2, rA1);
    const unsigned rB = dpp_x2(t1 ? u0 : u1);
    v2u w; w.x = t1 ? rB : u0; w.y = t1 ? u1 : rB; return w;
}
template <class RowFn>
__device__ __forceinline__ void store_tile_rows(const f32x16* o, const float* li_l, char* stg, int r32, int hi, int lane, const RowFn& rowptr) {
#pragma unroll
    for (int h = 0; h < 2; ++h) {
        { const int q = r32 & 3; const bool odd = (q & 1) != 0, t1 = (q & 2) != 0;
#pragma unroll
          for (int g2 = 0; g2 < 2; ++g2) { float rl[4];
#pragma unroll
              for (int j = 0; j < 4; ++j) rl[j] = __builtin_amdgcn_rcpf(li_l[crow(8 * h + 4 * g2 + j, hi)]);
              const int lr = q + 8 * g2 + 4 * hi;
#pragma unroll
              for (int d0 = 0; d0 < 4; ++d0) { const v2u w = quad_rows(o, 2 * h + g2, d0, rl, odd, t1); *(v2u*)(stg + lr * 256 + d0 * 64 + (r32 & ~3) * 2) = w; } } }
        asm volatile("s_waitcnt lgkmcnt(0)" ::: "memory");
#pragma unroll
        for (int i = 0; i < 4; ++i) { const int lr = 4 * i + (lane >> 4); const v4u x = *(const v4u*)(stg + lr * 256 + (lane & 15) * 16); char* dst = rowptr(16 * h + lr);
            if (dst) *(v4u*)(dst + (lane & 15) * 16) = x; }
        asm volatile("s_waitcnt lgkmcnt(0)" ::: "memory");
    }
}
struct BlockRef { const bf16* K; const bf16* V; char* O; float* ML; unsigned qoff; unsigned pinfo; int P0; int NT; int flags; };
struct Seam { bf16x8 qr[8]; bf16x8 st_v0, st_v1, st_k0, st_k1; };
#define KVP(p, k0, half) ((const char*)(p) + (size_t)((k0) + 32 * (half)) * (ldkv * 2))
__device__ __forceinline__ bf16x8 ld16(const char* base, unsigned off) { return *reinterpret_cast<const bf16x8*>(base + off); }
#define VMW() asm volatile("s_waitcnt vmcnt(0)" ::: "memory")
#define VMWN(n) asm volatile("s_waitcnt vmcnt(%0)" :: "i"(n) : "memory")
#define SLOAD_H(Kp, Vp, k0) do { S.st_v0 = ld16(KVP(Vp, k0, 0), kvoff); S.st_v1 = ld16(KVP(Vp, k0, 1), kvoff);              \
                         S.st_k0 = ld16(KVP(Kp, k0, 0), kvoff); S.st_k1 = ld16(KVP(Kp, k0, 1), kvoff); } while (0)
#define SWRITE_HK(bf) do { *(bf16x8*)(K_lds + (bf) * SHM_K + kws) = S.st_k0; *(bf16x8*)(K_lds + (bf) * SHM_K + kws + 32 * 256) = S.st_k1; } while (0)
#define SWRITE_HV(bf) do { *(bf16x8*)(V_lds + (bf) * SHM_V + vst0) = S.st_v0; *(bf16x8*)(V_lds + (bf) * SHM_V + vst1) = S.st_v1; } while (0)
#define SWRITE_H(bf) do { SWRITE_HV(bf); SWRITE_HK(bf); } while (0)
constexpr int ldq = PW, ldkv = PW, ldo = OPW;
__device__ __forceinline__ void attn_prime(const BlockRef& cur, const char* qbase, char* lds, Seam& S, const int tid) {
    const int sr = tid >> 4, sc = (tid & 15) * 8, kws = KSWZ(sr, sc * 2); char* K_lds = lds + 2 * SHM_V;
    const unsigned kvoff = (unsigned)(sr * ldkv + sc) * 2u;
    for (int d0 = 0; d0 < 8; ++d0) S.qr[d0] = ld16(qbase + d0 * 32, cur.qoff);
    SLOAD_H(cur.K, cur.V, 0); VMW(); SWRITE_HK(0);
    __syncthreads();
}
__device__ __forceinline__ void attn_block(const BlockRef& cur, const BlockRef& nxt, const char* qbase, char* lds, Seam& S, const int tid) {
    const int wid = __builtin_amdgcn_readfirstlane(tid >> 6), lane = tid & 63, r32 = lane & 31, hi = lane >> 5;
    const int NT = cur.NT;
    const int qlo = cur.P0 + wid * QBLK, qm = qlo + r32 - 4 * hi;
    const bool nomask = (cur.flags & 1) != 0;
    char* V_lds = lds; char* K_lds = lds + 2 * SHM_V;
    float* ws = (float*)(lds + 2 * SHM_V + 2 * SHM_K) + wid * 64; float* li_l = ws, * al_l = ws + 32;
    unsigned* rt = (unsigned*)(lds + 2 * SHM_V + 2 * SHM_K + NW * 64 * 4) + wid * 32;
    float m_reg = -1e30f, l_reg = 0; f32x16 o[4] = {};
    const int sr = tid >> 4, sc = (tid & 15) * 8, vst0 = v_st(sr, sc), vst1 = v_st(32 + sr, sc), kws = KSWZ(sr, sc * 2);
    const unsigned kvoff = (unsigned)(sr * ldkv + sc) * 2u;
    const int vb0 = (int)(uintptr_t)V_lds + v_rd_base(lane);
    const bf16* Kh = cur.K; const bf16* Vh = cur.V;
#define RESC(a) do { if (__any((a) < 1.f)) { if (hi == 0) al_l[r32] = (a); asm volatile("s_waitcnt lgkmcnt(0)" ::: "memory");              \
                     for (int d_ = 0; d_ < 4; ++d_) for (int r = 0; r < 16; ++r) o[d_][r] *= al_l[crow(r, hi)]; } } while (0)
#define KBASE(t) ((t) * KVBLK)
#define MASKT(P0_, P1_, t) do { const int kb_ = KBASE(t); if (!nomask && kb_ + KVBLK - 1 > qlo) mask_tile(P0_, P1_, qm - kb_); } while (0)
    constexpr int NQL = 8;
#define SEAM_K0() do { VMWN(NQL); SWRITE_HK(0); SBAR(); } while (0)
    f32x16 pA0, pA1, pB0, pB1; float mnA, mnB, alA, alB; bf16x8 pa0, pa1, pa2, pa3;
    SWRITE_HV(0); SBAR();
    if (NT > 1) { SLOAD_H(Kh, Vh, KBASE(1)); }
    SBAR(); qkt<0>(pA0, pA1, K_lds, r32, hi, S.qr);
    MASKT(pA0, pA1, 0); partialSM(pA0, pA1, m_reg, mnA, alA);
    if (NT > 1) { VMW(); SWRITE_H(1); }
    __syncthreads();
#define HALF_STEP(PX0, PX1, mnX, alX, PY0, PY1, alY, t, KB, VB, SB) do {                                                      \
        SBAR(); qkt<KB>(PX0, PX1, K_lds, r32, hi, S.qr);                                                         \
        finishSM(PY0, PY1, alY, l_reg, pa0, pa1, pa2, pa3); SBAR();                                                           \
        if ((t) + 1 < NT) { SLOAD_H(Kh, Vh, KBASE((t) + 1)); SBAR(); }                                               \
        pv_tile<VB>(o, vb0, pa0, pa1, pa2, pa3); MASKT(PX0, PX1, (t)); partialSM(PX0, PX1, m_reg, mnX, alX);                                        \
        __syncthreads();                                                                                                      \
        if ((t) + 1 < NT) { VMW(); SWRITE_H(SB); }                                                                          \
        RESC(alX); __syncthreads(); } while (0)
    for (int t = 1; t + 1 < NT; t += 2) {
        HALF_STEP(pB0, pB1, mnB, alB, pA0, pA1, alA, t, 1, 0, 0);
        HALF_STEP(pA0, pA1, mnA, alA, pB0, pB1, alB, t + 1, 0, 1, 1);
    }
    const bool even = (NT & 1) == 0;
    if (even) { SBAR(); qkt<1>(pB0, pB1, K_lds, r32, hi, S.qr); SBAR(); }
    { const bf16* Kn = nxt.K; const bf16* Vn = nxt.V; SLOAD_H(Kn, Vn, 0); SBAR(); }
#pragma unroll
    for (int d0 = 0; d0 < 8; ++d0) S.qr[d0] = ld16(qbase + d0 * 32, nxt.qoff);
    SBAR();
    finishSM(pA0, pA1, alA, l_reg, pa0, pa1, pa2, pa3); SBAR();
    pv_tile<0>(o, vb0, pa0, pa1, pa2, pa3);
    if (even) { MASKT(pB0, pB1, NT - 1); partialSM(pB0, pB1, m_reg, mnB, alB); __syncthreads(); RESC(alB);
        finishSM(pB0, pB1, alB, l_reg, pa0, pa1, pa2, pa3); SBAR(); pv_tile<1>(o, vb0, pa0, pa1, pa2, pa3); }
    SBAR(); SEAM_K0();
    if (hi == 0) { li_l[r32] = l_reg; rt[r32] = cur.pinfo; } asm volatile("s_waitcnt lgkmcnt(0)" ::: "memory");
    char* Ob = cur.O; char* stg = lds + STG_OFF + wid * 4096;
    if (hi == 0 && (int)cur.pinfo >= 0) { f32x2 ml = {m_reg, l_reg}; *(f32x2*)(cur.ML + (size_t)cur.pinfo * 2) = ml; }
    store_tile_rows(o, li_l, stg, r32, hi, lane, [&](int row) -> char* { const unsigned info = rt[row]; return (int)info >= 0 ? Ob + (size_t)(info & 0x7fffffffu) * 256u : nullptr; });
    __syncthreads();
#undef RESC
#undef KBASE
#undef MASKT
#undef SEAM_K0
#undef HALF_STEP
}
#undef KVP
#undef VMW
#undef VMWN
#undef SLOAD_H
#undef SWRITE_HK
#undef SWRITE_HV
#undef SWRITE_H
}

namespace att2 {
using att::dpp_x1; using att::dpp_x2; using att::dpp_x4; using att::quad_rows; using att::SHM_K; using att::SHM_V; using att::QBLK; using att::KVBLK; using att::crow; using att::cvtpk; using att::ld16; using att::v_st; using att::v_rd_base;
constexpr int OFF_V0 = 0, OFF_V1 = 2 * SHM_V, OFF_K = OFF_V1 + 2 * SHM_V, OFF_P = OFF_K + 2 * SHM_K, OFF_WS = OFF_P + 2 * 16384, ATT2_LDS_BYTES = OFF_WS + 4 * 128 * 4;
static_assert(ATT2_LDS_BYTES <= MISC_OFF, "diff-attention LDS map");
constexpr int ldkv = PW, ldo = OPW;
struct Ref { const bf16* K; const bf16* V; char* O; unsigned qoff; int P0; int NT; int desc; };
#define BARL() do { asm volatile("s_waitcnt lgkmcnt(0)" ::: "memory"); __builtin_amdgcn_s_barrier(); asm volatile("" ::: "memory"); } while (0)
#define VMW2() asm volatile("s_waitcnt vmcnt(0)" ::: "memory")
__device__ __forceinline__ void store_o(const f32x16* o, char* Ob, const float* li_l, int s, int r32, int hi, unsigned colb) {
    const int q = r32 & 3; const bool odd = (q & 1) != 0, t1 = (q & 2) != 0, b4 = (r32 & 4) != 0;
    unsigned ooff = (unsigned)((s * QBLK + 8 * (b4 ? 1 : 0) + 4 * hi + q) * ldo + (r32 & ~7)) * 2u + colb; asm volatile("" : "+v"(ooff));
#pragma unroll
    for (int G = 0; G < 2; ++G) {
        float rl0[4], rl1[4];
#pragma unroll
        for (int j = 0; j < 4; ++j) { rl0[j] = __builtin_amdgcn_rcpf(li_l[crow(8 * G + j, hi)]); rl1[j] = __builtin_amdgcn_rcpf(li_l[crow(8 * G + 4 + j, hi)]); }
#pragma unroll
        for (int d0 = 0; d0 < 4; ++d0) {
            const v2u w0 = quad_rows(o, 2 * G, d0, rl0, odd, t1), w1 = quad_rows(o, 2 * G + 1, d0, rl1, odd, t1);
            const unsigned rx = dpp_x4(b4 ? w0.x : w1.x), ry = dpp_x4(b4 ? w0.y : w1.y);
            v4u w; w.x = b4 ? rx : w0.x; w.y = b4 ? ry : w0.y; w.z = b4 ? w1.x : rx; w.w = b4 ? w1.y : ry;
            *(v4u*)(Ob + (ooff + (unsigned)(G * 16 * ldo * 2 + d0 * 64))) = w; } }
}
template <int CB>
__device__ __forceinline__ void pv256(f32x16* o, int vb0, bf16x8 pa0, bf16x8 pa1, bf16x8 pa2, bf16x8 pa3) {
    s16x4 Al0, Ah0, Al1, Ah1, Al2, Ah2, Al3, Ah3, Bl0, Bh0, Bl1, Bh1, Bl2, Bh2, Bl3, Bh3;
#define TR(dst, off) asm volatile("ds_read_b64_tr_b16 %0, %1 offset:%2" : "=&v"(dst) : "v"(vb0), "i"(off) : "memory")
#define RD(S, g) do { constexpr int b_ = ((g) >> 2) * OFF_V1 + CB * SHM_V + att::v_rd_off((g) & 3, 0, 0); \
        TR(S##l0, b_); TR(S##h0, b_ + 2048); TR(S##l1, b_ + 4096); TR(S##h1, b_ + 6144); TR(S##l2, b_ + 8192); TR(S##h2, b_ + 10240); TR(S##l3, b_ + 12288); TR(S##h3, b_ + 14336); } while (0)
#define MM(S, g) do { \
        o[g] = __builtin_amdgcn_mfma_f32_32x32x16_bf16(pa0, (bf16x8){S##l0[0], S##l0[1], S##l0[2], S##l0[3], S##h0[0], S##h0[1], S##h0[2], S##h0[3]}, o[g], 0, 0, 0); \
        o[g] = __builtin_amdgcn_mfma_f32_32x32x16_bf16(pa1, (bf16x8){S##l1[0], S##l1[1], S##l1[2], S##l1[3], S##h1[0], S##h1[1], S##h1[2], S##h1[3]}, o[g], 0, 0, 0); \
        o[g] = __builtin_amdgcn_mfma_f32_32x32x16_bf16(pa2, (bf16x8){S##l2[0], S##l2[1], S##l2[2], S##l2[3], S##h2[0], S##h2[1], S##h2[2], S##h2[3]}, o[g], 0, 0, 0); \
        o[g] = __builtin_amdgcn_mfma_f32_32x32x16_bf16(pa3, (bf16x8){S##l3[0], S##l3[1], S##l3[2], S##l3[3], S##h3[0], S##h3[1], S##h3[2], S##h3[3]}, o[g], 0, 0, 0); } while (0)
#define W8() do { asm volatile("s_waitcnt lgkmcnt(8)" ::: "memory"); SBAR(); } while (0)
#define W0() do { asm volatile("s_waitcnt lgkmcnt(0)" ::: "memory"); SBAR(); } while (0)
    asm volatile("s_waitcnt lgkmcnt(0)" ::: "memory");
    RD(A, 0); RD(B, 1); W8(); MM(A, 0); SBAR();
    RD(A, 2); W8(); MM(B, 1); SBAR();
    RD(B, 3); W8(); MM(A, 2); SBAR();
    RD(A, 4); W8(); MM(B, 3); SBAR();
    RD(B, 5); W8(); MM(A, 4); SBAR();
    RD(A, 6); W8(); MM(B, 5); SBAR();
    RD(B, 7); W8(); MM(A, 6); SBAR();
    W0(); MM(B, 7);
#undef TR
#undef RD
#undef MM
#undef W8
#undef W0
}
template <int KB>
__device__ __forceinline__ void qkt_pref(f32x16& p0, f32x16& p1, const char* K_lds, int r32, int hi, const bf16x8* qr, float nm) {
#pragma unroll
    for (int r = 0; r < 16; ++r) { p0[r] = nm; p1[r] = nm; }
    const char* kb[4];
#pragma unroll
    for (int dd = 0; dd < 4; ++dd) kb[dd] = K_lds + KB * SHM_K + KSWZ(r32, (dd * 16 + hi * 8) * 2);
    bf16x8 f0[8], f1[8];
#define QL(d0) do { const char* a_ = kb[(d0) & 3] + ((d0) >> 2) * 128; f0[d0] = *reinterpret_cast<const bf16x8*>(a_); f1[d0] = *reinterpret_cast<const bf16x8*>(a_ + 32 * 256); } while (0)
#define QM(d0) do { p0 = __builtin_amdgcn_mfma_f32_32x32x16_bf16(f0[d0], qr[d0], p0, 0, 0, 0); p1 = __builtin_amdgcn_mfma_f32_32x32x16_bf16(f1[d0], qr[d0], p1, 0, 0, 0); } while (0)
    QL(0); QL(1); QL(2); QL(3); SBAR();
    QM(0); QM(1); QL(4); QL(5); SBAR();
    QM(2); QM(3); QL(6); QL(7); SBAR();
    QM(4); QM(5); SBAR(); QM(6); QM(7);
#undef QL
#undef QM
}
__device__ __forceinline__ void partialSM2(f32x16& p0, f32x16& p1, float& m_reg, float& alpha) {
    float pmax = p0[0];
#pragma unroll
    for (int r = 1; r < 16; ++r) pmax = fmaxf(pmax, p0[r]);
#pragma unroll
    for (int r = 0; r < 16; ++r) pmax = fmaxf(pmax, p1[r]);
    { auto rr = __builtin_amdgcn_permlane32_swap(__float_as_uint(pmax), __float_as_uint(pmax), false, false);
      pmax = fmaxf(__uint_as_float(rr[0]), __uint_as_float(rr[1])); }
    constexpr float THR2 = att::THR * 1.4426950408889634f;
    if (__builtin_expect(__all(pmax <= THR2), 1)) { alpha = 1.f; }
    else { const float d = fmaxf(pmax, 0.f); alpha = __builtin_amdgcn_exp2f(-d); m_reg += d;
#pragma unroll
        for (int r = 0; r < 16; ++r) { p0[r] -= d; p1[r] -= d; } }
#pragma unroll
    for (int r = 0; r < 16; ++r) p0[r] = __builtin_amdgcn_exp2f(p0[r]);
}
struct Cursor { int b, t, NT, desc; const bf16* K; const bf16* V; char* O; };
#define TIDX(c) ((c).desc ? (c).NT - 1 - (c).t : (c).t)
#define ADVANCE(c) do { if (++(c).t == (c).NT) { (c).t = 0; if (++(c).b < nblk) { const Ref r_ = ref((c).b); (c).NT = r_.NT; (c).desc = r_.desc; (c).K = r_.K; (c).V = r_.V; (c).O = r_.O; } } } while (0)
template <class RefFn>
__device__ __forceinline__ void score_stream(const RefFn& ref, int nblk, int G, const char* qbase, char* lds, const int tid) {
    const int wid = __builtin_amdgcn_readfirstlane(tid >> 6), lane = tid & 63, r32 = lane & 31, hi = lane >> 5, s = wid & 3;
    const char* K_lds = lds + OFF_K; char* Pb = lds + OFF_P + s * 4096 + lane * 16;
    float* ws = (float*)(lds + OFF_WS) + s * 128;
    const int t2 = tid & 255, sr = t2 >> 4, sc = (t2 & 15) * 8, kws = KSWZ(sr, sc * 2);
    const unsigned kvoff = (unsigned)(sr * ldkv + sc) * 2u;
    bf16x8 qr[8], sk0[4], sk1[4], sw0[4], sw1[4];
    const int vst = v_st(sr, sc);
#define LOADK(dst, Kp, k0) do { _Pragma("unroll") for (int i_ = 0; i_ < 4; ++i_) dst[i_] = ld16((const char*)(Kp) + (size_t)((k0) + 16 * i_) * (ldkv * 2), kvoff); } while (0)
#define WRITEK(bf, src) do { _Pragma("unroll") for (int i_ = 0; i_ < 4; ++i_) *(bf16x8*)(lds + OFF_K + (bf) * SHM_K + kws + i_ * 4096) = src[i_]; } while (0)
#define LOADW(dst, Vp, k0) do { _Pragma("unroll") for (int i_ = 0; i_ < 4; ++i_) dst[i_] = ld16((const char*)(Vp) + (size_t)((k0) + 16 * i_) * (ldkv * 2) + 256, kvoff); } while (0)
#define WRITEW(bf, src) do { _Pragma("unroll") for (int i_ = 0; i_ < 4; ++i_) *(bf16x8*)(lds + OFF_V1 + (bf) * SHM_V + vst + i_ * 4096) = src[i_]; } while (0)
    Ref cur = ref(0);
    Cursor lk; lk.b = 0; lk.t = 0; lk.NT = cur.NT; lk.desc = cur.desc; lk.K = cur.K; lk.V = cur.V; lk.O = cur.O;
    Cursor lw = lk;
    LOADW(sw0, lw.V, TIDX(lw) * KVBLK); ADVANCE(lw);
    bool hw0 = true, hw1 = false; int gw = 1;
    __builtin_amdgcn_s_setprio(2);
    for (int d0 = 0; d0 < 8; ++d0) qr[d0] = ld16(qbase + d0 * 32, cur.qoff);
    LOADK(sk0, lk.K, TIDX(lk) * KVBLK); ADVANCE(lk); LOADK(sk1, lk.K, TIDX(lk) * KVBLK); ADVANCE(lk);
    WRITEK(0, sk0); WRITEK(1, sk1);
    bool have0 = 2 < G, have1 = false; int gl = 3;
    if (have0) { LOADK(sk0, lk.K, TIDX(lk) * KVBLK); ADVANCE(lk); }
    BARL();
    float m_reg = 0.f, l_reg = 0.f;
    f32x16 pA0, pA1, pB0, pB1; float alA = 1.f, alB = 1.f; bf16x8 pa0, pa1, pa2, pa3;
#define PUBLISH(slot, al) do { *(bf16x8*)(Pb + (slot) * 16384) = pa0; *(bf16x8*)(Pb + (slot) * 16384 + 1024) = pa1; *(bf16x8*)(Pb + (slot) * 16384 + 2048) = pa2; \
        *(bf16x8*)(Pb + (slot) * 16384 + 3072) = pa3; if (hi == 0) ws[64 + (slot) * 32 + r32] = (al); } while (0)
    for (int b = 0; b < nblk; ++b) {
        const Ref nxt = ref(b + 1 < nblk ? b + 1 : b);
        const int NT = cur.NT, qlo = cur.P0 + s * QBLK, qm = qlo + r32 - 4 * hi;
#define MASKT(P0_, P1_, t) do { const int kb_ = (t) * KVBLK; if (kb_ + KVBLK - 1 > qlo) att::mask_tile(P0_, P1_, qm - kb_); } while (0)
        for (int t = 0; t < NT; t += 2) {
            if (have1) WRITEK(1, sk1);
            have1 = gl < G; if (have1) { LOADK(sk1, lk.K, TIDX(lk) * KVBLK); ADVANCE(lk); } ++gl;
            if (hw1) WRITEW(1, sw1);
            hw1 = gw < G; if (hw1) { LOADW(sw1, lw.V, TIDX(lw) * KVBLK); ADVANCE(lw); } ++gw;
            SBAR(); qkt_pref<0>(pA0, pA1, K_lds, r32, hi, qr, (t == 0) ? 0.f : -m_reg);
            if (t > 0 || b > 0) { att::finishSM(pB0, pB1, alB, l_reg, pa0, pa1, pa2, pa3); SBAR(); PUBLISH(1, alB); }
            if (t == 0) { if (b > 0 && hi == 0) ws[((b - 1) & 1) * 32 + r32] = l_reg; m_reg = 0.f; l_reg = 0.f; }
            MASKT(pA0, pA1, (cur.desc ? NT - 1 - t : t)); partialSM2(pA0, pA1, m_reg, alA);
            BARL();
            if (have0) WRITEK(0, sk0);
            have0 = gl < G; if (have0) { LOADK(sk0, lk.K, TIDX(lk) * KVBLK); ADVANCE(lk); } ++gl;
            if (hw0) WRITEW(0, sw0);
            hw0 = gw < G; if (hw0) { LOADW(sw0, lw.V, TIDX(lw) * KVBLK); ADVANCE(lw); } ++gw;
            SBAR(); qkt_pref<1>(pB0, pB1, K_lds, r32, hi, qr, -m_reg);
            att::finishSM(pA0, pA1, alA, l_reg, pa0, pa1, pa2, pa3); SBAR(); PUBLISH(0, alA);
            if (t + 2 == NT) {
#pragma unroll
                for (int d0 = 0; d0 < 8; ++d0) qr[d0] = ld16(qbase + d0 * 32, nxt.qoff); }
            MASKT(pB0, pB1, (cur.desc ? NT - 2 - t : t + 1)); partialSM2(pB0, pB1, m_reg, alB);
            BARL();
        }
#undef MASKT
        cur = nxt;
    }
    att::finishSM(pB0, pB1, alB, l_reg, pa0, pa1, pa2, pa3); SBAR(); PUBLISH(1, alB);
    if (hi == 0) ws[((nblk - 1) & 1) * 32 + r32] = l_reg;
    if (hw1) WRITEW(1, sw1);
    BARL();
    BARL();
    __builtin_amdgcn_s_setprio(0);
#undef PUBLISH
#undef LOADK
#undef WRITEK
#undef LOADW
#undef WRITEW
}
template <class RefFn>
__device__ __forceinline__ void helper_stream(const RefFn& ref, int nblk, int G, char* lds, const int tid) {
    const int wid = __builtin_amdgcn_readfirstlane(tid >> 6), lane = tid & 63, r32 = lane & 31, hi = lane >> 5, s = wid & 3;
    char* Pb = lds + OFF_P + s * 4096 + lane * 16;
    float* ws = (float*)(lds + OFF_WS) + s * 128;
    const int vb0 = (int)(uintptr_t)(lds + OFF_V0) + v_rd_base(lane);
    const int t2 = tid & 255, sr = t2 >> 4, sc = (t2 & 15) * 8, vst = v_st(sr, sc);
    const unsigned kvoff = (unsigned)(sr * ldkv + sc) * 2u;
    bf16x8 sv0[4], sv1[4], pa0, pa1, pa2, pa3; f32x16 o[8];
#define LOADV(dst, Vp, k0) do { _Pragma("unroll") for (int i_ = 0; i_ < 4; ++i_) dst[i_] = ld16((const char*)(Vp) + (size_t)((k0) + 16 * i_) * (ldkv * 2), kvoff); } while (0)
#define WRITEV(bf, src) do { _Pragma("unroll") for (int i_ = 0; i_ < 4; ++i_) *(bf16x8*)(lds + OFF_V0 + (bf) * SHM_V + vst + i_ * 4096) = src[i_]; } while (0)
    Cursor lv, cc; { const Ref r0 = ref(0); lv.b = 0; lv.t = 0; lv.NT = r0.NT; lv.desc = r0.desc; lv.K = r0.K; lv.V = r0.V; lv.O = r0.O; cc = lv; }
    LOADV(sv0, lv.V, TIDX(lv) * KVBLK); ADVANCE(lv);
    bool have0 = true, have1 = false; int gl = 1;
    BARL();
    char* prevO = nullptr; int prevb = 0;
#define INTERVAL(i, CB, SWSET, SWBUF, HAVE) do {                                                                                        \
        if (HAVE) WRITEV(SWBUF, SWSET);                                                                                                 \
        HAVE = gl < G; if (HAVE) { LOADV(SWSET, lv.V, TIDX(lv) * KVBLK); ADVANCE(lv); } ++gl;                                               \
        if ((i) >= 2 && (i) - 2 < G) {                                                                                                  \
            if (cc.t == 0) { if (prevO) { store_o(o, prevO, ws + (prevb & 1) * 32, s, r32, hi, 0u); store_o(o + 4, prevO, ws + (prevb & 1) * 32, s, r32, hi, 256u); } \
                _Pragma("unroll") for (int d_ = 0; d_ < 8; ++d_) o[d_] = f32x16{}; prevO = cc.O; prevb = cc.b; }                         \
            pa0 = *(const bf16x8*)(Pb + (CB) * 16384); pa1 = *(const bf16x8*)(Pb + (CB) * 16384 + 1024); pa2 = *(const bf16x8*)(Pb + (CB) * 16384 + 2048); pa3 = *(const bf16x8*)(Pb + (CB) * 16384 + 3072); \
            { const float* al_ = ws + 64 + (CB) * 32; const float a_ = al_[r32];                                                        \
              if (__any(a_ < 1.f)) { for (int d_ = 0; d_ < 8; ++d_) for (int r = 0; r < 16; ++r) o[d_][r] *= al_[crow(r, hi)]; } }       \
            pv256<CB>(o, vb0, pa0, pa1, pa2, pa3);                      \
            ADVANCE(cc); }                                                                                                              \
        BARL(); } while (0)
    for (int i = 0; i < G + 2; i += 2) { INTERVAL(i, 0, sv1, 1, have1); INTERVAL(i + 1, 1, sv0, 0, have0); }
    store_o(o, prevO, ws + (prevb & 1) * 32, s, r32, hi, 0u); store_o(o + 4, prevO, ws + (prevb & 1) * 32, s, r32, hi, 256u);
#undef INTERVAL
#undef LOADV
#undef WRITEV
}
#undef ADVANCE
#undef TIDX
}

#define XB_TMO      128
#define XB_XCNT(j)  (256  + 64 * (j))
#define XB_XSUB(j)  (1280 + 64 * (j))
#define XB_XGEN(j)  (2304 + 64 * (j))
#define XB_TOP      3328
#define XB_TOPGEN   3392
#define XCD_BAR_WORDS 3456
#define XB_SPIN_CAP (1u << 18)
__device__ __forceinline__ unsigned xb_ld(unsigned* p)              { return __hip_atomic_load(p, __ATOMIC_RELAXED, __HIP_MEMORY_SCOPE_AGENT); }
__device__ __forceinline__ unsigned xb_add(unsigned* p, unsigned v) { return __hip_atomic_fetch_add(p, v, __ATOMIC_RELAXED, __HIP_MEMORY_SCOPE_AGENT); }
__device__ __forceinline__ unsigned xb_xcc_id() { return (unsigned)__builtin_amdgcn_s_getreg((3 << 11) | 20) & 0xFu; }
#define XB_SPIN(cond, bar) do { unsigned _sp = 0; while (cond) { __builtin_amdgcn_s_sleep(1); \
    if ((++_sp & 255u) == 0u) { if (xb_ld(&(bar)[XB_TMO])) break; if (_sp > XB_SPIN_CAP) { atomicAdd(&(bar)[XB_TMO], 1u); break; } } } } while (0)
struct XcdBarrier { unsigned* bar; unsigned x; volatile LAS unsigned* st; };
__device__ __forceinline__ XcdBarrier xcd_barrier_post(unsigned* bar, volatile LAS unsigned* st) {
    XcdBarrier b; b.bar = bar; b.x = xb_xcc_id(); b.st = st;
    if (threadIdx.x == 0) (void)xb_add(&bar[XB_XCNT(b.x)], 1u);
    return b;
}
__device__ __forceinline__ void xcd_barrier_complete(unsigned* bar, unsigned x, unsigned& nloc, unsigned& nx) {
    const unsigned G = gridDim.x * gridDim.y * gridDim.z;
    unsigned sum, cnt, mine, sp = 0u;
    for (;;) {
        sum = 0u; cnt = 0u; mine = 0u;
#pragma unroll
        for (unsigned j = 0; j < 16; ++j) { const unsigned c = xb_ld(&bar[XB_XCNT(j)]); sum += c; cnt += (c > 0u) ? 1u : 0u; mine = (j == x) ? c : mine; }
        if (sum == G) break;
        __builtin_amdgcn_s_sleep(1);
        if ((++sp & 255u) == 0u) { if (xb_ld(&bar[XB_TMO])) break; if (sp > XB_SPIN_CAP) { atomicAdd(&bar[XB_TMO], 1u); break; } }
    }
    nloc = mine > 0u ? mine : 1u; nx = cnt > 0u ? cnt : 1u;
}
__device__ __forceinline__ void xcd_barrier(const XcdBarrier& b) {
    asm volatile("s_waitcnt vmcnt(0)" ::: "memory");
    __syncthreads();
    if (threadIdx.x == 0) {
        unsigned* bar = b.bar;
        __builtin_amdgcn_s_waitcnt(0);
        unsigned nloc = b.st[0], nx = b.st[1];
        if (nloc == 0u) { xcd_barrier_complete(bar, b.x, nloc, nx); b.st[0] = nloc; b.st[1] = nx; }
        const unsigned old = xb_add(&bar[XB_XSUB(b.x)], 1u);
        const unsigned gen = old / nloc;
        if (old + 1u == (gen + 1u) * nloc) {
            __builtin_amdgcn_fence(__ATOMIC_RELEASE, "agent");
            asm volatile("s_waitcnt vmcnt(0)" ::: "memory");
            const unsigned og = xb_add(&bar[XB_TOP], 1u);
            const unsigned tg = og / nx;
            if (og + 1u == (tg + 1u) * nx) xb_add(&bar[XB_TOPGEN], 1u);
            else XB_SPIN(xb_ld(&bar[XB_TOPGEN]) == tg, bar);
            __builtin_amdgcn_fence(__ATOMIC_ACQUIRE, "agent");
            xb_add(&bar[XB_XGEN(b.x)], 1u);
            asm volatile("s_waitcnt vmcnt(0)" ::: "memory");
        } else {
            XB_SPIN(xb_ld(&bar[XB_XGEN(b.x)]) == gen, bar);
            __builtin_amdgcn_fence(__ATOMIC_ACQUIRE, "agent");
            asm volatile("s_waitcnt vmcnt(0)" ::: "memory");
        }
    }
    __syncthreads();
}

__device__ __forceinline__ unsigned xg_ld(gu32* p)              { return __hip_atomic_load(p, __ATOMIC_RELAXED, __HIP_MEMORY_SCOPE_AGENT); }
__device__ __forceinline__ unsigned xg_add(gu32* p, unsigned v) { return __hip_atomic_fetch_add(p, v, __ATOMIC_RELAXED, __HIP_MEMORY_SCOPE_AGENT); }
#define XG_SPIN(cond, bar) do { unsigned _sp = 0; while (cond) { __builtin_amdgcn_s_sleep(1); \
    if ((++_sp & 255u) == 0u) { if (xg_ld(&(bar)[XB_TMO])) break; if (_sp > XB_SPIN_CAP) { xg_add(&(bar)[XB_TMO], 1u); break; } } } } while (0)
__device__ __attribute__((noinline)) void xcd_barrier_slim(gu32* bar, unsigned x, volatile LAS unsigned* st, bool leader) {
    asm volatile("s_waitcnt vmcnt(0)" ::: "memory");
    __syncthreads();
    if (leader) {
        __builtin_amdgcn_s_waitcnt(0);
        unsigned nloc = st[0], nx = st[1];
        if (nloc == 0u || nx == 0u) { xg_add(&bar[XB_TMO], 1u); nloc = 1u; nx = 1u; }
        const unsigned old = xg_add(&bar[XB_XSUB(x)], 1u);
        const unsigned gen = old / nloc;
        if (old + 1u == (gen + 1u) * nloc) {
            __builtin_amdgcn_fence(__ATOMIC_RELEASE, "agent");
            asm volatile("s_waitcnt vmcnt(0)" ::: "memory");
            const unsigned og = xg_add(&bar[XB_TOP], 1u);
            const unsigned tg = og / nx;
            if (og + 1u == (tg + 1u) * nx) xg_add(&bar[XB_TOPGEN], 1u);
            else XG_SPIN(xg_ld(&bar[XB_TOPGEN]) == tg, bar);
            __builtin_amdgcn_fence(__ATOMIC_ACQUIRE, "agent");
            xg_add(&bar[XB_XGEN(x)], 1u);
            asm volatile("s_waitcnt vmcnt(0)" ::: "memory");
        } else {
            XG_SPIN(xg_ld(&bar[XB_XGEN(x)]) == gen, bar);
            __builtin_amdgcn_fence(__ATOMIC_ACQUIRE, "agent");
            asm volatile("s_waitcnt vmcnt(0)" ::: "memory");
        }
    }
    __syncthreads();
}

constexpr int NWAVES = 8;
struct Args { const void* in[N_IN]; float* out; unsigned char* ws; int ph_lo, ph_hi; };
static_assert(sizeof(Args) == (N_IN + 2) * 8 + 8, "Args has no padding");

struct Frame {
    LAS unsigned char* lds; char* ldsg; unsigned char* ws; int tid, lane, wave, vcu, G;
};
__device__ __forceinline__ int lane_id_now() { int l; asm volatile("v_mbcnt_lo_u32_b32 %0, -1, 0\n\tv_mbcnt_hi_u32_b32 %0, -1, %0" : "=v"(l)); return l; }
__device__ __forceinline__ Frame phase_frame(const Frame& F0) {
    Frame F = F0; int t = F0.wave * 64 + lane_id_now(); size_t z = 0; asm volatile("" : "+s"(z));
    F.tid = t; F.lane = t & 63; F.wave = __builtin_amdgcn_readfirstlane(t >> 6); F.ws = F0.ws + z; return F;
}

__device__ __forceinline__ void p0_transpose_item(const float* W, const float* gk, int K, int N, bf16* WT, int rowmode, LAS float* scr, int item, int lane) {
    const int nblk = N / 64, kb = item / nblk, nb = item - kb * nblk, k0 = 64 * kb, n0 = 64 * nb;
    const int kk4 = lane >> 4, nq = lane & 15;
    f32x4 v[16];
#pragma unroll
    for (int i = 0; i < 16; ++i) v[i] = *(const GAS f32x4*)(W + (size_t)(k0 + 4 * i + kk4) * N + n0 + 4 * nq);
#pragma unroll
    for (int i = 0; i < 16; ++i) { const int k = 4 * i + kk4; f32x4 w = v[i]; if (gk) w = w * gk[k0 + k];
        *(LAS f32x4*)(scr + k * 64 + ((4 * nq) ^ (k & 0x38))) = w; }
    LDS_WAIT(); asm volatile("" ::: "memory");
    const int r = lane >> 3, c = lane & 7;
    const int rbase = rowmode == 0 ? n0 : ((n0 >> 7) * 256 + (n0 & 127) + (rowmode == 2 ? 128 : 0));
#pragma unroll
    for (int i = 0; i < 8; ++i) { const int n = 8 * i + r; const LAS float* sp = scr + (8 * c) * 64 + (n ^ (8 * c));
        v4u o; o.x = cvt_pk_bf16(sp[0 * 64], sp[1 * 64]); o.y = cvt_pk_bf16(sp[2 * 64], sp[3 * 64]); o.z = cvt_pk_bf16(sp[4 * 64], sp[5 * 64]); o.w = cvt_pk_bf16(sp[6 * 64], sp[7 * 64]);
        *(GAS v4u*)(WT + (size_t)(rbase + n) * K + k0 + 8 * c) = o; }
    LDS_WAIT(); asm volatile("" ::: "memory");
}

struct P0Item { const float* W; const float* gk; bf16* WT; int K, N, rowmode, item; };
__device__ __forceinline__ void p0_item_load(const P0Item& d, int lane, f32x4 (&v)[16]) {
    const int nch = d.N / 256, kb = d.item / nch, nc = d.item - kb * nch, k0 = 16 * kb, n0 = 256 * nc + 4 * lane;
#pragma unroll
    for (int i = 0; i < 16; ++i) v[i] = *(const GAS f32x4*)(d.W + (size_t)(k0 + i) * d.N + n0);
}
__device__ __forceinline__ void p0_item_finish(const P0Item& d, const f32x4 (&v)[16], int lane) {
    const int nch = d.N / 256, kb = d.item / nch, nc = d.item - kb * nch, k0 = 16 * kb, n0 = 256 * nc + 4 * lane;
    const int nrow = d.rowmode == 0 ? n0 : ((n0 >> 7) * 256 + (n0 & 127) + (d.rowmode == 2 ? 128 : 0)), NR = d.rowmode == 0 ? d.N : 2 * d.N;
    float g[16];
#pragma unroll
    for (int i = 0; i < 16; ++i) g[i] = d.gk ? d.gk[k0 + i] : 1.f;
    char* dst = (char*)d.WT + ((size_t)(k0 >> 3) * NR + nrow) * 16;
#pragma unroll
    for (int o = 0; o < 2; ++o)
#pragma unroll
        for (int j = 0; j < 4; ++j) { v4u w;
            w.x = cvt_pk_bf16(v[8 * o + 0][j] * g[8 * o + 0], v[8 * o + 1][j] * g[8 * o + 1]); w.y = cvt_pk_bf16(v[8 * o + 2][j] * g[8 * o + 2], v[8 * o + 3][j] * g[8 * o + 3]);
            w.z = cvt_pk_bf16(v[8 * o + 4][j] * g[8 * o + 4], v[8 * o + 5][j] * g[8 * o + 5]); w.w = cvt_pk_bf16(v[8 * o + 6][j] * g[8 * o + 6], v[8 * o + 7][j] * g[8 * o + 7]);
            *(GAS v4u*)(dst + ((size_t)o * NR + j) * 16) = w; }
}
__device__ __forceinline__ void p0a_prologue(const Frame& F0, const Args& a) {
    const Frame F = phase_frame(F0);
    LAS float* scr = (LAS float*)(F.lds + F.wave * 16384);
    const int gw = F.vcu * NWAVES + F.wave, NGW = F.G * NWAVES;
    constexpr int I_MK = (DM / 64) * (2 * MEM_W / 64);
    for (int it = gw; it < I_MK; it += NGW) p0_transpose_item((const float*)a.in[IN_WMEMKV], nullptr, DM, 2 * MEM_W, (bf16*)(F.ws + WS_WMK), 0, scr, it, F.lane);
    { const float* x = (const float*)a.in[IN_X]; char* xb = (char*)(F.ws + WS_XB); float* ssb = (float*)(F.ws + WS_SSB);
      for (int t = gw; t < (SEQ / 16) * 4; t += NGW) {
          const int rg = t >> 2, cq = t & 3, r = F.lane & 15, sb = F.lane >> 4, m = rg * 16 + r; float s = 0.f;
          const float* xr = x + (size_t)m * DM + cq * 1024 + sb * 8;
#pragma unroll 8
          for (int j = 0; j < 32; ++j) { const f32x4 v0 = *(const GAS f32x4*)(xr + 32 * j), v1 = *(const GAS f32x4*)(xr + 32 * j + 4);
              s += ((v0[0] * v0[0] + v0[1] * v0[1]) + (v0[2] * v0[2] + v0[3] * v0[3])) + ((v1[0] * v1[0] + v1[1] * v1[1]) + (v1[2] * v1[2] + v1[3] * v1[3]));
              v4u w; w.x = cvt_pk_bf16(v0[0], v0[1]); w.y = cvt_pk_bf16(v0[2], v0[3]); w.z = cvt_pk_bf16(v1[0], v1[1]); w.w = cvt_pk_bf16(v1[2], v1[3]);
              *(GAS v4u*)(xb + ((size_t)(cq * 128 + 4 * j + sb) * SEQ + m) * 16) = w; }
          s += __shfl_xor(s, 16); s += __shfl_xor(s, 32);
          ssb[(size_t)m * 16 + 4 * sb + cq] = sb == 0 ? s : 0.f; } }
    { const int* pos = (const int*)a.in[IN_POS]; float* cs = (float*)(F.ws + WS_CS);
      const float INV[16] = {1.000000000e+00f, 4.403665960e-01f, 1.939227432e-01f, 8.539710194e-02f, 3.760603070e-02f, 1.656043902e-02f, 7.292664610e-03f, 3.211445874e-03f,
                             1.414213562e-03f, 6.227723788e-04f, 2.742481884e-04f, 1.207697351e-04f, 5.318296098e-05f, 2.341999971e-05f, 1.031338616e-05f, 4.541670478e-06f};
      for (int idx = F.vcu * 512 + F.tid; idx < SEQ * 16; idx += F.G * 512) {
          const int row = idx >> 4, i = idx & 15; float inv = INV[0];
#pragma unroll
          for (int k = 1; k < 16; ++k) inv = (i == k) ? INV[k] : inv;
          const float angf = (float)pos[row] * inv; const double ang = (double)angf;
          const double qd = __builtin_rint(ang * 0.63661977236758134308); const int qi = (int)qd;
          double r = __builtin_fma(-qd, 1.57079632679489655800e+00, ang); r = __builtin_fma(-qd, 6.12323399573676603587e-17, r);
          const double r2 = r * r;
          double sp = -2.5052108385441718775e-08; sp = sp * r2 + 2.7557319223985890653e-06; sp = sp * r2 - 1.9841269841269841253e-04; sp = sp * r2 + 8.3333333333333332177e-03; sp = sp * r2 - 1.6666666666666665741e-01;
          const double sn = r + r * r2 * sp;
          double cp = 2.0876756987868098979e-09; cp = cp * r2 - 2.7557319223985888276e-07; cp = cp * r2 + 2.4801587301587301566e-05; cp = cp * r2 - 1.3888888888888889419e-03; cp = cp * r2 + 4.1666666666666664354e-02; cp = cp * r2 - 0.5;
          const double cn = 1.0 + r2 * cp;
          const int q4 = qi & 3;
          const double c = (q4 == 0) ? cn : (q4 == 1) ? -sn : (q4 == 2) ? -cn : sn;
          const double s = (q4 == 0) ? sn : (q4 == 1) ? cn : (q4 == 2) ? -sn : -cn;
          cs[(size_t)row * 32 + i] = (float)c; cs[(size_t)row * 32 + 16 + i] = (float)s; } }
    { const float* mem = (const float*)a.in[IN_MEM]; const float* gm = (const float*)a.in[IN_GMEM]; bf16* mb = (bf16*)(F.ws + WS_MEMB); float* rsm = (float*)(F.ws + WS_RSM);
      for (int m = gw; m < MEML; m += NGW) {
          const GAS f32x4* xr = (const GAS f32x4*)(mem + (size_t)m * DM) + F.lane; const GAS f32x4* gr = (const GAS f32x4*)gm + F.lane; GAS v2u* o8 = (GAS v2u*)(mb + (size_t)m * DM) + F.lane; float s = 0.f;
#pragma unroll 4
          for (int j = 0; j < 16; ++j) { const f32x4 v = xr[64 * j]; const f32x4 g = gr[64 * j]; s += (v[0] * v[0] + v[1] * v[1]) + (v[2] * v[2] + v[3] * v[3]);
              v2u w; w.x = cvt_pk_bf16(v[0] * g[0], v[1] * g[1]); w.y = cvt_pk_bf16(v[2] * g[2], v[3] * g[3]); o8[64 * j] = w; }
          s = wave_sum(s);
          if (F.lane == 0) rsm[m] = __builtin_amdgcn_rsqf(s * (1.0f / DM) + NORM_EPS); } }
}
__device__ __forceinline__ void p0b_weights(const Frame& F0, const Args& a, int skip) {
    const Frame F = phase_frame(F0);
    if (F.vcu < skip) return;
    LAS float* scr = (LAS float*)(F.lds + F.wave * 16384);
    const int gw = (F.vcu - skip) * NWAVES + F.wave, NGW = (F.G - skip) * NWAVES;
    constexpr int I_IN = (DM / 64) * (PW / 64), I_OUT = (DM / 64) * (DM / 64), I_G = (DM / 64) * (DFF / 64), I_D = (DFF / 64) * (DM / 64);
    constexpr int I_LAYER = I_IN + I_OUT + 2 * I_G + I_D;
    auto desc = [&](int it) -> P0Item {
        const int l = it >= I_LAYER ? 1 : 0; int r = it - l * I_LAYER;
        if (r < I_IN) return P0Item{(const float*)a.in[IN_WIN] + (size_t)l * DM * PW, (const float*)a.in[IN_GATTN] + l * DM, (bf16*)(F.ws + WS_WIN + l * SZ_WIN), DM, PW, 0, r};
        r -= I_IN;
        if (r < I_OUT) return P0Item{(const float*)a.in[IN_WOUT] + (size_t)l * DM * DM, nullptr, (bf16*)(F.ws + WS_WOUT + l * SZ_WOUT), DM, DM, 0, r};
        r -= I_OUT;
        if (r < I_G) return P0Item{(const float*)a.in[IN_WGATE] + (size_t)l * DM * DFF, (const float*)a.in[IN_GFFN] + l * DM, (bf16*)(F.ws + WS_WGU + l * SZ_WGU), DM, DFF, 1, r};
        r -= I_G;
        if (r < I_G) return P0Item{(const float*)a.in[IN_WUP] + (size_t)l * DM * DFF, (const float*)a.in[IN_GFFN] + l * DM, (bf16*)(F.ws + WS_WGU + l * SZ_WGU), DM, DFF, 2, r};
        r -= I_G;
        return P0Item{(const float*)a.in[IN_WDOWN] + (size_t)l * DFF * DM, nullptr, (bf16*)(F.ws + WS_WDN + l * SZ_WDN), DFF, DM, 0, r}; };
    int it = gw;
    if (it < 2 * I_LAYER) {
        f32x4 va[16], vb[16];
        P0Item da = desc(it); p0_item_load(da, F.lane, va);
        for (;;) {
            const int itn = it + NGW; const bool more = itn < 2 * I_LAYER;
            P0Item db = da;
            if (more) { db = desc(itn); p0_item_load(db, F.lane, vb); }
            p0_item_finish(da, va, F.lane);
            if (!more) break;
            it = itn; da = db;
#pragma unroll
            for (int i = 0; i < 16; ++i) va[i] = vb[i];
        }
    }
}

__device__ __forceinline__ void memprep_phase(const Frame& F0, const Args& a, int layer) {
    const Frame F = phase_frame(F0);
    { const float* mkv = (const float*)(F.ws + WS_MKV); bf16* kmn = (bf16*)(F.ws + WS_KMN + (size_t)layer * 524288); bf16* vt = (bf16*)(F.ws + WS_VT);
      const float* gk = (const float*)a.in[IN_GMK] + layer * 256; const float* gq = (const float*)a.in[IN_GMQ] + layer * 256;
      const int gw = F.vcu * NWAVES + F.wave, NGW = F.G * NWAVES;
      for (int t = gw; t < 4 * MEML; t += NGW) { const int h = t >> 8, key = t & 255;
          const f32x4 v = *(const f32x4*)(mkv + (size_t)key * 2048 + h * 256 + F.lane * 4);
          float s = (v[0] * v[0] + v[1] * v[1]) + (v[2] * v[2] + v[3] * v[3]); s = wave_sum(s);
          const float rs = __builtin_amdgcn_rsqf(s * (1.0f / 256.0f) + NORM_EPS);
          const f32x4 g1 = *(const f32x4*)(gk + F.lane * 4), g2 = *(const f32x4*)(gq + F.lane * 4);
          v2u o; o.x = cvt_pk_bf16(v[0] * rs * g1[0] * g2[0], v[1] * rs * g1[1] * g2[1]); o.y = cvt_pk_bf16(v[2] * rs * g1[2] * g2[2], v[3] * rs * g1[3] * g2[3]);
          *(v2u*)(kmn + (size_t)t * 256 + F.lane * 4) = o; }
      for (int idx = F.vcu * 512 + F.tid; idx < 4 * 256 * 256; idx += F.G * 512) { const int hd = idx >> 8, key = idx & 255;
          const float v = mkv[(size_t)key * 2048 + 1024 + hd]; vt[idx] = (bf16)(cvt_pk_bf16(v, 0.f) & 0xffffu); } }
}

__device__ __forceinline__ void gate_phase(const Frame& F0) {
    const Frame F = phase_frame(F0);
    const bf16* proj = (const bf16*)(F.ws + WS_PROJ); const float* ksum = (const float*)(F.ws + WS_KSUM);
    unsigned short* seg = (unsigned short*)(F.ws + WS_SEG); unsigned* cnt = (unsigned*)(F.ws + WS_CNT);
    LAS float* km = (LAS float*)F.lds;
    LAS unsigned* wc = (LAS unsigned*)(F.lds + 16384);
    gu32* qcur = (gu32*)(F.ws + WS_CTL) + CW_GATEQ; volatile LAS int* qit = (volatile LAS int*)(F.lds + 16384 + 1024);
    for (;;) {
        __syncthreads();
        if (F.tid == 0) *qit = (int)__hip_atomic_fetch_add(qcur, 1u, __ATOMIC_RELAXED, __HIP_MEMORY_SCOPE_AGENT);
        __syncthreads();
        const int it = __builtin_amdgcn_readfirstlane(*qit);
        if (it >= NHEAD * (NBLK - 1)) break;
        const int h = it % NHEAD, b0 = NBLK - 1 - it / NHEAD;
        for (int e = F.tid; e < b0 * HD; e += 512) { const int blk = e >> 7, dim = e & 127; const float* kp = ksum + ((size_t)(h * NBLK + blk) * 2) * HD + dim;
            km[e] = (kp[0] + kp[HD]) * (1.0f / 256.0f); }
        __syncthreads();
        int i1 = 32, i2 = 32, i3 = 32;
        const int rib = F.tid >> 1, half = F.tid & 1;
        {
            const int row = b0 * 256 + rib;
            const v4u* qp = (const v4u*)(proj + (size_t)row * PW + h * HD + half * 64);
            v4u q[8];
#pragma unroll
            for (int j = 0; j < 8; ++j) q[j] = qp[j];
            float v1 = -__builtin_inff(), v2 = v1, v3 = v1;
            for (int blk = 0; blk < b0; ++blk) {
                const LAS f32x4* kr = (const LAS f32x4*)(km + blk * HD + half * 64); float g0 = 0.f, g1 = 0.f;
#pragma unroll
                for (int j = 0; j < 8; ++j) { const f32x4 ka = kr[2 * j], kb = kr[2 * j + 1];
                    g0 += bf_lo(q[j].x) * ka[0] + bf_hi(q[j].x) * ka[1] + bf_lo(q[j].y) * ka[2] + bf_hi(q[j].y) * ka[3];
                    g1 += bf_lo(q[j].z) * kb[0] + bf_hi(q[j].z) * kb[1] + bf_lo(q[j].w) * kb[2] + bf_hi(q[j].w) * kb[3]; }
                float gt = g0 + g1; gt += __shfl_xor(gt, 1);
                if (gt > v1) { v3 = v2; i3 = i2; v2 = v1; i2 = i1; v1 = gt; i1 = blk; }
                else if (gt > v2) { v3 = v2; i3 = i2; v2 = gt; i2 = blk; }
                else if (gt > v3) { v3 = gt; i3 = blk; }
            }
            for (int j = 0; j < b0; ++j) { const bool sj = (half == 0) && ((i1 == j) | (i2 == j) | (i3 == j)); const unsigned long long b = __ballot(sj); if (F.lane == 0) wc[j * 8 + F.wave] = (unsigned)__popcll(b); }
        }
        __syncthreads();
        {
            const unsigned long long lt = (1ull << F.lane) - 1ull;
            for (int j = 0; j < b0; ++j) { const bool sj = (half == 0) && ((i1 == j) | (i2 == j) | (i3 == j)); const unsigned long long b = __ballot(sj);
                unsigned base = 0; for (int w = 0; w < F.wave; ++w) base += wc[j * 8 + w];
                if (sj) { const unsigned rank = base + (unsigned)__popcll(b & lt); const unsigned pk = (i1 == j) ? 0u : (i2 == j) ? 1u : 2u;
                    seg[((size_t)(h * 32 + j) * 32 + b0) * 256 + rank] = (unsigned short)((unsigned)rib | (pk << 8)); }
                if (F.tid == 0) { unsigned t = 0; for (int w = 0; w < 8; ++w) t += wc[j * 8 + w]; cnt[(h * 32 + j) * 32 + b0] = t; } }
        }
    }
    __syncthreads();
}
__device__ __forceinline__ void flatten_phase(const Frame& F0) {
    const Frame F = phase_frame(F0);
    const unsigned short* seg = (const unsigned short*)(F.ws + WS_SEG); const unsigned* cnt = (const unsigned*)(F.ws + WS_CNT);
    unsigned short* flat = (unsigned short*)(F.ws + WS_FLAT); unsigned* rj = (unsigned*)(F.ws + WS_RJ);
    const int gw = F.vcu * NWAVES + F.wave, NGW = F.G * NWAVES;
    for (int v = gw; v < NHEAD * 31 * 4; v += NGW) {
        const int ch = v / (NHEAD * 31), it = v - ch * (NHEAD * 31);
        const int h = it / 31, j = it % 31;
        const int gbeg = j + 1 + 8 * ch, gend = (gbeg + 8 < 32) ? gbeg + 8 : 32;
        if (gbeg >= 32) continue;
        const unsigned c = (F.lane < 32 && F.lane > j) ? cnt[(h * 32 + j) * 32 + F.lane] : 0u, pc = (c + 31u) & ~31u;
        unsigned inc = pc;
#pragma unroll
        for (int o = 1; o < 32; o <<= 1) { const unsigned n = __shfl_up(inc, o); if (F.lane >= o) inc += n; }
        const unsigned offl = inc - pc;
        const unsigned total = (unsigned)__builtin_amdgcn_readlane((int)inc, 31), rounds = (total + 255u) >> 8;
        const unsigned long long nz = __ballot(c > 0u);
        unsigned short* fl = flat + (size_t)it * 8192;
        const unsigned short* sbase = seg + (size_t)(h * 32 + j) * 32 * 256;
        for (int g0 = gbeg; g0 < gend; g0 += 4) {
            unsigned ev[4][4];
#pragma unroll
            for (int k = 0; k < 4; ++k) { const int b0 = (g0 + k < gend) ? g0 + k : 31; const unsigned cb = (g0 + k < gend) ? (unsigned)__builtin_amdgcn_readlane((int)c, b0) : 0u, cpb = (cb + 31u) & ~31u;
#pragma unroll
                for (int q = 0; q < 4; ++q) { const unsigned t = (unsigned)F.lane + 64u * q; ev[k][q] = 0u;
                    if (t < cpb) ev[k][q] = (t < cb) ? (unsigned)sbase[b0 * 256 + t] : ((unsigned)sbase[b0 * 256 + (t & ~31u)] | 0x10000u); } }
#pragma unroll
            for (int k = 0; k < 4; ++k) { const int b0 = (g0 + k < gend) ? g0 + k : 31; const unsigned cb = (g0 + k < gend) ? (unsigned)__builtin_amdgcn_readlane((int)c, b0) : 0u, cpb = (cb + 31u) & ~31u;
                const unsigned ob = (unsigned)__builtin_amdgcn_readlane((int)offl, b0);
#pragma unroll
                for (int q = 0; q < 4; ++q) { const unsigned t = (unsigned)F.lane + 64u * q;
                    if (t < cpb) { const unsigned e = ev[k][q]; fl[ob + t] = (unsigned short)((e & 255u) | ((unsigned)b0 << 8) | (((e >> 8) & 3u) << 13) | ((e >> 16) << 15)); } } }
        }
        if (ch != 0) continue;
        if (total > 0u) { const unsigned bf = (unsigned)__builtin_ctzll(nz); const unsigned e0 = sbase[bf * 256];
            const unsigned short fill = (unsigned short)((e0 & 255u) | (bf << 8) | (((e0 >> 8) & 3u) << 13) | 0x8000u);
            for (unsigned idx = total + (unsigned)F.lane; idx < rounds * 256u; idx += 64u) fl[idx] = fill; }
        if (F.lane == 0) rj[it] = rounds;
    }
}

__device__ __forceinline__ att::BlockRef attn_ref_moba(const Frame& F, LAS unsigned* PT, int u, int ug, int wid, int r32, int hi) {
    const bf16* proj = (const bf16*)(F.ws + WS_PROJ); att::BlockRef r; int h, kb; unsigned row, pk, inact;
    if (u < ug) { int lo = 0, hiI = NHEAD * 31;
        while (hiI - lo > 1) { const int mid = (lo + hiI) >> 1; if ((int)PT[mid] <= u) lo = mid; else hiI = mid; }
        const unsigned short* fl = (const unsigned short*)(F.ws + WS_FLAT) + (size_t)lo * 8192;
        const unsigned ent = fl[(unsigned)(u - (int)PT[lo]) * 256u + (unsigned)(wid * 32 + r32)];
        h = lo / 31; kb = lo % 31; row = ent & 0x1fffu; pk = (ent >> 13) & 3u; inact = ent >> 15; r.flags = 3;
    } else { const int v = u - ug; h = v >> 5; kb = v & 31; row = (unsigned)(kb * 256 + wid * 32 + r32); pk = 3u; inact = 0u; r.flags = 2; }
    r.K = proj + (size_t)(kb * 256) * PW + SELF_W + h * HD; r.V = proj + (size_t)(kb * 256) * PW + 2 * SELF_W + h * HD;
    r.O = (char*)(F.ws + WS_PARTO) + (size_t)h * SEQ * 4 * HD * 2; r.ML = (float*)(F.ws + WS_PARTML) + (size_t)h * SEQ * 4 * 2;
    r.qoff = (unsigned)(row * PW + h * HD + hi * 8) * 2u; r.pinfo = (row * 4u + pk) | (inact << 31);
    r.P0 = 0; r.NT = 4;
    return r;
}
__device__ __forceinline__ void attn_phase_moba(const Frame& F0) {
    if (F0.G != 256) return;
    const Frame F = phase_frame(F0);
    char* lds = F.ldsg; const char* qbase = (const char*)(F.ws + WS_PROJ);
    const int wid = F.wave, r32 = F.lane & 31, hi = F.lane >> 5;
    LAS unsigned* PT = (LAS unsigned*)(F.lds + 73728);
    { const unsigned* rj = (const unsigned*)(F.ws + WS_RJ);
      for (int i = F.tid; i < NHEAD * 31; i += 512) PT[i + 1] = rj[i];
      __syncthreads();
      if (F.wave == 0) {
          unsigned v[12], t = 0u;
#pragma unroll
          for (int k = 0; k < 12; ++k) { const int i = F.lane * 12 + k; v[k] = (i < NHEAD * 31) ? PT[i + 1] : 0u; t += v[k]; }
          unsigned inc = t;
#pragma unroll
          for (int o = 1; o < 64; o <<= 1) { const unsigned n = __shfl_up(inc, o); if (F.lane >= o) inc += n; }
          unsigned a = inc - t;
#pragma unroll
          for (int k = 0; k < 12; ++k) { const int i = F.lane * 12 + k; a += v[k]; if (i < NHEAD * 31) PT[i + 1] = a; }
          if (F.lane == 0) PT[0] = 0u; }
      __syncthreads(); }
    const int ug = (int)PT[NHEAD * 31], U = ug + NHEAD * NBLK;
    int u = ((F.vcu & 31) >= 16) ? (F.vcu >> 5) * 16 + (F.vcu & 31) - 16 : 128 + (F.vcu >> 5) * 16 + (F.vcu & 31);
    att::Seam S;
    att::BlockRef cur = attn_ref_moba(F, PT, u, ug, wid, r32, hi);
    att::attn_prime(cur, qbase, lds, S, F.tid);
    for (;;) {
        const int un = u + F.G; const bool more = un < U;
        att::BlockRef nxt = cur;
        if (more) nxt = attn_ref_moba(F, PT, un, ug, wid, r32, hi);
        att::attn_block(cur, nxt, qbase, lds, S, F.tid);
        if (!more) break;
        cur = nxt; u = un;
    }
    VM_WAIT(); __builtin_amdgcn_s_waitcnt(0); __syncthreads();
}
__device__ __forceinline__ att2::Ref attn_ref_diff(const Frame& F, int i, int s, int r32, int hi) {
    const bf16* proj = (const bf16*)(F.ws + WS_PROJ); att2::Ref r;
    const int sh = (F.vcu >> 5) * 3 + (i >> 1), pr = F.vcu & 31, x = (i & 1) ? pr : 63 - pr;
    r.K = proj + SELF_W + sh * HD; r.V = proj + 2 * SELF_W + (sh >> 1) * 256;
    r.O = (char*)((bf16*)(F.ws + WS_OP) + (size_t)(x * 128) * OPW + sh * 256);
    r.qoff = (unsigned)((x * 128 + s * 32 + r32) * PW + sh * HD + hi * 8) * 2u; r.P0 = x * 128; r.NT = 2 * x + 2; r.desc = i & 1;
    return r;
}
__device__ __forceinline__ void attn_phase_diff(const Frame& F0) {
    if (F0.G != 256) return;
    const Frame F = phase_frame(F0);
    char* lds = F.ldsg; const char* qbase = (const char*)(F.ws + WS_PROJ);
    const int s = F.wave & 3, r32 = F.lane & 31, hi = F.lane >> 5;
    auto ref = [&](int i) { return attn_ref_diff(F, i, s, r32, hi); };
    int G = 0; for (int i = 0; i < 6; ++i) G += attn_ref_diff(F, i, s, r32, hi).NT;
    if (F.wave < 4) att2::score_stream(ref, 6, G, qbase, lds, F.tid);
    else att2::helper_stream(ref, 6, G, lds, F.tid);
    VM_WAIT(); __builtin_amdgcn_s_waitcnt(0); __syncthreads();
}
__device__ __forceinline__ void moba_merge_phase(const Frame& F0) {
    const Frame F = phase_frame(F0);
    const bf16* po = (const bf16*)(F.ws + WS_PARTO); const float* pml = (const float*)(F.ws + WS_PARTML); bf16* att_o = (bf16*)(F.ws + WS_ATT);
    constexpr float C2 = 1.4426950408889634f * att::SCALE;
    const int gw = F.vcu * NWAVES + F.wave, NGW = F.G * NWAVES, hq = F.lane >> 4, d8 = (F.lane & 15) * 8;
    for (int it = gw; it < SEQ * 2; it += NGW) {
        const int row = it >> 1, hb = (it & 1) * 3, nv = (row >> 8) < 3 ? (row >> 8) : 3;
        f32x4 ml01[3], ml23[3]; v4u ov[3][4];
#pragma unroll
        for (int q = 0; q < 3; ++q) { const size_t slot = ((size_t)((hb + q) * 4 + hq) * SEQ + row) * 4;
            ml01[q] = *(const f32x4*)(pml + slot * 2); ml23[q] = *(const f32x4*)(pml + slot * 2 + 4);
#pragma unroll
            for (int p4 = 0; p4 < 4; ++p4) ov[q][p4] = *(const v4u*)(po + (slot + p4) * HD + d8); }
#pragma unroll
        for (int q = 0; q < 3; ++q) { const int h = (hb + q) * 4 + hq;
            const float mp[4] = {ml01[q][0], ml01[q][2], ml23[q][0], ml23[q][2]}, lp[4] = {ml01[q][1], ml01[q][3], ml23[q][1], ml23[q][3]};
            float M = mp[3];
#pragma unroll
            for (int p4 = 0; p4 < 3; ++p4) M = (p4 < nv) ? fmaxf(M, mp[p4]) : M;
            float w[4], ws = 0.f;
#pragma unroll
            for (int p4 = 0; p4 < 4; ++p4) { w[p4] = (p4 == 3 || p4 < nv) ? lp[p4] * __builtin_amdgcn_exp2f((mp[p4] - M) * C2) : 0.f; ws += w[p4]; }
            const float rw = 1.0f / ws; float acc[8];
#pragma unroll
            for (int k = 0; k < 8; ++k) acc[k] = 0.f;
#pragma unroll
            for (int p4 = 0; p4 < 4; ++p4) { if (p4 == 3 || p4 < nv) { const float wp = w[p4] * rw; const v4u x = ov[q][p4];
                acc[0] += wp * bf_lo(x.x); acc[1] += wp * bf_hi(x.x); acc[2] += wp * bf_lo(x.y); acc[3] += wp * bf_hi(x.y);
                acc[4] += wp * bf_lo(x.z); acc[5] += wp * bf_hi(x.z); acc[6] += wp * bf_lo(x.w); acc[7] += wp * bf_hi(x.w); } }
            v4u o; o.x = cvt_pk_bf16(acc[0], acc[1]); o.y = cvt_pk_bf16(acc[2], acc[3]); o.z = cvt_pk_bf16(acc[4], acc[5]); o.w = cvt_pk_bf16(acc[6], acc[7]);
            *(v4u*)(att_o + (size_t)row * OPW + h * HD + d8) = o; }
    }
}

__device__ __forceinline__ void diff_combine_phase(const Frame& F0, const Args& a) {
    const Frame F = phase_frame(F0);
    const bf16* op = (const bf16*)(F.ws + WS_OP); bf16* att_o = (bf16*)(F.ws + WS_ATT);
    float d1 = 0.f, d2 = 0.f;
    { const float* q1 = (const float*)a.in[IN_LQ1]; const float* k1 = (const float*)a.in[IN_LK1]; const float* q2 = (const float*)a.in[IN_LQ2]; const float* k2 = (const float*)a.in[IN_LK2];
      d1 = q1[F.lane] * k1[F.lane] + q1[F.lane + 64] * k1[F.lane + 64]; d2 = q2[F.lane] * k2[F.lane] + q2[F.lane + 64] * k2[F.lane + 64];
      d1 = wave_sum(d1); d2 = wave_sum(d2); }
    const float lam = __expf(d1) - __expf(d2) + LAM_INIT;
    const f32x4 gs = *(const f32x4*)((const float*)a.in[IN_GSUB] + F.lane * 4);
    const int gw = F.vcu * NWAVES + F.wave, NGW = F.G * NWAVES;
    v2u w0[12], w1[12], n0[12], n1[12];
    if (gw < SEQ) { const bf16* orow = op + (size_t)gw * OPW + F.lane * 4;
#pragma unroll
        for (int h = 0; h < 12; ++h) { w0[h] = *(const v2u*)(orow + (h * 2 + 0) * 256); w1[h] = *(const v2u*)(orow + (h * 2 + 1) * 256); } }
    for (int row = gw; row < SEQ; row += NGW) {
        { const int nr = (row + NGW < SEQ) ? row + NGW : row; const bf16* orow = op + (size_t)nr * OPW + F.lane * 4;
#pragma unroll
          for (int h = 0; h < 12; ++h) { n0[h] = *(const v2u*)(orow + (h * 2 + 0) * 256); n1[h] = *(const v2u*)(orow + (h * 2 + 1) * 256); } }
#pragma unroll
        for (int h = 0; h < 12; ++h) {
            float o[4] = {bf_lo(w0[h].x) - lam * bf_lo(w1[h].x), bf_hi(w0[h].x) - lam * bf_hi(w1[h].x), bf_lo(w0[h].y) - lam * bf_lo(w1[h].y), bf_hi(w0[h].y) - lam * bf_hi(w1[h].y)};
            float s = (o[0] * o[0] + o[1] * o[1]) + (o[2] * o[2] + o[3] * o[3]); s = wave_sum(s);
            const float rs = __builtin_amdgcn_rsqf(s * (1.0f / 256.0f) + SUBLN_EPS) * (1.0f - LAM_INIT);
            v2u r; r.x = cvt_pk_bf16(o[0] * rs * gs[0], o[1] * rs * gs[1]); r.y = cvt_pk_bf16(o[2] * rs * gs[2], o[3] * rs * gs[3]);
            *(v2u*)(att_o + (size_t)row * OPW + h * 256 + F.lane * 4) = r;
        }
#pragma unroll
        for (int h = 0; h < 12; ++h) { w0[h] = n0[h]; w1[h] = n1[h]; }
    }
}

constexpr int N_PHASES = 2 + 2 * 9;
__global__ void __launch_bounds__(NWAVES * 64, 2) hybrid_fwd(Args args) {
    extern __shared__ __attribute__((aligned(16))) unsigned char lds[];
    Frame F;
    F.lds = (LAS unsigned char*)lds; F.ldsg = (char*)lds; F.ws = args.ws;
    F.tid = threadIdx.x; F.lane = F.tid & 63; F.wave = __builtin_amdgcn_readfirstlane(F.tid >> 6);
    asm volatile("" : "+s"(F.wave));
    F.G = gridDim.x; { const int bx = blockIdx.x; F.vcu = (F.G % 8 == 0) ? (bx % 8) * (F.G / 8) + bx / 8 : bx; }
    volatile LAS unsigned* MISC = (volatile LAS unsigned*)(F.lds + MISC_OFF);
    for (int u = F.tid; u < 64; u += NWAVES * 64) MISC[u] = 0u;
    __syncthreads();
    const int lo = args.ph_lo, hi = args.ph_hi;
    const bool one = (hi - lo) > 1;
    gu32* ctl = (gu32*)(args.ws + WS_CTL);
    XcdBarrier bar; bar.bar = (unsigned*)(ctl + CW_BAR); bar.x = 0; bar.st = nullptr;
    if (one) bar = xcd_barrier_post((unsigned*)(ctl + CW_BAR), MISC + 8);
#ifndef PH_MASK
#define PH_MASK 0xffff
#endif
#define IN(k) (lo <= (k) && (k) < hi)
#define EN(b) ((PH_MASK >> (b)) & 1)
#ifndef PROBE_ATT
#define PROBE_ATT -1
#endif
#ifndef PROBE_OUT
#define PROBE_OUT 0
#endif
#ifndef PROBE_DUP
#define PROBE_DUP 0
#endif
#ifndef PROBE_ID
#define PROBE_ID 0
#endif
#define DUP(id) _Pragma("unroll") for (int rp_ = 0; rp_ < ((PROBE_ID == (id)) ? 2 : 1); ++rp_)
#define REP(b) _Pragma("unroll") for (int rep_ = 0; rep_ < (((PROBE_DUP >> (b)) & 1) ? 2 : 1); ++rep_)
#define SEAM0(k) do { if (IN(k) && IN((k) + 1)) { XcdBarrier b2_ = bar; size_t bz_ = 0; asm volatile("" : "+s"(bz_)); b2_.bar = bar.bar + bz_; xcd_barrier(b2_); } } while (0)
#define SEAM(k) do { if (IN(k) && IN((k) + 1)) xcd_barrier_slim((gu32*)bar.bar, bar.x, bar.st, F.wave == 0 && lane_id_now() == 0); } while (0)
    float* xout = args.out;
    PG8_LAS float* exch = (PG8_LAS float*)(F.lds + EXCH_OFF);
#define WSP(T, off) ((T*)(wsl + (off)))
#define WS_LOCAL() size_t wz_ = 0; asm volatile("" : "+s"(wz_)); unsigned char* wsl = args.ws + wz_

    if (EN(0) && IN(0)) { p0a_prologue(F, args); }
    SEAM0(0);
    if (EN(0) && IN(1)) {
        const int skip = F.G > 16 ? 8 : 0;
        { WS_LOCAL();
          pg8::Gemm g{WSP(bf16, WS_MEMB), WSP(const bf16, WS_WMK), MEML, 2 * MEM_W, DM, DM, DM, 0}; pg8::StaticOrder S; S.init(MEML, 2 * MEM_W, F.G, F.vcu);
          pg8::EpiMKV E{WSP(float, WS_MKV), 2 * MEM_W, WSP(const float, WS_RSM)};
          pg8::gemm_phase<pg8::EpiMKV, pg8::StaticOrder>(F.lds, g, S, E, F.wave); }
        __syncthreads();
        DUP(1) p0b_weights(F, args, skip);
    }
    SEAM(1);
#pragma unroll 1
    for (int l = 0; l < 2; ++l) {
        const int pb = 2 + 9 * l;
        if (EN(1) && IN(pb + 0)) DUP(2) {
            WS_LOCAL();
            pg8::Gemm g{WSP(bf16, WS_XB), WSP(const bf16, WS_WIN + l * SZ_WIN), SEQ, PW, DM, DM, DM, 0, 1}; pg8::StaticOrder S; S.init(SEQ, PW, F.G, (int)blockIdx.x);
            pg8::EpiProjN E{WSP(bf16, WS_PROJ), PW, WSP(float, WS_SSB), 1.0f / DM, NORM_EPS, exch, (PG8_LAS float*)(F.lds + MISC_OFF + 256), (const float*)args.in[IN_GQ] + l * HD, (const float*)args.in[IN_GK] + l * HD,
                            (const int*)args.in[IN_POS], l == 0 ? WSP(float, WS_KSUM) : nullptr};
            pg8::gemm_phase<pg8::EpiProjN, pg8::StaticOrder>(F.lds, g, S, E, F.wave);
        }
        SEAM(pb + 0);
        if (l == 0) {
            if (EN(3) && IN(pb + 2)) DUP(3) { memprep_phase(F, args, 0); memprep_phase(F, args, 1); gate_phase(F); }
            SEAM(pb + 2);
        }
        if (l == 0) { if (IN(pb + 3)) DUP(4) flatten_phase(F); SEAM(pb + 3); }
        if (IN(pb + 4)) {
            if (EN(4)) DUP(5) { WS_LOCAL();
              pg8::Gemm g{WSP(bf16, WS_PROJ) + 3 * SELF_W, WSP(const bf16, WS_KMN + l * 524288), SEQ, MEM_W, 256, PW, 256, 256}; pg8::StaticOrder S; S.init(SEQ, MEM_W, F.G, (int)blockIdx.x);
              pg8::EpiMemS E{WSP(bf16, WS_PM), WSP(float, WS_PS)};
              pg8::gemm_phase<pg8::EpiMemS, pg8::StaticOrder>(F.lds, g, S, E, F.wave); }
            __syncthreads();
            if (EN(5)) { if (l == 0) DUP(6) attn_phase_moba(F); else DUP(7) attn_phase_diff(F); }
        }
        SEAM(pb + 4);
        if (IN(pb + 5)) {
            if (EN(6)) DUP(8) { WS_LOCAL();
              pg8::Gemm g{WSP(bf16, WS_PM), WSP(const bf16, WS_VT), SEQ, MEM_W, 256, MEM_W, 256, 256}; pg8::StaticOrder S; S.init(SEQ, MEM_W, F.G, (int)blockIdx.x);
              pg8::EpiMemO E{WSP(bf16, WS_ATT), WSP(float, WS_PS)};
              pg8::gemm_phase<pg8::EpiMemO, pg8::StaticOrder>(F.lds, g, S, E, F.wave); }
            if (EN(7)) { if (l == 0) DUP(9) moba_merge_phase(F); else DUP(10) diff_combine_phase(F, args); }
        }
        SEAM(pb + 5);
        if (EN(8) && IN(pb + 6)) {
            WS_LOCAL();
            pg8::Gemm g{WSP(bf16, WS_ATT), WSP(const bf16, WS_WOUT + l * SZ_WOUT), SEQ, DM, DM, OPW, DM, 0, 1}; pg8::StaticOrder S; S.init(SEQ, DM, F.G, (int)blockIdx.x);
            pg8::EpiRes<false> E{nullptr, nullptr, WSP(bf16, WS_XB), WSP(float, WS_SSA), DM, exch};
            pg8::gemm_phase<pg8::EpiRes<false>, pg8::StaticOrder>(F.lds, g, S, E, F.wave);
        }
        SEAM(pb + 6);
        if (EN(9) && IN(pb + 7)) REP(9) {
            WS_LOCAL();
            pg8::Gemm g{WSP(bf16, WS_XB), WSP(const bf16, WS_WGU + l * SZ_WGU), SEQ, NGU, DM, DM, DM, 0, 1}; pg8::StaticOrder S; S.init(SEQ, NGU, F.G, (int)blockIdx.x);
            pg8::EpiGU E{WSP(bf16, WS_HID), DFF, WSP(float, WS_SSA), 1.0f / DM, NORM_EPS, (PG8_LAS float*)(F.lds + MISC_OFF + 256)};
            pg8::gemm_phase<pg8::EpiGU, pg8::StaticOrder>(F.lds, g, S, E, F.wave);
        }
        SEAM(pb + 7);
        if (EN(10) && IN(pb + 8)) {
            WS_LOCAL();
            pg8::Gemm g{WSP(bf16, WS_HID), WSP(const bf16, WS_WDN + l * SZ_WDN), SEQ, DM, DFF, DFF, DFF, 0, 1}; pg8::StaticOrder S; S.init(SEQ, DM, F.G, (int)blockIdx.x);
            pg8::EpiRes<true> E{nullptr, l == 1 ? xout : (float*)nullptr, WSP(bf16, WS_XB), WSP(float, WS_SSB), DM, exch};
            pg8::gemm_phase<pg8::EpiRes<true>, pg8::StaticOrder>(F.lds, g, S, E, F.wave);
        }
        SEAM(pb + 8);
    }
#undef IN
#undef SEAM
#undef SEAM0
}

extern "C" void kernel_launch(void* const* d_in, const int* in_sizes, int n_in, void* d_out, int out_size, void* d_ws, size_t ws_size, hipStream_t stream) {
    static int grid = 0;
    if (grid == 0) {
        if (n_in != N_IN || in_sizes[0] != SEQ * DM || out_size != SEQ * DM || ws_size < WS_END) {
            fprintf(stderr, "kernel_launch: unexpected shapes (n_in %d, in0 %d, out %d, ws %zu < %zu); nothing launched\n", n_in, n_in > 0 ? in_sizes[0] : -1, out_size, ws_size, (size_t)WS_END); grid = -1; return; }
        int dev = 0, cus = 0, per_cu = 0;
        if (hipGetDevice(&dev) != hipSuccess || hipDeviceGetAttribute(&cus, hipDeviceAttributeMultiprocessorCount, dev) != hipSuccess) { grid = -1; return; }
        if (hipFuncSetAttribute((const void*)hybrid_fwd, hipFuncAttributeMaxDynamicSharedMemorySize, LDS_BYTES) != hipSuccess) { fprintf(stderr, "kernel_launch: hipFuncSetAttribute failed\n"); grid = -1; return; }
        if (hipOccupancyMaxActiveBlocksPerMultiprocessor(&per_cu, (const void*)hybrid_fwd, NWAVES * 64, LDS_BYTES) != hipSuccess || per_cu < 1)
            fprintf(stderr, "kernel_launch: note: occupancy query reports %d workgroups per CU\n", per_cu);
        (void)hipGetLastError();
        grid = cus;
        if (grid != 256) fprintf(stderr, "kernel_launch: %d CUs; the attention phase is dealt for 256\n", grid);
    }
    if (grid < 0) return;
    if (hipMemsetAsync((char*)d_ws + WS_CTL, 0, CTL_ZERO_BYTES, stream) != hipSuccess) return;
    Args a{};
    for (int i = 0; i < N_IN; ++i) a.in[i] = d_in[i];
    a.out = (float*)d_out; a.ws = (unsigned char*)d_ws;
#if MK_ONE_LAUNCH
    a.ph_lo = 0; a.ph_hi = N_PHASES;
    hipLaunchKernelGGL(hybrid_fwd, dim3(grid), dim3(NWAVES * 64), LDS_BYTES, stream, a);
#else
    for (int p = 0; p < N_PHASES; ++p) {
        if (p == 2 + 1 || p == 2 + 9 + 1 || p == 2 + 9 + 3) continue;
        a.ph_lo = p; a.ph_hi = p + 1;
        hipLaunchKernelGGL(hybrid_fwd, dim3(grid), dim3(NWAVES * 64), LDS_BYTES, stream, a);
    }
#endif
}
```

```cpp
#include <hip/hip_runtime.h>
#include <cstdio>
#include <cstdint>

#ifndef MK_ONE_LAUNCH
#define MK_ONE_LAUNCH 1
#endif

constexpr int SEQ = 8192, DM = 4096, PW = 10240, SELF_W = 3072, MEM_W = 1024, DFF = 11008, NGU = 2 * DFF, MEML = 256, HD = 128;
constexpr int NHEAD = 24;
constexpr int NBLK = SEQ / 256;
constexpr int OPW = 48 * HD;
constexpr float NORM_EPS = 1e-6f, SUBLN_EPS = 1e-5f;
constexpr float LAM_INIT = 0.35550906759096934f;

enum { IN_X = 0, IN_MEM, IN_POS, IN_GATTN, IN_WIN, IN_WOUT, IN_GQ, IN_GK, IN_GMQ, IN_GMK, IN_GMEM, IN_WMEMKV, IN_LQ1, IN_LK1, IN_LQ2, IN_LK2, IN_GSUB, IN_GFFN, IN_WGATE, IN_WUP, IN_WDOWN, N_IN };

constexpr size_t MiB = 1u << 20;
constexpr size_t SZ_WIN = (size_t)PW * DM * 2, SZ_WOUT = (size_t)DM * DM * 2, SZ_WGU = (size_t)NGU * DM * 2, SZ_WDN = (size_t)DM * DFF * 2;
constexpr size_t WS_CTL = 0, CTL_ZERO_BYTES = 64 * 1024;
constexpr size_t WS_WIN = 1 * MiB;
constexpr size_t WS_WOUT = WS_WIN + 2 * SZ_WIN;
constexpr size_t WS_WGU = WS_WOUT + 2 * SZ_WOUT;
constexpr size_t WS_WDN = WS_WGU + 2 * SZ_WGU;
constexpr size_t WS_XB = WS_WDN + 2 * SZ_WDN;
constexpr size_t WS_PROJ = WS_XB + (size_t)SEQ * DM * 2;
constexpr size_t WS_ATT = WS_PROJ + (size_t)SEQ * PW * 2;
constexpr size_t WS_HID = WS_ATT + (size_t)SEQ * OPW * 2;
constexpr size_t WS_OP = WS_HID + (size_t)SEQ * DFF * 2;
constexpr size_t WS_PM = WS_OP + (size_t)SEQ * OPW * 2;
constexpr size_t WS_SSA = WS_PM + (size_t)SEQ * MEM_W * 2;
constexpr size_t WS_SSB = WS_SSA + 1 * MiB;
constexpr size_t WS_CS = WS_SSB + 1 * MiB;
constexpr size_t WS_MKV = WS_CS + 1 * MiB;
constexpr size_t WS_KMN = WS_MKV + 2 * MiB;
constexpr size_t WS_VT = WS_KMN + 1 * MiB;
constexpr size_t WS_KSUM = WS_VT + 1 * MiB;
constexpr size_t WS_SEG = WS_KSUM + 2 * MiB;
constexpr size_t WS_CNT = WS_SEG + (size_t)NHEAD * 32 * 32 * 256 * 2;
constexpr size_t WS_FLAT = WS_CNT + 1 * MiB;
constexpr size_t WS_RJ = WS_FLAT + (size_t)NHEAD * 31 * 8192 * 2;
constexpr size_t WS_PARTO = WS_RJ + 1 * MiB;
constexpr size_t WS_PARTML = WS_PARTO + (size_t)NHEAD * SEQ * 4 * HD * 2;
constexpr size_t WS_PS = WS_PARTML + (size_t)NHEAD * SEQ * 4 * 2 * 4;
constexpr size_t WS_WMK = WS_PS + 1 * MiB;
constexpr size_t WS_MEMB = WS_WMK + (size_t)2 * MEM_W * DM * 2;
constexpr size_t WS_RSM = WS_MEMB + (size_t)MEML * DM * 2;
constexpr size_t WS_END = WS_RSM + 1 * MiB;
constexpr int CW_TMO = 0, CW_GATEQ = 64, CW_BAR = 4096;

constexpr int RING_BYTES = 131072;
constexpr int EXCH_OFF = RING_BYTES;
constexpr int MISC_OFF = EXCH_OFF + 8192;
constexpr int LDS_BYTES = 147456;
static_assert(MISC_OFF + 256 + 2048 <= LDS_BYTES, "LDS map");

#define GAS __attribute__((address_space(1)))
#define LAS __attribute__((address_space(3)))
typedef unsigned short bf16;
typedef unsigned v4u __attribute__((ext_vector_type(4)));
typedef unsigned v2u __attribute__((ext_vector_type(2)));
typedef float f32x4 __attribute__((ext_vector_type(4)));
typedef float f32x2 __attribute__((ext_vector_type(2)));
typedef float f32x16 __attribute__((ext_vector_type(16)));
typedef short bf16x8 __attribute__((ext_vector_type(8)));
typedef short s16x4 __attribute__((ext_vector_type(4)));
typedef GAS unsigned gu32;
#define RLX_AGENT __ATOMIC_RELAXED, __HIP_MEMORY_SCOPE_AGENT
#define LDS_WAIT() asm volatile("s_waitcnt lgkmcnt(0)" ::: "memory")
#define VM_WAIT() asm volatile("s_waitcnt vmcnt(0)" ::: "memory")

__device__ __forceinline__ unsigned cvt_pk_bf16(float lo, float hi) { unsigned r; asm volatile("v_cvt_pk_bf16_f32 %0, %1, %2" : "=v"(r) : "v"(lo), "v"(hi)); return r; }
__device__ __forceinline__ float bf_lo(unsigned w) { return __uint_as_float(w << 16); }
__device__ __forceinline__ float bf_hi(unsigned w) { return __uint_as_float(w & 0xffff0000u); }
__device__ __forceinline__ float wave_sum(float v) {
#pragma unroll
    for (int o = 1; o < 64; o <<= 1) v += __shfl_xor(v, o);
    return v;
}

namespace pg8 {
#define PG8_LAS __attribute__((address_space(3)))
typedef unsigned short bf16_t;
typedef unsigned u32x4 __attribute__((ext_vector_type(4)));
constexpr int BM = 256, BK = 64, HALF = 128, HTB = HALF * BK * 2, STAGE_BYTES = 8 * HTB, NXCD = 8, WGM = 8;

__host__ __device__ __forceinline__ int lds_byte(int r, int c) { const int st = (r >> 4) * 2 + (c >> 5), rr = r & 15, cc = c & 31, ob = rr * 64 + cc * 2; return st * 1024 + (ob ^ (((ob >> 9) & 1) << 5)); }
__host__ __device__ __forceinline__ void stage_rc(int b, int& R, int& C) { const int st = b / 1024, sb = b % 1024, swz = sb ^ (((sb >> 9) & 1) << 5); R = (st >> 1) * 16 + swz / 64; C = (st & 1) * 32 + (swz % 64) / 2; }
__host__ __device__ __forceinline__ int perm32(int rho) { const int n = rho >> 4, i = rho & 15; return 8 * (i >> 2) + 4 * n + (i & 3); }

struct Unit { int pm, pn; };
struct Gemm { const bf16_t* A; const bf16_t* Bt; int M, N, K, lda, ldb, a_pn_step, b_oct; };

struct StaticOrder {
    int nM, nN, nwg, G, c;
    __host__ __device__ void init(int M, int N, int G_, int c_) { nM = M / BM; nN = N / BM; nwg = nM * nN; G = G_; c = c_; }
    __host__ __device__ bool next(int i, Unit& u) const {
        const long L = (long)i * G + c; if (L >= nwg) return false;
        int wgid = (int)L; { const int q = nwg / NXCD, r = nwg % NXCD, xcd = wgid % NXCD, off = wgid / NXCD; wgid = (xcd < r ? xcd * (q + 1) : r * (q + 1) + (xcd - r) * q) + off; }
        const int nig = WGM * nN, gid = wgid / nig, fm = gid * WGM, gsz = (nM - fm) < WGM ? (nM - fm) : WGM;
        u.pm = fm + ((wgid % nig) % gsz); u.pn = (wgid % nig) / gsz; return true;
    }
    __device__ __forceinline__ void a_ready(const Unit&) const {}
    __device__ __forceinline__ void done(const Unit&) const {}
};

__device__ __forceinline__ float row_rstd(const float* ss, int row, float inv_d, float eps) {
    const f32x4* sp = (const f32x4*)(ss + (size_t)row * 16);
    const f32x4 a = sp[0], b = sp[1], c = sp[2], d = sp[3];
    const float t = ((a[0] + a[1]) + (a[2] + a[3])) + ((b[0] + b[1]) + (b[2] + b[3])) + ((c[0] + c[1]) + (c[2] + c[3])) + ((d[0] + d[1]) + (d[2] + d[3]));
    return __builtin_amdgcn_rsqf(t * inv_d + eps);
}
struct EpiProj {
    static constexpr bool PERM = true, AFTER_DRAIN = false, BOCT = false, AOCT = false;
    bf16_t* O; int ldc; const float* ss; float inv_d, eps;
    __device__ __forceinline__ void operator()(const f32x4 (&acc)[2][2][4][2], const Unit& u, int wr, int wc, int fr, int fq) const {
        const int row0 = u.pm * BM + wr * 64 + fr, col0 = u.pn * BM + wc * 32 + 8 * fq;
#pragma unroll
        for (int ai = 0; ai < 2; ++ai)
#pragma unroll
            for (int m = 0; m < 4; ++m) { const int row = row0 + ai * HALF + m * 16; const float rs = row_rstd(ss, row, inv_d, eps);
                bf16_t* rowp = O + (size_t)row * ldc + col0;
#pragma unroll
                for (int bj = 0; bj < 2; ++bj) { const f32x4 v0 = acc[ai][bj][m][0] * rs, v1 = acc[ai][bj][m][1] * rs;
                    u32x4 w; w.x = cvt_pk_bf16(v0[0], v0[1]); w.y = cvt_pk_bf16(v0[2], v0[3]); w.z = cvt_pk_bf16(v1[0], v1[1]); w.w = cvt_pk_bf16(v1[2], v1[3]);
                    *(u32x4*)(rowp + bj * HALF) = w; } }
    }
};
struct EpiProjN {
    static constexpr bool PERM = true, AFTER_DRAIN = false, BOCT = true, AOCT = true;
    bf16_t* O; int ldc; const float* ss; float inv_d, eps; PG8_LAS float* exch; PG8_LAS float* tab; const float* gq; const float* gk; const int* pos; float* ksum; const float* cs;
    static __device__ __forceinline__ float shx(float x, int lane_, int mask) { return __builtin_bit_cast(float, __builtin_amdgcn_ds_bpermute((lane_ ^ mask) << 2, __builtin_bit_cast(int, x))); }
    __device__ __forceinline__ void operator()(const f32x4 (&acc)[2][2][4][2], const Unit& u, int wr, int wc, int fr_in, int fq_in) const {
        int fr = fr_in, fq = fq_in; asm volatile("" : "+v"(fr), "+v"(fq));
        const int lane_ = fr + 16 * fq;
        const int row0 = u.pm * BM + wr * 64 + fr, col0 = u.pn * BM + wc * 32 + 8 * fq;
        char* Ob = (char*)O; const unsigned off0 = (unsigned)(row0 * PW + col0) * 2u;
        const int typ = u.pn < 12 ? 0 : u.pn < 24 ? 1 : u.pn < 36 ? 2 : 3;
        if (typ == 2) {
#pragma unroll
            for (int ai = 0; ai < 2; ++ai)
#pragma unroll
                for (int m = 0; m < 4; ++m) { const int row = row0 + ai * HALF + m * 16; const float rs = row_rstd(ss, row, inv_d, eps);
#pragma unroll
                    for (int bj = 0; bj < 2; ++bj) { const f32x4 v0 = acc[ai][bj][m][0] * rs, v1 = acc[ai][bj][m][1] * rs;
                        u32x4 w; w.x = cvt_pk_bf16(v0[0], v0[1]); w.y = cvt_pk_bf16(v0[2], v0[3]); w.z = cvt_pk_bf16(v1[0], v1[1]); w.w = cvt_pk_bf16(v1[2], v1[3]);
                        *(u32x4*)(Ob + (off0 + (unsigned)(((ai * HALF + m * 16) * PW + bj * HALF) * 2))) = w; } }
            return;
        }
#pragma unroll
        for (int ai = 0; ai < 2; ++ai)
#pragma unroll
            for (int m = 0; m < 4; ++m)
#pragma unroll
                for (int bj = 0; bj < 2; ++bj) { const f32x4 v0 = acc[ai][bj][m][0], v1 = acc[ai][bj][m][1];
                    float q = (v0[0] * v0[0] + v0[1] * v0[1]) + (v0[2] * v0[2] + v0[3] * v0[3]) + (v1[0] * v1[0] + v1[1] * v1[1]) + (v1[2] * v1[2] + v1[3] * v1[3]);
                    q += shx(q, lane_, 16); q += shx(q, lane_, 32);
                    if (fq == 0) exch[((ai * HALF + wr * 64 + m * 16 + fr) * 2 + bj) * 4 + wc] = q; }
        { const int t = (wr * 4 + wc) * 64 + fq * 16 + fr;
          if (t < 256) { tab[t] = row_rstd(ss, u.pm * BM + t, inv_d, eps); tab[256 + t] = __int_as_float(pos[u.pm * BM + t]); } }
        asm volatile("s_waitcnt lgkmcnt(0)" ::: "memory"); __builtin_amdgcn_s_barrier(); asm volatile("" ::: "memory");
        f32x4 g0 = {1.f, 1.f, 1.f, 1.f}, g1 = g0;
        if (typ < 2) { const float* gp = (typ == 0 ? gq : gk) + wc * 32 + 8 * fq; g0 = *(const f32x4*)gp; g1 = *(const f32x4*)(gp + 4); }
        if (typ == 0 && ksum == nullptr) { constexpr float QS = 0.08838834764831845f * 1.4426950408889634f; g0 = g0 * QS; g1 = g1 * QS; }
        const bool hi8 = (fq & 1) != 0;
        float ks[2][8];
#pragma unroll
        for (int bj = 0; bj < 2; ++bj)
#pragma unroll
            for (int k = 0; k < 8; ++k) ks[bj][k] = 0.f;
#pragma unroll
        for (int ai = 0; ai < 2; ++ai)
#pragma unroll
            for (int m = 0; m < 4; ++m) { const int rl = ai * HALF + wr * 64 + m * 16 + fr;
                const f32x4 pa = *(const PG8_LAS f32x4*)(exch + (rl * 2 + 0) * 4), pb = *(const PG8_LAS f32x4*)(exch + (rl * 2 + 1) * 4);
                const float rs = tab[rl], rs2 = rs * rs;
                f32x4 c0 = {}, c1 = {}, s0 = {}, s1 = {};
                if (typ < 2 && wc == 0) { const char* cp = (const char*)cs + (size_t)u.pm * (BM * 128) + (unsigned)((rl * 32 + (hi8 ? 8 : 0)) * 4);
                    c0 = *(const f32x4*)cp; c1 = *(const f32x4*)(cp + 16); s0 = *(const f32x4*)(cp + 64); s1 = *(const f32x4*)(cp + 80); }
                float sa = ((pa[0] + pa[1]) + (pa[2] + pa[3])) * rs2, sb = ((pb[0] + pb[1]) + (pb[2] + pb[3])) * rs2;
                if (typ == 3) { sa = sb = (sa + sb) * 0.5f; }
#pragma unroll
                for (int bj = 0; bj < 2; ++bj) {
                    const float sc = rs * __builtin_amdgcn_rsqf((bj == 0 ? sa : sb) * (1.0f / 128.0f) + eps); const f32x4 v0 = acc[ai][bj][m][0] * sc * g0, v1 = acc[ai][bj][m][1] * sc * g1;
                    float y[8] = {v0[0], v0[1], v0[2], v0[3], v1[0], v1[1], v1[2], v1[3]};
                    if (typ < 2 && wc == 0) {
#pragma unroll
                        for (int k = 0; k < 8; ++k) { const float cn = k < 4 ? c0[k & 3] : c1[k & 3], sn = k < 4 ? s0[k & 3] : s1[k & 3];
                            const float other = shx(y[k], lane_, 32);
                            y[k] = (fq < 2) ? y[k] * cn - other * sn : y[k] * cn + other * sn; } }
#pragma unroll
                    for (int k = 0; k < 8; ++k) ks[bj][k] += y[k];
                    u32x4 w; w.x = cvt_pk_bf16(y[0], y[1]); w.y = cvt_pk_bf16(y[2], y[3]); w.z = cvt_pk_bf16(y[4], y[5]); w.w = cvt_pk_bf16(y[6], y[7]);
                    *(u32x4*)(Ob + (off0 + (unsigned)(((ai * HALF + m * 16) * PW + bj * HALF) * 2))) = w;
                    asm volatile("" : "+v"(ks[bj][0]), "+v"(ks[bj][1]), "+v"(ks[bj][2]), "+v"(ks[bj][3]), "+v"(ks[bj][4]), "+v"(ks[bj][5]), "+v"(ks[bj][6]), "+v"(ks[bj][7]) :: "memory"); } }
        if (typ == 1 && ksum != nullptr) {
#pragma unroll
            for (int bj = 0; bj < 2; ++bj)
#pragma unroll
                for (int k = 0; k < 8; ++k) { float t = ks[bj][k]; t += shx(t, lane_, 1); t += shx(t, lane_, 2); t += shx(t, lane_, 4); t += shx(t, lane_, 8); ks[bj][k] = t; }
            if (fr == 0) {
#pragma unroll
                for (int bj = 0; bj < 2; ++bj) { float* kp = ksum + ((size_t)((2 * (u.pn - 12) + bj) * 32 + u.pm) * 2 + wr) * 128 + wc * 32 + 8 * fq;
                    *(f32x4*)kp = (f32x4){ks[bj][0], ks[bj][1], ks[bj][2], ks[bj][3]}; *(f32x4*)(kp + 4) = (f32x4){ks[bj][4], ks[bj][5], ks[bj][6], ks[bj][7]}; } }
        }
    }
};
__device__ __forceinline__ float silu_mul(float g, float u) { const float e = __builtin_amdgcn_exp2f(-1.4426950408889634f * g); return g * __builtin_amdgcn_rcpf(1.0f + e) * u; }
struct EpiGU {
    static constexpr bool PERM = true, AFTER_DRAIN = false, BOCT = true, AOCT = true;
    bf16_t* O; int ldc; const float* ss; float inv_d, eps; PG8_LAS float* tab;
    __device__ __forceinline__ void operator()(const f32x4 (&acc)[2][2][4][2], const Unit& u, int wr, int wc, int fr_in, int fq_in) const {
        int fr = fr_in, fq = fq_in; asm volatile("" : "+v"(fr), "+v"(fq));
        { const int t = (wr * 4 + wc) * 64 + fq * 16 + fr; if (t < 256) tab[t] = row_rstd(ss, u.pm * BM + t, inv_d, eps); }
        asm volatile("s_waitcnt lgkmcnt(0)" ::: "memory"); __builtin_amdgcn_s_barrier(); asm volatile("" ::: "memory");
        char* Ob = (char*)O; const unsigned off0 = (unsigned)(((u.pn * HALF + wc * 32 + 8 * fq) >> 3) * SEQ + u.pm * BM + wr * 64 + fr) * 16u;
#pragma unroll
        for (int ai = 0; ai < 2; ++ai)
#pragma unroll
            for (int m = 0; m < 4; ++m) { const float rs = tab[ai * HALF + wr * 64 + m * 16 + fr];
                const f32x4 g0 = acc[ai][0][m][0] * rs, g1 = acc[ai][0][m][1] * rs, u0 = acc[ai][1][m][0] * rs, u1 = acc[ai][1][m][1] * rs;
                u32x4 w; w.x = cvt_pk_bf16(silu_mul(g0[0], u0[0]), silu_mul(g0[1], u0[1])); w.y = cvt_pk_bf16(silu_mul(g0[2], u0[2]), silu_mul(g0[3], u0[3]));
                w.z = cvt_pk_bf16(silu_mul(g1[0], u1[0]), silu_mul(g1[1], u1[1])); w.w = cvt_pk_bf16(silu_mul(g1[2], u1[2]), silu_mul(g1[3], u1[3]));
                *(u32x4*)(Ob + (off0 + (unsigned)((ai * HALF + m * 16) * 16))) = w; }
    }
};
template <bool AOCT_> struct EpiRes {
    static constexpr bool PERM = true, AFTER_DRAIN = false, BOCT = true, AOCT = AOCT_;
    const float* base32; float* out32; bf16_t* xb; float* ss; int ldc; PG8_LAS float* exch;
    __device__ __forceinline__ void operator()(const f32x4 (&acc)[2][2][4][2], const Unit& u, int wr, int wc, int fr, int fq) const {
        const int row0 = u.pm * BM + wr * 64 + fr, col0 = u.pn * BM + wc * 32 + 8 * fq;
        const bool fin = out32 != nullptr;
#pragma unroll
        for (int ai = 0; ai < 2; ++ai)
#pragma unroll
            for (int m = 0; m < 4; ++m) { const int row = row0 + ai * HALF + m * 16; const size_t off = (size_t)row * ldc + col0; float q = 0.f;
#pragma unroll
                for (int bj = 0; bj < 2; ++bj) { char* xp = (char*)xb + ((size_t)((col0 + bj * HALF) >> 3) * SEQ + row) * 16;
                    const u32x4 r = *(const u32x4*)xp;
                    const f32x4 b0 = (f32x4){bf_lo(r.x), bf_hi(r.x), bf_lo(r.y), bf_hi(r.y)}, b1 = (f32x4){bf_lo(r.z), bf_hi(r.z), bf_lo(r.w), bf_hi(r.w)};
                    const f32x4 o0 = b0 + acc[ai][bj][m][0], o1 = b1 + acc[ai][bj][m][1];
                    if (fin) { *(f32x4*)(out32 + off + bj * HALF) = o0; *(f32x4*)(out32 + off + bj * HALF + 4) = o1; }
                    else { q += (o0[0] * o0[0] + o0[1] * o0[1]) + (o0[2] * o0[2] + o0[3] * o0[3]) + (o1[0] * o1[0] + o1[1] * o1[1]) + (o1[2] * o1[2] + o1[3] * o1[3]);
                        u32x4 w; w.x = cvt_pk_bf16(o0[0], o0[1]); w.y = cvt_pk_bf16(o0[2], o0[3]); w.z = cvt_pk_bf16(o1[0], o1[1]); w.w = cvt_pk_bf16(o1[2], o1[3]);
                        *(u32x4*)xp = w; } }
                if (!fin) { q += __shfl_xor(q, 16); q += __shfl_xor(q, 32); if (fq == 0) exch[(ai * HALF + wr * 64 + m * 16 + fr) * 4 + wc] = q; }
                asm volatile("" ::: "memory"); }
        if (!fin) {
            asm volatile("s_waitcnt lgkmcnt(0)" ::: "memory"); __builtin_amdgcn_s_barrier(); asm volatile("" ::: "memory");
            const int t = (wr * 4 + wc) * 64 + fq * 16 + fr;
            if (t < 256) { const f32x4 p = *(const PG8_LAS f32x4*)(exch + t * 4); ss[(size_t)(u.pm * BM + t) * 16 + u.pn] = (p[0] + p[1]) + (p[2] + p[3]); }
        }
    }
};
struct EpiMKV {
    static constexpr bool PERM = true, AFTER_DRAIN = false, BOCT = false, AOCT = false;
    float* O; int ldc; const float* rs;
    __device__ __forceinline__ void operator()(const f32x4 (&acc)[2][2][4][2], const Unit& u, int wr, int wc, int fr, int fq) const {
        const int row0 = u.pm * BM + wr * 64 + fr, col0 = u.pn * BM + wc * 32 + 8 * fq;
#pragma unroll
        for (int ai = 0; ai < 2; ++ai)
#pragma unroll
            for (int m = 0; m < 4; ++m) { const int row = row0 + ai * HALF + m * 16; const float r = rs[row]; float* rowp = O + (size_t)row * ldc + col0;
#pragma unroll
                for (int bj = 0; bj < 2; ++bj) { *(f32x4*)(rowp + bj * HALF) = acc[ai][bj][m][0] * r; *(f32x4*)(rowp + bj * HALF + 4) = acc[ai][bj][m][1] * r; } }
    }
};
struct EpiMemS {
    static constexpr bool PERM = true, AFTER_DRAIN = false, BOCT = false, AOCT = false;
    bf16_t* P; float* ps;
    __device__ __forceinline__ void operator()(const f32x4 (&acc)[2][2][4][2], const Unit& u, int wr, int wc, int fr, int fq) const {
        const int row0 = u.pm * BM + wr * 64 + fr, col0 = u.pn * BM + wc * 32 + 8 * fq; constexpr float C = 0.0625f * 1.4426950408889634f;
#pragma unroll
        for (int ai = 0; ai < 2; ++ai)
#pragma unroll
            for (int m = 0; m < 4; ++m) { const int row = row0 + ai * HALF + m * 16;
#pragma unroll
                for (int bj = 0; bj < 2; ++bj) { const f32x4 a0 = acc[ai][bj][m][0], a1 = acc[ai][bj][m][1];
                    u32x4 w; w.x = cvt_pk_bf16(__builtin_amdgcn_exp2f(a0[0] * C), __builtin_amdgcn_exp2f(a0[1] * C)); w.y = cvt_pk_bf16(__builtin_amdgcn_exp2f(a0[2] * C), __builtin_amdgcn_exp2f(a0[3] * C));
                    w.z = cvt_pk_bf16(__builtin_amdgcn_exp2f(a1[0] * C), __builtin_amdgcn_exp2f(a1[1] * C)); w.w = cvt_pk_bf16(__builtin_amdgcn_exp2f(a1[2] * C), __builtin_amdgcn_exp2f(a1[3] * C));
                    *(u32x4*)(P + (size_t)row * MEM_W + col0 + bj * HALF) = w;
                    float q = ((bf_lo(w.x) + bf_hi(w.x)) + (bf_lo(w.y) + bf_hi(w.y))) + ((bf_lo(w.z) + bf_hi(w.z)) + (bf_lo(w.w) + bf_hi(w.w)));
                    q += __shfl_xor(q, 16); q += __shfl_xor(q, 32);
                    if (fq == 0) ps[((size_t)row * 4 + u.pn) * 8 + bj * 4 + wc] = q; } }
    }
};
struct EpiMemO {
    static constexpr bool PERM = true, AFTER_DRAIN = false, BOCT = false, AOCT = false;
    bf16_t* O; const float* ps;
    __device__ __forceinline__ void operator()(const f32x4 (&acc)[2][2][4][2], const Unit& u, int wr, int wc, int fr, int fq) const {
        const int row0 = u.pm * BM + wr * 64 + fr, col0 = SELF_W + u.pn * BM + wc * 32 + 8 * fq;
#pragma unroll
        for (int ai = 0; ai < 2; ++ai)
#pragma unroll
            for (int m = 0; m < 4; ++m) { const int row = row0 + ai * HALF + m * 16;
                const f32x4* lp = (const f32x4*)(ps + ((size_t)row * 4 + u.pn) * 8); const f32x4 la = lp[0], lb = lp[1];
                const float rl = 1.0f / (((la[0] + la[1]) + (la[2] + la[3])) + ((lb[0] + lb[1]) + (lb[2] + lb[3])));
#pragma unroll
                for (int bj = 0; bj < 2; ++bj) { const f32x4 v0 = acc[ai][bj][m][0] * rl, v1 = acc[ai][bj][m][1] * rl;
                    u32x4 w; w.x = cvt_pk_bf16(v0[0], v0[1]); w.y = cvt_pk_bf16(v0[2], v0[3]); w.z = cvt_pk_bf16(v1[0], v1[1]); w.w = cvt_pk_bf16(v1[2], v1[3]);
                    *(u32x4*)(O + (size_t)row * OPW + col0 + bj * HALF) = w; } }
    }
};

template <class Epi, class Sched, bool ALIGN_EPI = true>
__device__ __forceinline__ void gemm_phase(PG8_LAS unsigned char* lds, const Gemm g, const Sched& S, const Epi& E, const int wave0) {
    int lane_; asm volatile("v_mbcnt_lo_u32_b32 %0, -1, 0\n\tv_mbcnt_hi_u32_b32 %0, -1, %0" : "=v"(lane_));
    int tid_ = wave0 * 64 + lane_;
    const int tid = tid_, wid = __builtin_amdgcn_readfirstlane(tid >> 6), lane = tid & 63, wr = wid >> 2, wc = wid & 3, fr = lane & 15, fq = lane >> 4;
    const int K = g.K, nt = K / BK;
    unsigned voffA[2], voffB[2];
#pragma unroll
    for (int i = 0; i < 2; ++i) { int R, C; stage_rc(tid * 16 + i * 8192, R, C); const int Rb = Epi::PERM ? ((R & ~31) + perm32(R & 31)) : R;
        if (Epi::AOCT) { const int b = tid * 16 + i * 8192, oc = b >> 11, Ro = (b & 2047) >> 4; voffA[i] = (unsigned)(Ro * 16 + oc * (g.M * 16)); }
        else voffA[i] = (unsigned)(R * g.lda + C) * 2u;
        if (Epi::BOCT) { const int b = tid * 16 + i * 8192, oc = b >> 11, Ro = (b & 2047) >> 4, Rp = Epi::PERM ? ((Ro & ~31) + perm32(Ro & 31)) : Ro; voffB[i] = (unsigned)(Rp * 16 + oc * (g.N * 16)); }
        else voffB[i] = (unsigned)(Rb * g.ldb + C) * 2u; }
    const size_t kstep = Epi::AOCT ? (size_t)(BK / 8) * g.M * 16 : (size_t)(BK * 2), kstepB = Epi::BOCT ? (size_t)(BK / 8) * g.N * 16 : (size_t)(BK * 2);
    const size_t hstepA = Epi::AOCT ? (size_t)HALF * 16 : (size_t)HALF * g.lda * 2, hstepB = Epi::BOCT ? (size_t)HALF * 16 : (size_t)HALF * g.ldb * 2;
    const size_t tstepA = 2 * hstepA, tstepB = 2 * hstepB, pnstepA = (size_t)g.a_pn_step * 2;
    const unsigned ldsw = (unsigned)wid * 1024u;
    const int aoff = Epi::AOCT ? fq * 2048 + (wr * 64 + fr) * 16 : lds_byte(wr * 64 + fr, fq * 8), boff = Epi::BOCT ? fq * 2048 + (wc * 32 + fr) * 16 : lds_byte(wc * 32 + fr, fq * 8);
#define PG8_SA(b, h) (((b) * 2 + (h)) * HTB)
#define PG8_SB(b, h) ((4 + (b) * 2 + (h)) * HTB)
#define PG8_STAGE(bufoff, gbase, voff) do { _Pragma("unroll") for (int _i = 0; _i < 2; ++_i) \
        __builtin_amdgcn_global_load_lds((const unsigned*)((const char*)(gbase) + (voff)[_i]), (PG8_LAS unsigned*)(lds + (bufoff) + ldsw + _i * 8192), 16, 0, 0); } while (0)
#define PG8_LDA(dst, b, h) do { _Pragma("unroll") for (int m = 0; m < 4; ++m) _Pragma("unroll") for (int k = 0; k < 2; ++k) dst[m][k] = *(const PG8_LAS bf16x8*)(lds + PG8_SA(b, h) + aoff + m * (Epi::AOCT ? 256 : 2048) + k * (Epi::AOCT ? 8192 : 1024)); } while (0)
#define PG8_LDB(dst, b, h) do { _Pragma("unroll") for (int n = 0; n < 2; ++n) _Pragma("unroll") for (int k = 0; k < 2; ++k) dst[n][k] = *(const PG8_LAS bf16x8*)(lds + PG8_SB(b, h) + boff + n * (Epi::BOCT ? 256 : 2048) + k * (Epi::BOCT ? 8192 : 1024)); } while (0)
#define PG8_MMA(ai, bj, At, Bt) do { __builtin_amdgcn_s_setprio(1); _Pragma("unroll") for (int m = 0; m < 4; ++m) _Pragma("unroll") for (int n = 0; n < 2; ++n) _Pragma("unroll") for (int k = 0; k < 2; ++k) \
        acc[ai][bj][m][n] = __builtin_amdgcn_mfma_f32_16x16x32_bf16(Bt[n][k], At[m][k], acc[ai][bj][m][n], 0, 0, 0); __builtin_amdgcn_s_setprio(0); } while (0)
#define PG8_WAIT_V(n) asm volatile("s_waitcnt vmcnt(" #n ")" ::: "memory")
#define PG8_WAIT_L(n) asm volatile("s_waitcnt lgkmcnt(" #n ")" ::: "memory")
#define PG8_BAR __builtin_amdgcn_s_barrier()
#define PG8_SCHED __builtin_amdgcn_sched_barrier(0)
    __builtin_amdgcn_s_waitcnt(0);
    Unit cur, nxt; int ui = 0;
    if (!S.next(0, cur)) return;
    f32x4 acc[2][2][4][2];
#pragma unroll
    for (int a = 0; a < 2; ++a)
#pragma unroll
        for (int b = 0; b < 2; ++b)
#pragma unroll
            for (int m = 0; m < 4; ++m)
#pragma unroll
                for (int n = 0; n < 2; ++n) acc[a][b][m][n] = (f32x4){0.f, 0.f, 0.f, 0.f};
    bf16x8 At[4][2], B0[2][2], B1[2][2];
    const char* cA = (const char*)g.A + (size_t)cur.pm * tstepA + (size_t)cur.pn * pnstepA; const char* cB = (const char*)g.Bt + (size_t)cur.pn * tstepB;
    S.a_ready(cur);
    PG8_STAGE(PG8_SB(0, 0), cB, voffB); PG8_STAGE(PG8_SB(0, 1), cB + hstepB, voffB); PG8_STAGE(PG8_SA(0, 0), cA, voffA); PG8_STAGE(PG8_SA(0, 1), cA + hstepA, voffA);
    if (wr == 1) PG8_BAR;
    PG8_WAIT_V(2); PG8_BAR;
    PG8_STAGE(PG8_SB(1, 0), cB + kstepB, voffB); PG8_STAGE(PG8_SA(1, 0), cA + kstep, voffA); PG8_STAGE(PG8_SB(1, 1), cB + hstepB + kstepB, voffB);
    PG8_WAIT_V(6); PG8_BAR;
    for (;;) {
        const bool has_next = S.next(ui + 1, nxt);
        const char* nA = has_next ? (const char*)g.A + (size_t)nxt.pm * tstepA + (size_t)nxt.pn * pnstepA : cA; const char* nB = has_next ? (const char*)g.Bt + (size_t)nxt.pn * tstepB : cB;
#pragma unroll 1
        for (int t = 0; t < nt; t += 2) {
            const bool last = (t == nt - 2);
            const char* a1 = cA + (size_t)(t + 1) * kstep;
            const char* a2 = last ? nA : cA + (size_t)(t + 2) * kstep; const char* b2 = last ? nB : cB + (size_t)(t + 2) * kstepB;
            const char* a3 = a2 + kstep; const char* b3 = b2 + kstepB;
            if (last && has_next) S.a_ready(nxt);
            PG8_LDB(B0, 0, 0); PG8_LDB(B1, 0, 1); PG8_SCHED; PG8_LDA(At, 0, 0); PG8_STAGE(PG8_SA(1, 1), a1 + hstepA, voffA);
            PG8_WAIT_V(8); PG8_WAIT_L(0); PG8_BAR; PG8_MMA(0, 0, At, B0); PG8_MMA(0, 1, At, B1); PG8_BAR; PG8_SCHED;
            PG8_LDA(At, 0, 1); PG8_STAGE(PG8_SB(0, 0), b2, voffB); PG8_STAGE(PG8_SB(0, 1), b2 + hstepB, voffB); PG8_STAGE(PG8_SA(0, 0), a2, voffA);
            PG8_WAIT_V(8); PG8_WAIT_L(0); PG8_BAR; PG8_MMA(1, 0, At, B0); PG8_MMA(1, 1, At, B1); PG8_BAR; PG8_SCHED;
            PG8_LDB(B0, 1, 0); PG8_LDB(B1, 1, 1); PG8_SCHED; PG8_LDA(At, 1, 0); PG8_STAGE(PG8_SA(0, 1), a2 + hstepA, voffA);
            PG8_WAIT_V(8); PG8_WAIT_L(0); PG8_BAR; PG8_MMA(0, 0, At, B0); PG8_MMA(0, 1, At, B1); PG8_BAR; PG8_SCHED;
            PG8_LDA(At, 1, 1); PG8_STAGE(PG8_SB(1, 0), b3, voffB); PG8_STAGE(PG8_SB(1, 1), b3 + hstepB, voffB); PG8_STAGE(PG8_SA(1, 0), a3, voffA);
            PG8_WAIT_V(8); PG8_WAIT_L(0); PG8_BAR; PG8_MMA(1, 0, At, B0); PG8_MMA(1, 1, At, B1); PG8_BAR; PG8_SCHED;
        }
        if constexpr (ALIGN_EPI) { if (wr == 0) PG8_BAR; }
        E(acc, cur, wr, wc, fr, fq); S.done(cur);
        if (!has_next) break;
#pragma unroll
        for (int a = 0; a < 2; ++a)
#pragma unroll
            for (int b = 0; b < 2; ++b)
#pragma unroll
                for (int m = 0; m < 4; ++m)
#pragma unroll
                    for (int n = 0; n < 2; ++n) acc[a][b][m][n] = (f32x4){0.f, 0.f, 0.f, 0.f};
        cur = nxt; cA = nA; cB = nB; ++ui;
        if constexpr (ALIGN_EPI) { if (wr == 1) PG8_BAR; }
    }
    PG8_WAIT_V(0); __builtin_amdgcn_s_waitcnt(0);
    if constexpr (!ALIGN_EPI) { if (wr == 0) PG8_BAR; }
    PG8_BAR;
#undef PG8_SA
#undef PG8_SB
#undef PG8_STAGE
#undef PG8_LDA
#undef PG8_LDB
#undef PG8_MMA
#undef PG8_WAIT_V
#undef PG8_WAIT_L
#undef PG8_BAR
#undef PG8_SCHED
}
}

namespace att {
constexpr float SCALE = 0.08838834764831845f;
constexpr int NW = 8, QBLK = 32, KVBLK = 64, QB = NW * QBLK, D = 128;
constexpr int SHM_V = KVBLK * D * 2, SHM_K = KVBLK * D * 2;
constexpr int ATT_LDS_BYTES = 2 * SHM_V + 2 * SHM_K + NW * 64 * 4 + NW * 32 * 4;
constexpr int STG_OFF = 77824;
constexpr float THR = 8.f;
#define KSWZ(row, colB) ((row) * 256 + ((colB) ^ (((row) & 7) << 4)))
#define SBAR() __builtin_amdgcn_sched_barrier(0)
__device__ __forceinline__ int v_st(int k, int c) { const int kk = (k & ~0xC) | ((k & 4) << 1) | ((k & 8) >> 1); return ((kk >> 3) * 4 + (c >> 5)) * 512 + ((kk & 7) * 32 + (c & 31)) * 2; }
__device__ __forceinline__ int v_rd_base(int lane) { return ((lane & 3) << 3) | (((lane >> 2) & 3) << 6) | (((lane >> 4) & 1) << 5) | (((lane >> 5) & 1) << 8); }
constexpr int v_rd_off(int d0, int ks, int half) { return d0 * 512 + ks * 4096 + half * 2048; }
__device__ __forceinline__ int crow(int r, int hi) { return (r & 3) + 8 * (r >> 2) + 4 * hi; }
__device__ __forceinline__ unsigned cvtpk(float lo, float hi) { unsigned r; asm volatile("v_cvt_pk_bf16_f32 %0, %1, %2" : "=v"(r) : "v"(lo), "v"(hi)); return r; }
__device__ __forceinline__ bf16x8 load8(const bf16* p) { return *reinterpret_cast<const bf16x8*>(p); }
__device__ __forceinline__ void mask_tile(f32x16& p0, f32x16& p1, int dq) {
    const float NEG = -__builtin_inff();
#pragma unroll
    for (int r = 0; r < 16; ++r) {
        const int c = (r & 3) + 8 * (r >> 2);
        if (dq - c < 0) p0[r] = NEG;
        if (dq - c - 32 < 0) p1[r] = NEG;
    }
}
__device__ __forceinline__ void mask_sel(f32x16& p0, f32x16& p1, unsigned keep) {
    const float NEG = -__builtin_inff();
#pragma unroll
    for (int r = 0; r < 16; ++r) { p0[r] = keep ? p0[r] : NEG; p1[r] = keep ? p1[r] : NEG; }
}
__device__ __forceinline__ void partialSM(f32x16& p0, f32x16& p1, float& m_reg, float& mn, float& alpha) {
    float pmax = p0[0]; for (int r = 1; r < 16; ++r) pmax = fmaxf(pmax, p0[r]); for (int r = 0; r < 16; ++r) pmax = fmaxf(pmax, p1[r]);
    { auto rr = __builtin_amdgcn_permlane32_swap(__float_as_uint(pmax), __float_as_uint(pmax), false, false);
      pmax = fmaxf(__uint_as_float(rr[0]), __uint_as_float(rr[1])); }
    constexpr float C2 = 1.4426950408889634f * SCALE;
    if (__builtin_expect(__all((pmax - m_reg) * SCALE <= THR), 1)) { mn = m_reg; alpha = 1.f; }
    else { mn = fmaxf(m_reg, pmax); alpha = __builtin_amdgcn_exp2f((m_reg - mn) * C2); m_reg = mn; }
    const float mnL = -mn * C2;
    for (int r = 0; r < 16; ++r) p0[r] = fmaf(p0[r], C2, mnL); for (int r = 0; r < 16; ++r) p1[r] = fmaf(p1[r], C2, mnL);
    for (int r = 0; r < 16; ++r) p0[r] = __builtin_amdgcn_exp2f(p0[r]);
}
__device__ __forceinline__ void finishSM(f32x16& p0, f32x16& p1, float alpha, float& l_reg, bf16x8& pa0, bf16x8& pa1, bf16x8& pa2, bf16x8& pa3) {
    for (int r = 0; r < 16; ++r) p1[r] = __builtin_amdgcn_exp2f(p1[r]);
    float ps = 0; for (int r = 0; r < 16; ++r) ps += p0[r]; for (int r = 0; r < 16; ++r) ps += p1[r];
    { auto rr = __builtin_amdgcn_permlane32_swap(__float_as_uint(ps), __float_as_uint(ps), false, false);
      ps = __uint_as_float(rr[0]) + __uint_as_float(rr[1]); }
    l_reg = l_reg * alpha + ps;
#define PK4(P, B_, OUT) do { unsigned a0 = cvtpk(P[B_+0], P[B_+1]), a1 = cvtpk(P[B_+2], P[B_+3]);                          \
        unsigned b0 = cvtpk(P[B_+4], P[B_+5]), b1 = cvtpk(P[B_+6], P[B_+7]);                                             \
        auto r0 = __builtin_amdgcn_permlane32_swap(a0, b0, false, false); auto r1 = __builtin_amdgcn_permlane32_swap(a1, b1, false, false); \
        v4u w = {r0[0], r1[0], r0[1], r1[1]}; OUT = *reinterpret_cast<bf16x8*>(&w); } while (0)
    PK4(p0, 0, pa0); PK4(p0, 8, pa1); PK4(p1, 0, pa2); PK4(p1, 8, pa3);
#undef PK4
}
template <int KB>
__device__ __forceinline__ void qkt(f32x16& p0, f32x16& p1, const char* K_lds, int r32, int hi, const bf16x8* qr) {
    p0 = f32x16{}; p1 = f32x16{};
    const char* kb[4];
#pragma unroll
    for (int dd = 0; dd < 4; ++dd) kb[dd] = K_lds + KB * SHM_K + KSWZ(r32, (dd * 16 + hi * 8) * 2);
#pragma unroll
    for (int d0 = 0; d0 < 8; ++d0) { const char* a = kb[d0 & 3] + (d0 >> 2) * 128;
        bf16x8 b0 = *reinterpret_cast<const bf16x8*>(a);
        bf16x8 b1 = *reinterpret_cast<const bf16x8*>(a + 32 * 256);
        p0 = __builtin_amdgcn_mfma_f32_32x32x16_bf16(b0, qr[d0], p0, 0, 0, 0);
        p1 = __builtin_amdgcn_mfma_f32_32x32x16_bf16(b1, qr[d0], p1, 0, 0, 0); }
}
template <int VB, int EXTRA = 0>
__device__ __forceinline__ void pv_tile(f32x16* o, int vb0, bf16x8 pa0, bf16x8 pa1, bf16x8 pa2, bf16x8 pa3) {
#define TRRD(dst, off) asm volatile("ds_read_b64_tr_b16 %0, %1 offset:%2" : "=&v"(dst) : "v"(vb0), "i"(off) : "memory")
#define PV_D0(d0) do { s16x4 l0, l1, l2, l3, h0, h1, h2, h3; constexpr int b_ = EXTRA + VB * SHM_V + v_rd_off(d0, 0, 0); \
        TRRD(l0, b_); TRRD(h0, b_ + 2048); TRRD(l1, b_ + 4096); TRRD(h1, b_ + 6144); TRRD(l2, b_ + 8192); TRRD(h2, b_ + 10240); TRRD(l3, b_ + 12288); TRRD(h3, b_ + 14336); \
        asm volatile("s_waitcnt lgkmcnt(0)" ::: "memory"); SBAR();   \
        o[d0] = __builtin_amdgcn_mfma_f32_32x32x16_bf16(pa0, (bf16x8){l0[0], l0[1], l0[2], l0[3], h0[0], h0[1], h0[2], h0[3]}, o[d0], 0, 0, 0);   \
        o[d0] = __builtin_amdgcn_mfma_f32_32x32x16_bf16(pa1, (bf16x8){l1[0], l1[1], l1[2], l1[3], h1[0], h1[1], h1[2], h1[3]}, o[d0], 0, 0, 0);   \
        o[d0] = __builtin_amdgcn_mfma_f32_32x32x16_bf16(pa2, (bf16x8){l2[0], l2[1], l2[2], l2[3], h2[0], h2[1], h2[2], h2[3]}, o[d0], 0, 0, 0);   \
        o[d0] = __builtin_amdgcn_mfma_f32_32x32x16_bf16(pa3, (bf16x8){l3[0], l3[1], l3[2], l3[3], h3[0], h3[1], h3[2], h3[3]}, o[d0], 0, 0, 0); } while (0)
    PV_D0(0); PV_D0(1); PV_D0(2); PV_D0(3);
#undef PV_D0
#undef TRRD
}

__device__ __forceinline__ unsigned dpp_x1(unsigned v) { return (unsigned)__builtin_amdgcn_update_dpp(0, (int)v, 0xB1, 0xF, 0xF, true); }
__device__ __forceinline__ unsigned dpp_x2(unsigned v) { return (unsigned)__builtin_amdgcn_update_dpp(0, (int)v, 0x4E, 0xF, 0xF, true); }
__device__ __forceinline__ unsigned dpp_x4(unsigned v) { const int t = __builtin_amdgcn_update_dpp(0, (int)v, 0x141, 0xF, 0xF, true);
    return (unsigned)__builtin_amdgcn_update_dpp(0, t, 0x1B, 0xF, 0xF, true); }
__device__ __forceinline__ v2u quad_rows(const f32x16* o, int g, int d0, const float* rl, bool odd, bool t1) {
    const float a0 = o[d0][4 * g + 0] * rl[0], a1 = o[d0][4 * g + 1] * rl[1], a2 = o[d0][4 * g + 2] * rl[2], a3 = o[d0][4 * g + 3] * rl[3];
    const float rA0 = __uint_as_float(dpp_x1(__float_as_uint(odd ? a0 : a1))), rA1 = __uint_as_float(dpp_x1(__float_as_uint(odd ? a2 : a3)));
    const unsigned u0 = odd ? cvtpk(rA0, a1) : cvtpk(a0, rA0);
    const unsigned u1 = odd ? cvtpk(rA1, a3) : cvtpk(a2, rA1);
    const unsigned rB = dpp_x2(t1 ? u0 : u1);
    v2u w; w.x = t1 ? rB : u0; w.y = t1 ? u1 : rB; return w;
}
template <class RowFn>
__device__ __forceinline__ void store_tile_rows(const f32x16* o, const float* li_l, char* stg, int r32, int hi, int lane, const RowFn& rowptr) {
#pragma unroll
    for (int h = 0; h < 2; ++h) {
        { const int q = r32 & 3; const bool odd = (q & 1) != 0, t1 = (q & 2) != 0;
#pragma unroll
          for (int g2 = 0; g2 < 2; ++g2) { float rl[4];
#pragma unroll
              for (int j = 0; j < 4; ++j) rl[j] = __builtin_amdgcn_rcpf(li_l[crow(8 * h + 4 * g2 + j, hi)]);
              const int lr = q + 8 * g2 + 4 * hi;
#pragma unroll
              for (int d0 = 0; d0 < 4; ++d0) { const v2u w = quad_rows(o, 2 * h + g2, d0, rl, odd, t1); *(v2u*)(stg + lr * 256 + d0 * 64 + (r32 & ~3) * 2) = w; } } }
        asm volatile("s_waitcnt lgkmcnt(0)" ::: "memory");
#pragma unroll
        for (int i = 0; i < 4; ++i) { const int lr = 4 * i + (lane >> 4); const v4u x = *(const v4u*)(stg + lr * 256 + (lane & 15) * 16); char* dst = rowptr(16 * h + lr);
            if (dst) *(v4u*)(dst + (lane & 15) * 16) = x; }
        asm volatile("s_waitcnt lgkmcnt(0)" ::: "memory");
    }
}
struct BlockRef { const bf16* K; const bf16* V; char* O; float* ML; unsigned qoff; unsigned pinfo; int P0; int NT; int flags; };
struct Seam { bf16x8 qr[8]; bf16x8 st_v0, st_v1, st_k0, st_k1; };
#define KVP(p, k0, half) ((const char*)(p) + (size_t)((k0) + 32 * (half)) * (ldkv * 2))
__device__ __forceinline__ bf16x8 ld16(const char* base, unsigned off) { return *reinterpret_cast<const bf16x8*>(base + off); }
#define VMW() asm volatile("s_waitcnt vmcnt(0)" ::: "memory")
#define VMWN(n) asm volatile("s_waitcnt vmcnt(%0)" :: "i"(n) : "memory")
#define SLOAD_H(Kp, Vp, k0) do { S.st_v0 = ld16(KVP(Vp, k0, 0), kvoff); S.st_v1 = ld16(KVP(Vp, k0, 1), kvoff);              \
                         S.st_k0 = ld16(KVP(Kp, k0, 0), kvoff); S.st_k1 = ld16(KVP(Kp, k0, 1), kvoff); } while (0)
#define SWRITE_HK(bf) do { *(bf16x8*)(K_lds + (bf) * SHM_K + kws) = S.st_k0; *(bf16x8*)(K_lds + (bf) * SHM_K + kws + 32 * 256) = S.st_k1; } while (0)
#define SWRITE_HV(bf) do { *(bf16x8*)(V_lds + (bf) * SHM_V + vst0) = S.st_v0; *(bf16x8*)(V_lds + (bf) * SHM_V + vst1) = S.st_v1; } while (0)
#define SWRITE_H(bf) do { SWRITE_HV(bf); SWRITE_HK(bf); } while (0)
constexpr int ldq = PW, ldkv = PW, ldo = OPW;
__device__ __forceinline__ void attn_prime(const BlockRef& cur, const char* qbase, char* lds, Seam& S, const int tid) {
    const int sr = tid >> 4, sc = (tid & 15) * 8, kws = KSWZ(sr, sc * 2); char* K_lds = lds + 2 * SHM_V;
    const unsigned kvoff = (unsigned)(sr * ldkv + sc) * 2u;
    for (int d0 = 0; d0 < 8; ++d0) S.qr[d0] = ld16(qbase + d0 * 32, cur.qoff);
    SLOAD_H(cur.K, cur.V, 0); VMW(); SWRITE_HK(0);
    __syncthreads();
}
__device__ __forceinline__ void attn_block(const BlockRef& cur, const BlockRef& nxt, const char* qbase, char* lds, Seam& S, const int tid) {
    const int wid = __builtin_amdgcn_readfirstlane(tid >> 6), lane = tid & 63, r32 = lane & 31, hi = lane >> 5;
    const int NT = cur.NT;
    const int qlo = cur.P0 + wid * QBLK, qm = qlo + r32 - 4 * hi;
    const bool nomask = (cur.flags & 1) != 0;
    char* V_lds = lds; char* K_lds = lds + 2 * SHM_V;
    float* ws = (float*)(lds + 2 * SHM_V + 2 * SHM_K) + wid * 64; float* li_l = ws, * al_l = ws + 32;
    unsigned* rt = (unsigned*)(lds + 2 * SHM_V + 2 * SHM_K + NW * 64 * 4) + wid * 32;
    float m_reg = -1e30f, l_reg = 0; f32x16 o[4] = {};
    const int sr = tid >> 4, sc = (tid & 15) * 8, vst0 = v_st(sr, sc), vst1 = v_st(32 + sr, sc), kws = KSWZ(sr, sc * 2);
    const unsigned kvoff = (unsigned)(sr * ldkv + sc) * 2u;
    const int vb0 = (int)(uintptr_t)V_lds + v_rd_base(lane);
    const bf16* Kh = cur.K; const bf16* Vh = cur.V;
#define RESC(a) do { if (__any((a) < 1.f)) { if (hi == 0) al_l[r32] = (a); asm volatile("s_waitcnt lgkmcnt(0)" ::: "memory");              \
                     for (int d_ = 0; d_ < 4; ++d_) for (int r = 0; r < 16; ++r) o[d_][r] *= al_l[crow(r, hi)]; } } while (0)
#define KBASE(t) ((t) * KVBLK)
#define MASKT(P0_, P1_, t) do { const int kb_ = KBASE(t); if (!nomask && kb_ + KVBLK - 1 > qlo) mask_tile(P0_, P1_, qm - kb_); } while (0)
    constexpr int NQL = 8;
#define SEAM_K0() do { VMWN(NQL); SWRITE_HK(0); SBAR(); } while (0)
    f32x16 pA0, pA1, pB0, pB1; float mnA, mnB, alA, alB; bf16x8 pa0, pa1, pa2, pa3;
    SWRITE_HV(0); SBAR();
    if (NT > 1) { SLOAD_H(Kh, Vh, KBASE(1)); }
    SBAR(); qkt<0>(pA0, pA1, K_lds, r32, hi, S.qr);
    MASKT(pA0, pA1, 0); partialSM(pA0, pA1, m_reg, mnA, alA);
    if (NT > 1) { VMW(); SWRITE_H(1); }
    __syncthreads();
#define HALF_STEP(PX0, PX1, mnX, alX, PY0, PY1, alY, t, KB, VB, SB) do {                                                      \
        SBAR(); qkt<KB>(PX0, PX1, K_lds, r32, hi, S.qr);                                                         \
        finishSM(PY0, PY1, alY, l_reg, pa0, pa1, pa2, pa3); SBAR();                                                           \
        if ((t) + 1 < NT) { SLOAD_H(Kh, Vh, KBASE((t) + 1)); SBAR(); }                                               \
        pv_tile<VB>(o, vb0, pa0, pa1, pa2, pa3); MASKT(PX0, PX1, (t)); partialSM(PX0, PX1, m_reg, mnX, alX);                                        \
        __syncthreads();                                                                                                      \
        if ((t) + 1 < NT) { VMW(); SWRITE_H(SB); }                                                                          \
        RESC(alX); __syncthreads(); } while (0)
    for (int t = 1; t + 1 < NT; t += 2) {
        HALF_STEP(pB0, pB1, mnB, alB, pA0, pA1, alA, t, 1, 0, 0);
        HALF_STEP(pA0, pA1, mnA, alA, pB0, pB1, alB, t + 1, 0, 1, 1);
    }
    const bool even = (NT & 1) == 0;
    if (even) { SBAR(); qkt<1>(pB0, pB1, K_lds, r32, hi, S.qr); SBAR(); }
    { const bf16* Kn = nxt.K; const bf16* Vn = nxt.V; SLOAD_H(Kn, Vn, 0); SBAR(); }
#pragma unroll
    for (int d0 = 0; d0 < 8; ++d0) S.qr[d0] = ld16(qbase + d0 * 32, nxt.qoff);
    SBAR();
    finishSM(pA0, pA1, alA, l_reg, pa0, pa1, pa2, pa3); SBAR();
    pv_tile<0>(o, vb0, pa0, pa1, pa2, pa3);
    if (even) { MASKT(pB0, pB1, NT - 1); partialSM(pB0, pB1, m_reg, mnB, alB); __syncthreads(); RESC(alB);
        finishSM(pB0, pB1, alB, l_reg, pa0, pa1, pa2, pa3); SBAR(); pv_tile<1>(o, vb0, pa0, pa1, pa2, pa3); }
    SBAR(); SEAM_K0();
    if (hi == 0) { li_l[r32] = l_reg; rt[r32] = cur.pinfo; } asm volatile("s_waitcnt lgkmcnt(0)" ::: "memory");
    char* Ob = cur.O; char* stg = lds + STG_OFF + wid * 4096;
    if (hi == 0 && (int)cur.pinfo >= 0) { f32x2 ml = {m_reg, l_reg}; *(f32x2*)(cur.ML + (size_t)cur.pinfo * 2) = ml; }
    store_tile_rows(o, li_l, stg, r32, hi, lane, [&](int row) -> char* { const unsigned info = rt[row]; return (int)info >= 0 ? Ob + (size_t)(info & 0x7fffffffu) * 256u : nullptr; });
    __syncthreads();
#undef RESC
#undef KBASE
#undef MASKT
#undef SEAM_K0
#undef HALF_STEP
}
#undef KVP
#undef VMW
#undef VMWN
#undef SLOAD_H
#undef SWRITE_HK
#undef SWRITE_HV
#undef SWRITE_H
}

namespace att2 {
using att::dpp_x1; using att::dpp_x2; using att::dpp_x4; using att::quad_rows; using att::SHM_K; using att::SHM_V; using att::QBLK; using att::KVBLK; using att::crow; using att::cvtpk; using att::ld16; using att::v_st; using att::v_rd_base;
constexpr int OFF_V0 = 0, OFF_V1 = 2 * SHM_V, OFF_K = OFF_V1 + 2 * SHM_V, OFF_P = OFF_K + 2 * SHM_K, OFF_WS = OFF_P + 2 * 16384, ATT2_LDS_BYTES = OFF_WS + 4 * 128 * 4;
static_assert(ATT2_LDS_BYTES <= MISC_OFF, "diff-attention LDS map");
constexpr int ldkv = PW, ldo = OPW;
struct Ref { const bf16* K; const bf16* V; char* O; unsigned qoff; int P0; int NT; int desc; };
#define BARL() do { asm volatile("s_waitcnt lgkmcnt(0)" ::: "memory"); __builtin_amdgcn_s_barrier(); asm volatile("" ::: "memory"); } while (0)
#define VMW2() asm volatile("s_waitcnt vmcnt(0)" ::: "memory")
__device__ __forceinline__ void store_o(const f32x16* o, char* Ob, const float* li_l, int s, int r32, int hi, unsigned colb) {
    const int q = r32 & 3; const bool odd = (q & 1) != 0, t1 = (q & 2) != 0, b4 = (r32 & 4) != 0;
    unsigned ooff = (unsigned)((s * QBLK + 8 * (b4 ? 1 : 0) + 4 * hi + q) * ldo + (r32 & ~7)) * 2u + colb; asm volatile("" : "+v"(ooff));
#pragma unroll
    for (int G = 0; G < 2; ++G) {
        float rl0[4], rl1[4];
#pragma unroll
        for (int j = 0; j < 4; ++j) { rl0[j] = __builtin_amdgcn_rcpf(li_l[crow(8 * G + j, hi)]); rl1[j] = __builtin_amdgcn_rcpf(li_l[crow(8 * G + 4 + j, hi)]); }
#pragma unroll
        for (int d0 = 0; d0 < 4; ++d0) {
            const v2u w0 = quad_rows(o, 2 * G, d0, rl0, odd, t1), w1 = quad_rows(o, 2 * G + 1, d0, rl1, odd, t1);
            const unsigned rx = dpp_x4(b4 ? w0.x : w1.x), ry = dpp_x4(b4 ? w0.y : w1.y);
            v4u w; w.x = b4 ? rx : w0.x; w.y = b4 ? ry : w0.y; w.z = b4 ? w1.x : rx; w.w = b4 ? w1.y : ry;
            *(v4u*)(Ob + (ooff + (unsigned)(G * 16 * ldo * 2 + d0 * 64))) = w; } }
}
template <int CB>
__device__ __forceinline__ void pv256(f32x16* o, int vb0, bf16x8 pa0, bf16x8 pa1, bf16x8 pa2, bf16x8 pa3) {
    s16x4 Al0, Ah0, Al1, Ah1, Al2, Ah2, Al3, Ah3, Bl0, Bh0, Bl1, Bh1, Bl2, Bh2, Bl3, Bh3;
#define TR(dst, off) asm volatile("ds_read_b64_tr_b16 %0, %1 offset:%2" : "=&v"(dst) : "v"(vb0), "i"(off) : "memory")
#define RD(S, g) do { constexpr int b_ = ((g) >> 2) * OFF_V1 + CB * SHM_V + att::v_rd_off((g) & 3, 0, 0); \
        TR(S##l0, b_); TR(S##h0, b_ + 2048); TR(S##l1, b_ + 4096); TR(S##h1, b_ + 6144); TR(S##l2, b_ + 8192); TR(S##h2, b_ + 10240); TR(S##l3, b_ + 12288); TR(S##h3, b_ + 14336); } while (0)
#define MM(S, g) do { \
        o[g] = __builtin_amdgcn_mfma_f32_32x32x16_bf16(pa0, (bf16x8){S##l0[0], S##l0[1], S##l0[2], S##l0[3], S##h0[0], S##h0[1], S##h0[2], S##h0[3]}, o[g], 0, 0, 0); \
        o[g] = __builtin_amdgcn_mfma_f32_32x32x16_bf16(pa1, (bf16x8){S##l1[0], S##l1[1], S##l1[2], S##l1[3], S##h1[0], S##h1[1], S##h1[2], S##h1[3]}, o[g], 0, 0, 0); \
        o[g] = __builtin_amdgcn_mfma_f32_32x32x16_bf16(pa2, (bf16x8){S##l2[0], S##l2[1], S##l2[2], S##l2[3], S##h2[0], S##h2[1], S##h2[2], S##h2[3]}, o[g], 0, 0, 0); \
        o[g] = __builtin_amdgcn_mfma_f32_32x32x16_bf16(pa3, (bf16x8){S##l3[0], S##l3[1], S##l3[2], S##l3[3], S##h3[0], S##h3[1], S##h3[2], S##h3[3]}, o[g], 0, 0, 0); } while (0)
#define W8() do { asm volatile("s_waitcnt lgkmcnt(8)" ::: "memory"); SBAR(); } while (0)
#define W0() do { asm volatile("s_waitcnt lgkmcnt(0)" ::: "memory"); SBAR(); } while (0)
    asm volatile("s_waitcnt lgkmcnt(0)" ::: "memory");
    RD(A, 0); RD(B, 1); W8(); MM(A, 0); SBAR();
    RD(A, 2); W8(); MM(B, 1); SBAR();
    RD(B, 3); W8(); MM(A, 2); SBAR();
    RD(A, 4); W8(); MM(B, 3); SBAR();
    RD(B, 5); W8(); MM(A, 4); SBAR();
    RD(A, 6); W8(); MM(B, 5); SBAR();
    RD(B, 7); W8(); MM(A, 6); SBAR();
    W0(); MM(B, 7);
#undef TR
#undef RD
#undef MM
#undef W8
#undef W0
}
template <int KB>
__device__ __forceinline__ void qkt_pref(f32x16& p0, f32x16& p1, const char* K_lds, int r32, int hi, const bf16x8* qr, float nm) {
#pragma unroll
    for (int r = 0; r < 16; ++r) { p0[r] = nm; p1[r] = nm; }
    const char* kb[4];
#pragma unroll
    for (int dd = 0; dd < 4; ++dd) kb[dd] = K_lds + KB * SHM_K + KSWZ(r32, (dd * 16 + hi * 8) * 2);
    bf16x8 f0[8], f1[8];
#define QL(d0) do { const char* a_ = kb[(d0) & 3] + ((d0) >> 2) * 128; f0[d0] = *reinterpret_cast<const bf16x8*>(a_); f1[d0] = *reinterpret_cast<const bf16x8*>(a_ + 32 * 256); } while (0)
#define QM(d0) do { p0 = __builtin_amdgcn_mfma_f32_32x32x16_bf16(f0[d0], qr[d0], p0, 0, 0, 0); p1 = __builtin_amdgcn_mfma_f32_32x32x16_bf16(f1[d0], qr[d0], p1, 0, 0, 0); } while (0)
    QL(0); QL(1); QL(2); QL(3); SBAR();
    QM(0); QM(1); QL(4); QL(5); SBAR();
    QM(2); QM(3); QL(6); QL(7); SBAR();
    QM(4); QM(5); SBAR(); QM(6); QM(7);
#undef QL
#undef QM
}
__device__ __forceinline__ void partialSM2(f32x16& p0, f32x16& p1, float& m_reg, float& alpha) {
    float pmax = p0[0];
#pragma unroll
    for (int r = 1; r < 16; ++r) pmax = fmaxf(pmax, p0[r]);
#pragma unroll
    for (int r = 0; r < 16; ++r) pmax = fmaxf(pmax, p1[r]);
    { auto rr = __builtin_amdgcn_permlane32_swap(__float_as_uint(pmax), __float_as_uint(pmax), false, false);
      pmax = fmaxf(__uint_as_float(rr[0]), __uint_as_float(rr[1])); }
    constexpr float THR2 = att::THR * 1.4426950408889634f;
    if (__builtin_expect(__all(pmax <= THR2), 1)) { alpha = 1.f; }
    else { const float d = fmaxf(pmax, 0.f); alpha = __builtin_amdgcn_exp2f(-d); m_reg += d;
#pragma unroll
        for (int r = 0; r < 16; ++r) { p0[r] -= d; p1[r] -= d; } }
#pragma unroll
    for (int r = 0; r < 16; ++r) p0[r] = __builtin_amdgcn_exp2f(p0[r]);
}
struct Cursor { int b, t, NT, desc; const bf16* K; const bf16* V; char* O; };
#define TIDX(c) ((c).desc ? (c).NT - 1 - (c).t : (c).t)
#define ADVANCE(c) do { if (++(c).t == (c).NT) { (c).t = 0; if (++(c).b < nblk) { const Ref r_ = ref((c).b); (c).NT = r_.NT; (c).desc = r_.desc; (c).K = r_.K; (c).V = r_.V; (c).O = r_.O; } } } while (0)
template <class RefFn>
__device__ __forceinline__ void score_stream(const RefFn& ref, int nblk, int G, const char* qbase, char* lds, const int tid) {
    const int wid = __builtin_amdgcn_readfirstlane(tid >> 6), lane = tid & 63, r32 = lane & 31, hi = lane >> 5, s = wid & 3;
    const char* K_lds = lds + OFF_K; char* Pb = lds + OFF_P + s * 4096 + lane * 16;
    float* ws = (float*)(lds + OFF_WS) + s * 128;
    const int t2 = tid & 255, sr = t2 >> 4, sc = (t2 & 15) * 8, kws = KSWZ(sr, sc * 2);
    const unsigned kvoff = (unsigned)(sr * ldkv + sc) * 2u;
    bf16x8 qr[8], sk0[4], sk1[4], sw0[4], sw1[4];
    const int vst = v_st(sr, sc);
#define LOADK(dst, Kp, k0) do { _Pragma("unroll") for (int i_ = 0; i_ < 4; ++i_) dst[i_] = ld16((const char*)(Kp) + (size_t)((k0) + 16 * i_) * (ldkv * 2), kvoff); } while (0)
#define WRITEK(bf, src) do { _Pragma("unroll") for (int i_ = 0; i_ < 4; ++i_) *(bf16x8*)(lds + OFF_K + (bf) * SHM_K + kws + i_ * 4096) = src[i_]; } while (0)
#define LOADW(dst, Vp, k0) do { _Pragma("unroll") for (int i_ = 0; i_ < 4; ++i_) dst[i_] = ld16((const char*)(Vp) + (size_t)((k0) + 16 * i_) * (ldkv * 2) + 256, kvoff); } while (0)
#define WRITEW(bf, src) do { _Pragma("unroll") for (int i_ = 0; i_ < 4; ++i_) *(bf16x8*)(lds + OFF_V1 + (bf) * SHM_V + vst + i_ * 4096) = src[i_]; } while (0)
    Ref cur = ref(0);
    Cursor lk; lk.b = 0; lk.t = 0; lk.NT = cur.NT; lk.desc = cur.desc; lk.K = cur.K; lk.V = cur.V; lk.O = cur.O;
    Cursor lw = lk;
    LOADW(sw0, lw.V, TIDX(lw) * KVBLK); ADVANCE(lw);
    bool hw0 = true, hw1 = false; int gw = 1;
    __builtin_amdgcn_s_setprio(2);
    for (int d0 = 0; d0 < 8; ++d0) qr[d0] = ld16(qbase + d0 * 32, cur.qoff);
    LOADK(sk0, lk.K, TIDX(lk) * KVBLK); ADVANCE(lk); LOADK(sk1, lk.K, TIDX(lk) * KVBLK); ADVANCE(lk);
    WRITEK(0, sk0); WRITEK(1, sk1);
    bool have0 = 2 < G, have1 = false; int gl = 3;
    if (have0) { LOADK(sk0, lk.K, TIDX(lk) * KVBLK); ADVANCE(lk); }
    BARL();
    float m_reg = 0.f, l_reg = 0.f;
    f32x16 pA0, pA1, pB0, pB1; float alA = 1.f, alB = 1.f; bf16x8 pa0, pa1, pa2, pa3;
#define PUBLISH(slot, al) do { *(bf16x8*)(Pb + (slot) * 16384) = pa0; *(bf16x8*)(Pb + (slot) * 16384 + 1024) = pa1; *(bf16x8*)(Pb + (slot) * 16384 + 2048) = pa2; \
        *(bf16x8*)(Pb + (slot) * 16384 + 3072) = pa3; if (hi == 0) ws[64 + (slot) * 32 + r32] = (al); } while (0)
    for (int b = 0; b < nblk; ++b) {
        const Ref nxt = ref(b + 1 < nblk ? b + 1 : b);
        const int NT = cur.NT, qlo = cur.P0 + s * QBLK, qm = qlo + r32 - 4 * hi;
#define MASKT(P0_, P1_, t) do { const int kb_ = (t) * KVBLK; if (kb_ + KVBLK - 1 > qlo) att::mask_tile(P0_, P1_, qm - kb_); } while (0)
        for (int t = 0; t < NT; t += 2) {
            if (have1) WRITEK(1, sk1);
            have1 = gl < G; if (have1) { LOADK(sk1, lk.K, TIDX(lk) * KVBLK); ADVANCE(lk); } ++gl;
            if (hw1) WRITEW(1, sw1);
            hw1 = gw < G; if (hw1) { LOADW(sw1, lw.V, TIDX(lw) * KVBLK); ADVANCE(lw); } ++gw;
            SBAR(); qkt_pref<0>(pA0, pA1, K_lds, r32, hi, qr, (t == 0) ? 0.f : -m_reg);
            if (t > 0 || b > 0) { att::finishSM(pB0, pB1, alB, l_reg, pa0, pa1, pa2, pa3); SBAR(); PUBLISH(1, alB); }
            if (t == 0) { if (b > 0 && hi == 0) ws[((b - 1) & 1) * 32 + r32] = l_reg; m_reg = 0.f; l_reg = 0.f; }
            MASKT(pA0, pA1, (cur.desc ? NT - 1 - t : t)); partialSM2(pA0, pA1, m_reg, alA);
            BARL();
            if (have0) WRITEK(0, sk0);
            have0 = gl < G; if (have0) { LOADK(sk0, lk.K, TIDX(lk) * KVBLK); ADVANCE(lk); } ++gl;
            if (hw0) WRITEW(0, sw0);
            hw0 = gw < G; if (hw0) { LOADW(sw0, lw.V, TIDX(lw) * KVBLK); ADVANCE(lw); } ++gw;
            SBAR(); qkt_pref<1>(pB0, pB1, K_lds, r32, hi, qr, -m_reg);
            att::finishSM(pA0, pA1, alA, l_reg, pa0, pa1, pa2, pa3); SBAR(); PUBLISH(0, alA);
            if (t + 2 == NT) {
#pragma unroll
                for (int d0 = 0; d0 < 8; ++d0) qr[d0] = ld16(qbase + d0 * 32, nxt.qoff); }
            MASKT(pB0, pB1, (cur.desc ? NT - 2 - t : t + 1)); partialSM2(pB0, pB1, m_reg, alB);
            BARL();
        }
#undef MASKT
        cur = nxt;
    }
    att::finishSM(pB0, pB1, alB, l_reg, pa0, pa1, pa2, pa3); SBAR(); PUBLISH(1, alB);
    if (hi == 0) ws[((nblk - 1) & 1) * 32 + r32] = l_reg;
    if (hw1) WRITEW(1, sw1);
    BARL();
    BARL();
    __builtin_amdgcn_s_setprio(0);
#undef PUBLISH
#undef LOADK
#undef WRITEK
#undef LOADW
#undef WRITEW
}
template <class RefFn>
__device__ __forceinline__ void helper_stream(const RefFn& ref, int nblk, int G, char* lds, const int tid) {
    const int wid = __builtin_amdgcn_readfirstlane(tid >> 6), lane = tid & 63, r32 = lane & 31, hi = lane >> 5, s = wid & 3;
    char* Pb = lds + OFF_P + s * 4096 + lane * 16;
    float* ws = (float*)(lds + OFF_WS) + s * 128;
    const int vb0 = (int)(uintptr_t)(lds + OFF_V0) + v_rd_base(lane);
    const int t2 = tid & 255, sr = t2 >> 4, sc = (t2 & 15) * 8, vst = v_st(sr, sc);
    const unsigned kvoff = (unsigned)(sr * ldkv + sc) * 2u;
    bf16x8 sv0[4], sv1[4], pa0, pa1, pa2, pa3; f32x16 o[8];
#define LOADV(dst, Vp, k0) do { _Pragma("unroll") for (int i_ = 0; i_ < 4; ++i_) dst[i_] = ld16((const char*)(Vp) + (size_t)((k0) + 16 * i_) * (ldkv * 2), kvoff); } while (0)
#define WRITEV(bf, src) do { _Pragma("unroll") for (int i_ = 0; i_ < 4; ++i_) *(bf16x8*)(lds + OFF_V0 + (bf) * SHM_V + vst + i_ * 4096) = src[i_]; } while (0)
    Cursor lv, cc; { const Ref r0 = ref(0); lv.b = 0; lv.t = 0; lv.NT = r0.NT; lv.desc = r0.desc; lv.K = r0.K; lv.V = r0.V; lv.O = r0.O; cc = lv; }
    LOADV(sv0, lv.V, TIDX(lv) * KVBLK); ADVANCE(lv);
    bool have0 = true, have1 = false; int gl = 1;
    BARL();
    char* prevO = nullptr; int prevb = 0;
#define INTERVAL(i, CB, SWSET, SWBUF, HAVE) do {                                                                                        \
        if (HAVE) WRITEV(SWBUF, SWSET);                                                                                                 \
        HAVE = gl < G; if (HAVE) { LOADV(SWSET, lv.V, TIDX(lv) * KVBLK); ADVANCE(lv); } ++gl;                                               \
        if ((i) >= 2 && (i) - 2 < G) {                                                                                                  \
            if (cc.t == 0) { if (prevO) { store_o(o, prevO, ws + (prevb & 1) * 32, s, r32, hi, 0u); store_o(o + 4, prevO, ws + (prevb & 1) * 32, s, r32, hi, 256u); } \
                _Pragma("unroll") for (int d_ = 0; d_ < 8; ++d_) o[d_] = f32x16{}; prevO = cc.O; prevb = cc.b; }                         \
            pa0 = *(const bf16x8*)(Pb + (CB) * 16384); pa1 = *(const bf16x8*)(Pb + (CB) * 16384 + 1024); pa2 = *(const bf16x8*)(Pb + (CB) * 16384 + 2048); pa3 = *(const bf16x8*)(Pb + (CB) * 16384 + 3072); \
            { const float* al_ = ws + 64 + (CB) * 32; const float a_ = al_[r32];                                                        \
              if (__any(a_ < 1.f)) { for (int d_ = 0; d_ < 8; ++d_) for (int r = 0; r < 16; ++r) o[d_][r] *= al_[crow(r, hi)]; } }       \
            pv256<CB>(o, vb0, pa0, pa1, pa2, pa3);                      \
            ADVANCE(cc); }                                                                                                              \
        BARL(); } while (0)
    for (int i = 0; i < G + 2; i += 2) { INTERVAL(i, 0, sv1, 1, have1); INTERVAL(i + 1, 1, sv0, 0, have0); }
    store_o(o, prevO, ws + (prevb & 1) * 32, s, r32, hi, 0u); store_o(o + 4, prevO, ws + (prevb & 1) * 32, s, r32, hi, 256u);
#undef INTERVAL
#undef LOADV
#undef WRITEV
}
#undef ADVANCE
#undef TIDX
}

#define XB_TMO      128
#define XB_XCNT(j)  (256  + 64 * (j))
#define XB_XSUB(j)  (1280 + 64 * (j))
#define XB_XGEN(j)  (2304 + 64 * (j))
#define XB_TOP      3328
#define XB_TOPGEN   3392
#define XCD_BAR_WORDS 3456
#define XB_SPIN_CAP (1u << 18)
__device__ __forceinline__ unsigned xb_ld(unsigned* p)              { return __hip_atomic_load(p, __ATOMIC_RELAXED, __HIP_MEMORY_SCOPE_AGENT); }
__device__ __forceinline__ unsigned xb_add(unsigned* p, unsigned v) { return __hip_atomic_fetch_add(p, v, __ATOMIC_RELAXED, __HIP_MEMORY_SCOPE_AGENT); }
__device__ __forceinline__ unsigned xb_xcc_id() { return (unsigned)__builtin_amdgcn_s_getreg((3 << 11) | 20) & 0xFu; }
#define XB_SPIN(cond, bar) do { unsigned _sp = 0; while (cond) { __builtin_amdgcn_s_sleep(1); \
    if ((++_sp & 255u) == 0u) { if (xb_ld(&(bar)[XB_TMO])) break; if (_sp > XB_SPIN_CAP) { atomicAdd(&(bar)[XB_TMO], 1u); break; } } } } while (0)
struct XcdBarrier { unsigned* bar; unsigned x; volatile LAS unsigned* st; };
__device__ __forceinline__ XcdBarrier xcd_barrier_post(unsigned* bar, volatile LAS unsigned* st) {
    XcdBarrier b; b.bar = bar; b.x = xb_xcc_id(); b.st = st;
    if (threadIdx.x == 0) (void)xb_add(&bar[XB_XCNT(b.x)], 1u);
    return b;
}
__device__ __forceinline__ void xcd_barrier_complete(unsigned* bar, unsigned x, unsigned& nloc, unsigned& nx) {
    const unsigned G = gridDim.x * gridDim.y * gridDim.z;
    unsigned sum, cnt, mine, sp = 0u;
    for (;;) {
        sum = 0u; cnt = 0u; mine = 0u;
#pragma unroll
        for (unsigned j = 0; j < 16; ++j) { const unsigned c = xb_ld(&bar[XB_XCNT(j)]); sum += c; cnt += (c > 0u) ? 1u : 0u; mine = (j == x) ? c : mine; }
        if (sum == G) break;
        __builtin_amdgcn_s_sleep(1);
        if ((++sp & 255u) == 0u) { if (xb_ld(&bar[XB_TMO])) break; if (sp > XB_SPIN_CAP) { atomicAdd(&bar[XB_TMO], 1u); break; } }
    }
    nloc = mine > 0u ? mine : 1u; nx = cnt > 0u ? cnt : 1u;
}
__device__ __forceinline__ void xcd_barrier(const XcdBarrier& b) {
    asm volatile("s_waitcnt vmcnt(0)" ::: "memory");
    __syncthreads();
    if (threadIdx.x == 0) {
        unsigned* bar = b.bar;
        __builtin_amdgcn_s_waitcnt(0);
        unsigned nloc = b.st[0], nx = b.st[1];
        if (nloc == 0u) { xcd_barrier_complete(bar, b.x, nloc, nx); b.st[0] = nloc; b.st[1] = nx; }
        const unsigned old = xb_add(&bar[XB_XSUB(b.x)], 1u);
        const unsigned gen = old / nloc;
        if (old + 1u == (gen + 1u) * nloc) {
            __builtin_amdgcn_fence(__ATOMIC_RELEASE, "agent");
            asm volatile("s_waitcnt vmcnt(0)" ::: "memory");
            const unsigned og = xb_add(&bar[XB_TOP], 1u);
            const unsigned tg = og / nx;
            if (og + 1u == (tg + 1u) * nx) xb_add(&bar[XB_TOPGEN], 1u);
            else XB_SPIN(xb_ld(&bar[XB_TOPGEN]) == tg, bar);
            __builtin_amdgcn_fence(__ATOMIC_ACQUIRE, "agent");
            xb_add(&bar[XB_XGEN(b.x)], 1u);
            asm volatile("s_waitcnt vmcnt(0)" ::: "memory");
        } else {
            XB_SPIN(xb_ld(&bar[XB_XGEN(b.x)]) == gen, bar);
            __builtin_amdgcn_fence(__ATOMIC_ACQUIRE, "agent");
            asm volatile("s_waitcnt vmcnt(0)" ::: "memory");
        }
    }
    __syncthreads();
}

__device__ __forceinline__ unsigned xg_ld(gu32* p)              { return __hip_atomic_load(p, __ATOMIC_RELAXED, __HIP_MEMORY_SCOPE_AGENT); }
__device__ __forceinline__ unsigned xg_add(gu32* p, unsigned v) { return __hip_atomic_fetch_add(p, v, __ATOMIC_RELAXED, __HIP_MEMORY_SCOPE_AGENT); }
#define XG_SPIN(cond, bar) do { unsigned _sp = 0; while (cond) { __builtin_amdgcn_s_sleep(1); \
    if ((++_sp & 255u) == 0u) { if (xg_ld(&(bar)[XB_TMO])) break; if (_sp > XB_SPIN_CAP) { xg_add(&(bar)[XB_TMO], 1u); break; } } } } while (0)
__device__ __attribute__((noinline)) void xcd_barrier_slim(gu32* bar, unsigned x, volatile LAS unsigned* st, bool leader) {
    asm volatile("s_waitcnt vmcnt(0)" ::: "memory");
    __syncthreads();
    if (leader) {
        __builtin_amdgcn_s_waitcnt(0);
        unsigned nloc = st[0], nx = st[1];
        if (nloc == 0u || nx == 0u) { xg_add(&bar[XB_TMO], 1u); nloc = 1u; nx = 1u; }
        const unsigned old = xg_add(&bar[XB_XSUB(x)], 1u);
        const unsigned gen = old / nloc;
        if (old + 1u == (gen + 1u) * nloc) {
            __builtin_amdgcn_fence(__ATOMIC_RELEASE, "agent");
            asm volatile("s_waitcnt vmcnt(0)" ::: "memory");
            const unsigned og = xg_add(&bar[XB_TOP], 1u);
            const unsigned tg = og / nx;
            if (og + 1u == (tg + 1u) * nx) xg_add(&bar[XB_TOPGEN], 1u);
            else XG_SPIN(xg_ld(&bar[XB_TOPGEN]) == tg, bar);
            __builtin_amdgcn_fence(__ATOMIC_ACQUIRE, "agent");
            xg_add(&bar[XB_XGEN(x)], 1u);
            asm volatile("s_waitcnt vmcnt(0)" ::: "memory");
        } else {
            XG_SPIN(xg_ld(&bar[XB_XGEN(x)]) == gen, bar);
            __builtin_amdgcn_fence(__ATOMIC_ACQUIRE, "agent");
            asm volatile("s_waitcnt vmcnt(0)" ::: "memory");
        }
    }
    __syncthreads();
}

constexpr int NWAVES = 8;
struct Args { const void* in[N_IN]; float* out; unsigned char* ws; int ph_lo, ph_hi; };
static_assert(sizeof(Args) == (N_IN + 2) * 8 + 8, "Args has no padding");

struct Frame {
    LAS unsigned char* lds; char* ldsg; unsigned char* ws; int tid, lane, wave, vcu, G;
};
__device__ __forceinline__ int lane_id_now() { int l; asm volatile("v_mbcnt_lo_u32_b32 %0, -1, 0\n\tv_mbcnt_hi_u32_b32 %0, -1, %0" : "=v"(l)); return l; }
__device__ __forceinline__ Frame phase_frame(const Frame& F0) {
    Frame F = F0; int t = F0.wave * 64 + lane_id_now(); size_t z = 0; asm volatile("" : "+s"(z));
    F.tid = t; F.lane = t & 63; F.wave = __builtin_amdgcn_readfirstlane(t >> 6); F.ws = F0.ws + z; return F;
}

__device__ __forceinline__ void p0_transpose_item(const float* W, const float* gk, int K, int N, bf16* WT, int rowmode, LAS float* scr, int item, int lane) {
    const int nblk = N / 64, kb = item / nblk, nb = item - kb * nblk, k0 = 64 * kb, n0 = 64 * nb;
    const int kk4 = lane >> 4, nq = lane & 15;
    f32x4 v[16];
#pragma unroll
    for (int i = 0; i < 16; ++i) v[i] = *(const GAS f32x4*)(W + (size_t)(k0 + 4 * i + kk4) * N + n0 + 4 * nq);
#pragma unroll
    for (int i = 0; i < 16; ++i) { const int k = 4 * i + kk4; f32x4 w = v[i]; if (gk) w = w * gk[k0 + k];
        *(LAS f32x4*)(scr + k * 64 + ((4 * nq) ^ (k & 0x38))) = w; }
    LDS_WAIT(); asm volatile("" ::: "memory");
    const int r = lane >> 3, c = lane & 7;
    const int rbase = rowmode == 0 ? n0 : ((n0 >> 7) * 256 + (n0 & 127) + (rowmode == 2 ? 128 : 0));
#pragma unroll
    for (int i = 0; i < 8; ++i) { const int n = 8 * i + r; const LAS float* sp = scr + (8 * c) * 64 + (n ^ (8 * c));
        v4u o; o.x = cvt_pk_bf16(sp[0 * 64], sp[1 * 64]); o.y = cvt_pk_bf16(sp[2 * 64], sp[3 * 64]); o.z = cvt_pk_bf16(sp[4 * 64], sp[5 * 64]); o.w = cvt_pk_bf16(sp[6 * 64], sp[7 * 64]);
        *(GAS v4u*)(WT + (size_t)(rbase + n) * K + k0 + 8 * c) = o; }
    LDS_WAIT(); asm volatile("" ::: "memory");
}

struct P0Item { const float* W; const float* gk; bf16* WT; int K, N, rowmode, item; };
__device__ __forceinline__ void p0_item_load(const P0Item& d, int lane, f32x4 (&v)[16]) {
    const int nch = d.N / 256, kb = d.item / nch, nc = d.item - kb * nch, k0 = 16 * kb, n0 = 256 * nc + 4 * lane;
#pragma unroll
    for (int i = 0; i < 16; ++i) v[i] = *(const GAS f32x4*)(d.W + (size_t)(k0 + i) * d.N + n0);
}
__device__ __forceinline__ void p0_item_finish(const P0Item& d, const f32x4 (&v)[16], int lane) {
    const int nch = d.N / 256, kb = d.item / nch, nc = d.item - kb * nch, k0 = 16 * kb, n0 = 256 * nc + 4 * lane;
    const int nrow = d.rowmode == 0 ? n0 : ((n0 >> 7) * 256 + (n0 & 127) + (d.rowmode == 2 ? 128 : 0)), NR = d.rowmode == 0 ? d.N : 2 * d.N;
    float g[16];
#pragma unroll
    for (int i = 0; i < 16; ++i) g[i] = d.gk ? d.gk[k0 + i] : 1.f;
    char* dst = (char*)d.WT + ((size_t)(k0 >> 3) * NR + nrow) * 16;
#pragma unroll
    for (int o = 0; o < 2; ++o)
#pragma unroll
        for (int j = 0; j < 4; ++j) { v4u w;
            w.x = cvt_pk_bf16(v[8 * o + 0][j] * g[8 * o + 0], v[8 * o + 1][j] * g[8 * o + 1]); w.y = cvt_pk_bf16(v[8 * o + 2][j] * g[8 * o + 2], v[8 * o + 3][j] * g[8 * o + 3]);
            w.z = cvt_pk_bf16(v[8 * o + 4][j] * g[8 * o + 4], v[8 * o + 5][j] * g[8 * o + 5]); w.w = cvt_pk_bf16(v[8 * o + 6][j] * g[8 * o + 6], v[8 * o + 7][j] * g[8 * o + 7]);
            *(GAS v4u*)(dst + ((size_t)o * NR + j) * 16) = w; }
}
__device__ __forceinline__ void p0a_prologue(const Frame& F0, const Args& a) {
    const Frame F = phase_frame(F0);
    LAS float* scr = (LAS float*)(F.lds + F.wave * 16384);
    const int gw = F.vcu * NWAVES + F.wave, NGW = F.G * NWAVES;
    constexpr int I_MK = (DM / 64) * (2 * MEM_W / 64);
    for (int it = gw; it < I_MK; it += NGW) p0_transpose_item((const float*)a.in[IN_WMEMKV], nullptr, DM, 2 * MEM_W, (bf16*)(F.ws + WS_WMK), 0, scr, it, F.lane);
    { const float* x = (const float*)a.in[IN_X]; char* xb = (char*)(F.ws + WS_XB); float* ssb = (float*)(F.ws + WS_SSB);
      for (int t = gw; t < (SEQ / 16) * 4; t += NGW) {
          const int rg = t >> 2, cq = t & 3, r = F.lane & 15, sb = F.lane >> 4, m = rg * 16 + r; float s = 0.f;
          const float* xr = x + (size_t)m * DM + cq * 1024 + sb * 8;
#pragma unroll 8
          for (int j = 0; j < 32; ++j) { const f32x4 v0 = *(const GAS f32x4*)(xr + 32 * j), v1 = *(const GAS f32x4*)(xr + 32 * j + 4);
              s += ((v0[0] * v0[0] + v0[1] * v0[1]) + (v0[2] * v0[2] + v0[3] * v0[3])) + ((v1[0] * v1[0] + v1[1] * v1[1]) + (v1[2] * v1[2] + v1[3] * v1[3]));
              v4u w; w.x = cvt_pk_bf16(v0[0], v0[1]); w.y = cvt_pk_bf16(v0[2], v0[3]); w.z = cvt_pk_bf16(v1[0], v1[1]); w.w = cvt_pk_bf16(v1[2], v1[3]);
              *(GAS v4u*)(xb + ((size_t)(cq * 128 + 4 * j + sb) * SEQ + m) * 16) = w; }
          s += __shfl_xor(s, 16); s += __shfl_xor(s, 32);
          ssb[(size_t)m * 16 + 4 * sb + cq] = sb == 0 ? s : 0.f; } }
    { const int* pos = (const int*)a.in[IN_POS]; float* cs = (float*)(F.ws + WS_CS);
      const float INV[16] = {1.000000000e+00f, 4.403665960e-01f, 1.939227432e-01f, 8.539710194e-02f, 3.760603070e-02f, 1.656043902e-02f, 7.292664610e-03f, 3.211445874e-03f,
                             1.414213562e-03f, 6.227723788e-04f, 2.742481884e-04f, 1.207697351e-04f, 5.318296098e-05f, 2.341999971e-05f, 1.031338616e-05f, 4.541670478e-06f};
      for (int idx = F.vcu * 512 + F.tid; idx < SEQ * 16; idx += F.G * 512) {
          const int row = idx >> 4, i = idx & 15; float inv = INV[0];
#pragma unroll
          for (int k = 1; k < 16; ++k) inv = (i == k) ? INV[k] : inv;
          const float angf = (float)pos[row] * inv; const double ang = (double)angf;
          const double qd = __builtin_rint(ang * 0.63661977236758134308); const int qi = (int)qd;
          double r = __builtin_fma(-qd, 1.57079632679489655800e+00, ang); r = __builtin_fma(-qd, 6.12323399573676603587e-17, r);
          const double r2 = r * r;
          double sp = -2.5052108385441718775e-08; sp = sp * r2 + 2.7557319223985890653e-06; sp = sp * r2 - 1.9841269841269841253e-04; sp = sp * r2 + 8.3333333333333332177e-03; sp = sp * r2 - 1.6666666666666665741e-01;
          const double sn = r + r * r2 * sp;
          double cp = 2.0876756987868098979e-09; cp = cp * r2 - 2.7557319223985888276e-07; cp = cp * r2 + 2.4801587301587301566e-05; cp = cp * r2 - 1.3888888888888889419e-03; cp = cp * r2 + 4.1666666666666664354e-02; cp = cp * r2 - 0.5;
          const double cn = 1.0 + r2 * cp;
          const int q4 = qi & 3;
          const double c = (q4 == 0) ? cn : (q4 == 1) ? -sn : (q4 == 2) ? -cn : sn;
          const double s = (q4 == 0) ? sn : (q4 == 1) ? cn : (q4 == 2) ? -sn : -cn;
          cs[(size_t)row * 32 + i] = (float)c; cs[(size_t)row * 32 + 16 + i] = (float)s; } }
    { const float* mem = (const float*)a.in[IN_MEM]; const float* gm = (const float*)a.in[IN_GMEM]; bf16* mb = (bf16*)(F.ws + WS_MEMB); float* rsm = (float*)(F.ws + WS_RSM);
      for (int m = gw; m < MEML; m += NGW) {
          const GAS f32x4* xr = (const GAS f32x4*)(mem + (size_t)m * DM) + F.lane; const GAS f32x4* gr = (const GAS f32x4*)gm + F.lane; GAS v2u* o8 = (GAS v2u*)(mb + (size_t)m * DM) + F.lane; float s = 0.f;
#pragma unroll 4
          for (int j = 0; j < 16; ++j) { const f32x4 v = xr[64 * j]; const f32x4 g = gr[64 * j]; s += (v[0] * v[0] + v[1] * v[1]) + (v[2] * v[2] + v[3] * v[3]);
              v2u w; w.x = cvt_pk_bf16(v[0] * g[0], v[1] * g[1]); w.y = cvt_pk_bf16(v[2] * g[2], v[3] * g[3]); o8[64 * j] = w; }
          s = wave_sum(s);
          if (F.lane == 0) rsm[m] = __builtin_amdgcn_rsqf(s * (1.0f / DM) + NORM_EPS); } }
}
__device__ __forceinline__ void p0b_weights(const Frame& F0, const Args& a, int skip) {
    const Frame F = phase_frame(F0);
    if (F.vcu < skip) return;
    LAS float* scr = (LAS float*)(F.lds + F.wave * 16384);
    const int gw = (F.vcu - skip) * NWAVES + F.wave, NGW = (F.G - skip) * NWAVES;
    constexpr int I_IN = (DM / 64) * (PW / 64), I_OUT = (DM / 64) * (DM / 64), I_G = (DM / 64) * (DFF / 64), I_D = (DFF / 64) * (DM / 64);
    constexpr int I_LAYER = I_IN + I_OUT + 2 * I_G + I_D;
    auto desc = [&](int it) -> P0Item {
        const int l = it >= I_LAYER ? 1 : 0; int r = it - l * I_LAYER;
        if (r < I_IN) return P0Item{(const float*)a.in[IN_WIN] + (size_t)l * DM * PW, (const float*)a.in[IN_GATTN] + l * DM, (bf16*)(F.ws + WS_WIN + l * SZ_WIN), DM, PW, 0, r};
        r -= I_IN;
        if (r < I_OUT) return P0Item{(const float*)a.in[IN_WOUT] + (size_t)l * DM * DM, nullptr, (bf16*)(F.ws + WS_WOUT + l * SZ_WOUT), DM, DM, 0, r};
        r -= I_OUT;
        if (r < I_G) return P0Item{(const float*)a.in[IN_WGATE] + (size_t)l * DM * DFF, (const float*)a.in[IN_GFFN] + l * DM, (bf16*)(F.ws + WS_WGU + l * SZ_WGU), DM, DFF, 1, r};
        r -= I_G;
        if (r < I_G) return P0Item{(const float*)a.in[IN_WUP] + (size_t)l * DM * DFF, (const float*)a.in[IN_GFFN] + l * DM, (bf16*)(F.ws + WS_WGU + l * SZ_WGU), DM, DFF, 2, r};
        r -= I_G;
        return P0Item{(const float*)a.in[IN_WDOWN] + (size_t)l * DFF * DM, nullptr, (bf16*)(F.ws + WS_WDN + l * SZ_WDN), DFF, DM, 0, r}; };
    int it = gw;
    if (it < 2 * I_LAYER) {
        f32x4 va[16], vb[16];
        P0Item da = desc(it); p0_item_load(da, F.lane, va);
        for (;;) {
            const int itn = it + NGW; const bool more = itn < 2 * I_LAYER;
            P0Item db = da;
            if (more) { db = desc(itn); p0_item_load(db, F.lane, vb); }
            p0_item_finish(da, va, F.lane);
            if (!more) break;
            it = itn; da = db;
#pragma unroll
            for (int i = 0; i < 16; ++i) va[i] = vb[i];
        }
    }
}

__device__ __forceinline__ void memprep_phase(const Frame& F0, const Args& a, int layer) {
    const Frame F = phase_frame(F0);
    { const float* mkv = (const float*)(F.ws + WS_MKV); bf16* kmn = (bf16*)(F.ws + WS_KMN + (size_t)layer * 524288); bf16* vt = (bf16*)(F.ws + WS_VT);
      const float* gk = (const float*)a.in[IN_GMK] + layer * 256; const float* gq = (const float*)a.in[IN_GMQ] + layer * 256;
      const int gw = F.vcu * NWAVES + F.wave, NGW = F.G * NWAVES;
      for (int t = gw; t < 4 * MEML; t += NGW) { const int h = t >> 8, key = t & 255;
          const f32x4 v = *(const f32x4*)(mkv + (size_t)key * 2048 + h * 256 + F.lane * 4);
          float s = (v[0] * v[0] + v[1] * v[1]) + (v[2] * v[2] + v[3] * v[3]); s = wave_sum(s);
          const float rs = __builtin_amdgcn_rsqf(s * (1.0f / 256.0f) + NORM_EPS);
          const f32x4 g1 = *(const f32x4*)(gk + F.lane * 4), g2 = *(const f32x4*)(gq + F.lane * 4);
          v2u o; o.x = cvt_pk_bf16(v[0] * rs * g1[0] * g2[0], v[1] * rs * g1[1] * g2[1]); o.y = cvt_pk_bf16(v[2] * rs * g1[2] * g2[2], v[3] * rs * g1[3] * g2[3]);
          *(v2u*)(kmn + (size_t)t * 256 + F.lane * 4) = o; }
      for (int idx = F.vcu * 512 + F.tid; idx < 4 * 256 * 256; idx += F.G * 512) { const int hd = idx >> 8, key = idx & 255;
          const float v = mkv[(size_t)key * 2048 + 1024 + hd]; vt[idx] = (bf16)(cvt_pk_bf16(v, 0.f) & 0xffffu); } }
}

__device__ __forceinline__ void gate_phase(const Frame& F0) {
    const Frame F = phase_frame(F0);
    const bf16* proj = (const bf16*)(F.ws + WS_PROJ); const float* ksum = (const float*)(F.ws + WS_KSUM);
    unsigned short* seg = (unsigned short*)(F.ws + WS_SEG); unsigned* cnt = (unsigned*)(F.ws + WS_CNT);
    LAS float* km = (LAS float*)F.lds;
    LAS unsigned* wc = (LAS unsigned*)(F.lds + 16384);
    gu32* qcur = (gu32*)(F.ws + WS_CTL) + CW_GATEQ; volatile LAS int* qit = (volatile LAS int*)(F.lds + 16384 + 1024);
    for (;;) {
        __syncthreads();
        if (F.tid == 0) *qit = (int)__hip_atomic_fetch_add(qcur, 1u, __ATOMIC_RELAXED, __HIP_MEMORY_SCOPE_AGENT);
        __syncthreads();
        const int it = __builtin_amdgcn_readfirstlane(*qit);
        if (it >= NHEAD * (NBLK - 1)) break;
        const int h = it % NHEAD, b0 = NBLK - 1 - it / NHEAD;
        for (int e = F.tid; e < b0 * HD; e += 512) { const int blk = e >> 7, dim = e & 127; const float* kp = ksum + ((size_t)(h * NBLK + blk) * 2) * HD + dim;
            km[e] = (kp[0] + kp[HD]) * (1.0f / 256.0f); }
        __syncthreads();
        int i1 = 32, i2 = 32, i3 = 32;
        const int rib = F.tid >> 1, half = F.tid & 1;
        {
            const int row = b0 * 256 + rib;
            const v4u* qp = (const v4u*)(proj + (size_t)row * PW + h * HD + half * 64);
            v4u q[8];
#pragma unroll
            for (int j = 0; j < 8; ++j) q[j] = qp[j];
            float v1 = -__builtin_inff(), v2 = v1, v3 = v1;
            for (int blk = 0; blk < b0; ++blk) {
                const LAS f32x4* kr = (const LAS f32x4*)(km + blk * HD + half * 64); float g0 = 0.f, g1 = 0.f;
#pragma unroll
                for (int j = 0; j < 8; ++j) { const f32x4 ka = kr[2 * j], kb = kr[2 * j + 1];
                    g0 += bf_lo(q[j].x) * ka[0] + bf_hi(q[j].x) * ka[1] + bf_lo(q[j].y) * ka[2] + bf_hi(q[j].y) * ka[3];
                    g1 += bf_lo(q[j].z) * kb[0] + bf_hi(q[j].z) * kb[1] + bf_lo(q[j].w) * kb[2] + bf_hi(q[j].w) * kb[3]; }
                float gt = g0 + g1; gt += __shfl_xor(gt, 1);
                if (gt > v1) { v3 = v2; i3 = i2; v2 = v1; i2 = i1; v1 = gt; i1 = blk; }
                else if (gt > v2) { v3 = v2; i3 = i2; v2 = gt; i2 = blk; }
                else if (gt > v3) { v3 = gt; i3 = blk; }
            }
            for (int j = 0; j < b0; ++j) { const bool sj = (half == 0) && ((i1 == j) | (i2 == j) | (i3 == j)); const unsigned long long b = __ballot(sj); if (F.lane == 0) wc[j * 8 + F.wave] = (unsigned)__popcll(b); }
        }
        __syncthreads();
        {
            const unsigned long long lt = (1ull << F.lane) - 1ull;
            for (int j = 0; j < b0; ++j) { const bool sj = (half == 0) && ((i1 == j) | (i2 == j) | (i3 == j)); const unsigned long long b = __ballot(sj);
                unsigned base = 0; for (int w = 0; w < F.wave; ++w) base += wc[j * 8 + w];
                if (sj) { const unsigned rank = base + (unsigned)__popcll(b & lt); const unsigned pk = (i1 == j) ? 0u : (i2 == j) ? 1u : 2u;
                    seg[((size_t)(h * 32 + j) * 32 + b0) * 256 + rank] = (unsigned short)((unsigned)rib | (pk << 8)); }
                if (F.tid == 0) { unsigned t = 0; for (int w = 0; w < 8; ++w) t += wc[j * 8 + w]; cnt[(h * 32 + j) * 32 + b0] = t; } }
        }
    }
    __syncthreads();
}
__device__ __forceinline__ void flatten_phase(const Frame& F0) {
    const Frame F = phase_frame(F0);
    const unsigned short* seg = (const unsigned short*)(F.ws + WS_SEG); const unsigned* cnt = (const unsigned*)(F.ws + WS_CNT);
    unsigned short* flat = (unsigned short*)(F.ws + WS_FLAT); unsigned* rj = (unsigned*)(F.ws + WS_RJ);
    const int gw = F.vcu * NWAVES + F.wave, NGW = F.G * NWAVES;
    for (int v = gw; v < NHEAD * 31 * 4; v += NGW) {
        const int ch = v / (NHEAD * 31), it = v - ch * (NHEAD * 31);
        const int h = it / 31, j = it % 31;
        const int gbeg = j + 1 + 8 * ch, gend = (gbeg + 8 < 32) ? gbeg + 8 : 32;
        if (gbeg >= 32) continue;
        const unsigned c = (F.lane < 32 && F.lane > j) ? cnt[(h * 32 + j) * 32 + F.lane] : 0u, pc = (c + 31u) & ~31u;
        unsigned inc = pc;
#pragma unroll
        for (int o = 1; o < 32; o <<= 1) { const unsigned n = __shfl_up(inc, o); if (F.lane >= o) inc += n; }
        const unsigned offl = inc - pc;
        const unsigned total = (unsigned)__builtin_amdgcn_readlane((int)inc, 31), rounds = (total + 255u) >> 8;
        const unsigned long long nz = __ballot(c > 0u);
        unsigned short* fl = flat + (size_t)it * 8192;
        const unsigned short* sbase = seg + (size_t)(h * 32 + j) * 32 * 256;
        for (int g0 = gbeg; g0 < gend; g0 += 4) {
            unsigned ev[4][4];
#pragma unroll
            for (int k = 0; k < 4; ++k) { const int b0 = (g0 + k < gend) ? g0 + k : 31; const unsigned cb = (g0 + k < gend) ? (unsigned)__builtin_amdgcn_readlane((int)c, b0) : 0u, cpb = (cb + 31u) & ~31u;
#pragma unroll
                for (int q = 0; q < 4; ++q) { const unsigned t = (unsigned)F.lane + 64u * q; ev[k][q] = 0u;
                    if (t < cpb) ev[k][q] = (t < cb) ? (unsigned)sbase[b0 * 256 + t] : ((unsigned)sbase[b0 * 256 + (t & ~31u)] | 0x10000u); } }
#pragma unroll
            for (int k = 0; k < 4; ++k) { const int b0 = (g0 + k < gend) ? g0 + k : 31; const unsigned cb = (g0 + k < gend) ? (unsigned)__builtin_amdgcn_readlane((int)c, b0) : 0u, cpb = (cb + 31u) & ~31u;
                const unsigned ob = (unsigned)__builtin_amdgcn_readlane((int)offl, b0);
#pragma unroll
                for (int q = 0; q < 4; ++q) { const unsigned t = (unsigned)F.lane + 64u * q;
                    if (t < cpb) { const unsigned e = ev[k][q]; fl[ob + t] = (unsigned short)((e & 255u) | ((unsigned)b0 << 8) | (((e >> 8) & 3u) << 13) | ((e >> 16) << 15)); } } }
        }
        if (ch != 0) continue;
        if (total > 0u) { const unsigned bf = (unsigned)__builtin_ctzll(nz); const unsigned e0 = sbase[bf * 256];
            const unsigned short fill = (unsigned short)((e0 & 255u) | (bf << 8) | (((e0 >> 8) & 3u) << 13) | 0x8000u);
            for (unsigned idx = total + (unsigned)F.lane; idx < rounds * 256u; idx += 64u) fl[idx] = fill; }
        if (F.lane == 0) rj[it] = rounds;
    }
}

__device__ __forceinline__ att::BlockRef attn_ref_moba(const Frame& F, LAS unsigned* PT, int u, int ug, int wid, int r32, int hi) {
    const bf16* proj = (const bf16*)(F.ws + WS_PROJ); att::BlockRef r; int h, kb; unsigned row, pk, inact;
    if (u < ug) { int lo = 0, hiI = NHEAD * 31;
        while (hiI - lo > 1) { const int mid = (lo + hiI) >> 1; if ((int)PT[mid] <= u) lo = mid; else hiI = mid; }
        const unsigned short* fl = (const unsigned short*)(F.ws + WS_FLAT) + (size_t)lo * 8192;
        const unsigned ent = fl[(unsigned)(u - (int)PT[lo]) * 256u + (unsigned)(wid * 32 + r32)];
        h = lo / 31; kb = lo % 31; row = ent & 0x1fffu; pk = (ent >> 13) & 3u; inact = ent >> 15; r.flags = 3;
    } else { const int v = u - ug; h = v >> 5; kb = v & 31; row = (unsigned)(kb * 256 + wid * 32 + r32); pk = 3u; inact = 0u; r.flags = 2; }
    r.K = proj + (size_t)(kb * 256) * PW + SELF_W + h * HD; r.V = proj + (size_t)(kb * 256) * PW + 2 * SELF_W + h * HD;
    r.O = (char*)(F.ws + WS_PARTO) + (size_t)h * SEQ * 4 * HD * 2; r.ML = (float*)(F.ws + WS_PARTML) + (size_t)h * SEQ * 4 * 2;
    r.qoff = (unsigned)(row * PW + h * HD + hi * 8) * 2u; r.pinfo = (row * 4u + pk) | (inact << 31);
    r.P0 = 0; r.NT = 4;
    return r;
}
__device__ __forceinline__ void attn_phase_moba(const Frame& F0) {
    if (F0.G != 256) return;
    const Frame F = phase_frame(F0);
    char* lds = F.ldsg; const char* qbase = (const char*)(F.ws + WS_PROJ);
    const int wid = F.wave, r32 = F.lane & 31, hi = F.lane >> 5;
    LAS unsigned* PT = (LAS unsigned*)(F.lds + 73728);
    { const unsigned* rj = (const unsigned*)(F.ws + WS_RJ);
      for (int i = F.tid; i < NHEAD * 31; i += 512) PT[i + 1] = rj[i];
      __syncthreads();
      if (F.wave == 0) {
          unsigned v[12], t = 0u;
#pragma unroll
          for (int k = 0; k < 12; ++k) { const int i = F.lane * 12 + k; v[k] = (i < NHEAD * 31) ? PT[i + 1] : 0u; t += v[k]; }
          unsigned inc = t;
#pragma unroll
          for (int o = 1; o < 64; o <<= 1) { const unsigned n = __shfl_up(inc, o); if (F.lane >= o) inc += n; }
          unsigned a = inc - t;
#pragma unroll
          for (int k = 0; k < 12; ++k) { const int i = F.lane * 12 + k; a += v[k]; if (i < NHEAD * 31) PT[i + 1] = a; }
          if (F.lane == 0) PT[0] = 0u; }
      __syncthreads(); }
    const int ug = (int)PT[NHEAD * 31], U = ug + NHEAD * NBLK;
    int u = ((F.vcu & 31) >= 16) ? (F.vcu >> 5) * 16 + (F.vcu & 31) - 16 : 128 + (F.vcu >> 5) * 16 + (F.vcu & 31);
    att::Seam S;
    att::BlockRef cur = attn_ref_moba(F, PT, u, ug, wid, r32, hi);
    att::attn_prime(cur, qbase, lds, S, F.tid);
    for (;;) {
        const int un = u + F.G; const bool more = un < U;
        att::BlockRef nxt = cur;
        if (more) nxt = attn_ref_moba(F, PT, un, ug, wid, r32, hi);
        att::attn_block(cur, nxt, qbase, lds, S, F.tid);
        if (!more) break;
        cur = nxt; u = un;
    }
    VM_WAIT(); __builtin_amdgcn_s_waitcnt(0); __syncthreads();
}
__device__ __forceinline__ att2::Ref attn_ref_diff(const Frame& F, int i, int s, int r32, int hi) {
    const bf16* proj = (const bf16*)(F.ws + WS_PROJ); att2::Ref r;
    const int sh = (F.vcu >> 5) * 3 + (i >> 1), pr = F.vcu & 31, x = (i & 1) ? pr : 63 - pr;
    r.K = proj + SELF_W + sh * HD; r.V = proj + 2 * SELF_W + (sh >> 1) * 256;
    r.O = (char*)((bf16*)(F.ws + WS_OP) + (size_t)(x * 128) * OPW + sh * 256);
    r.qoff = (unsigned)((x * 128 + s * 32 + r32) * PW + sh * HD + hi * 8) * 2u; r.P0 = x * 128; r.NT = 2 * x + 2; r.desc = i & 1;
    return r;
}
__device__ __forceinline__ void attn_phase_diff(const Frame& F0) {
    if (F0.G != 256) return;
    const Frame F = phase_frame(F0);
    char* lds = F.ldsg; const char* qbase = (const char*)(F.ws + WS_PROJ);
    const int s = F.wave & 3, r32 = F.lane & 31, hi = F.lane >> 5;
    auto ref = [&](int i) { return attn_ref_diff(F, i, s, r32, hi); };
    int G = 0; for (int i = 0; i < 6; ++i) G += attn_ref_diff(F, i, s, r32, hi).NT;
    if (F.wave < 4) att2::score_stream(ref, 6, G, qbase, lds, F.tid);
    else att2::helper_stream(ref, 6, G, lds, F.tid);
    VM_WAIT(); __builtin_amdgcn_s_waitcnt(0); __syncthreads();
}
__device__ __forceinline__ void moba_merge_phase(const Frame& F0) {
    const Frame F = phase_frame(F0);
    const bf16* po = (const bf16*)(F.ws + WS_PARTO); const float* pml = (const float*)(F.ws + WS_PARTML); bf16* att_o = (bf16*)(F.ws + WS_ATT);
    constexpr float C2 = 1.4426950408889634f * att::SCALE;
    const int gw = F.vcu * NWAVES + F.wave, NGW = F.G * NWAVES, hq = F.lane >> 4, d8 = (F.lane & 15) * 8;
    for (int it = gw; it < SEQ * 2; it += NGW) {
        const int row = it >> 1, hb = (it & 1) * 3, nv = (row >> 8) < 3 ? (row >> 8) : 3;
        f32x4 ml01[3], ml23[3]; v4u ov[3][4];
#pragma unroll
        for (int q = 0; q < 3; ++q) { const size_t slot = ((size_t)((hb + q) * 4 + hq) * SEQ + row) * 4;
            ml01[q] = *(const f32x4*)(pml + slot * 2); ml23[q] = *(const f32x4*)(pml + slot * 2 + 4);
#pragma unroll
            for (int p4 = 0; p4 < 4; ++p4) ov[q][p4] = *(const v4u*)(po + (slot + p4) * HD + d8); }
#pragma unroll
        for (int q = 0; q < 3; ++q) { const int h = (hb + q) * 4 + hq;
            const float mp[4] = {ml01[q][0], ml01[q][2], ml23[q][0], ml23[q][2]}, lp[4] = {ml01[q][1], ml01[q][3], ml23[q][1], ml23[q][3]};
            float M = mp[3];
#pragma unroll
            for (int p4 = 0; p4 < 3; ++p4) M = (p4 < nv) ? fmaxf(M, mp[p4]) : M;
            float w[4], ws = 0.f;
#pragma unroll
            for (int p4 = 0; p4 < 4; ++p4) { w[p4] = (p4 == 3 || p4 < nv) ? lp[p4] * __builtin_amdgcn_exp2f((mp[p4] - M) * C2) : 0.f; ws += w[p4]; }
            const float rw = 1.0f / ws; float acc[8];
#pragma unroll
            for (int k = 0; k < 8; ++k) acc[k] = 0.f;
#pragma unroll
            for (int p4 = 0; p4 < 4; ++p4) { if (p4 == 3 || p4 < nv) { const float wp = w[p4] * rw; const v4u x = ov[q][p4];
                acc[0] += wp * bf_lo(x.x); acc[1] += wp * bf_hi(x.x); acc[2] += wp * bf_lo(x.y); acc[3] += wp * bf_hi(x.y);
                acc[4] += wp * bf_lo(x.z); acc[5] += wp * bf_hi(x.z); acc[6] += wp * bf_lo(x.w); acc[7] += wp * bf_hi(x.w); } }
            v4u o; o.x = cvt_pk_bf16(acc[0], acc[1]); o.y = cvt_pk_bf16(acc[2], acc[3]); o.z = cvt_pk_bf16(acc[4], acc[5]); o.w = cvt_pk_bf16(acc[6], acc[7]);
            *(v4u*)(att_o + (size_t)row * OPW + h * HD + d8) = o; }
    }
}

__device__ __forceinline__ void diff_combine_phase(const Frame& F0, const Args& a) {
    const Frame F = phase_frame(F0);
    const bf16* op = (const bf16*)(F.ws + WS_OP); bf16* att_o = (bf16*)(F.ws + WS_ATT);
    float d1 = 0.f, d2 = 0.f;
    { const float* q1 = (const float*)a.in[IN_LQ1]; const float* k1 = (const float*)a.in[IN_LK1]; const float* q2 = (const float*)a.in[IN_LQ2]; const float* k2 = (const float*)a.in[IN_LK2];
      d1 = q1[F.lane] * k1[F.lane] + q1[F.lane + 64] * k1[F.lane + 64]; d2 = q2[F.lane] * k2[F.lane] + q2[F.lane + 64] * k2[F.lane + 64];
      d1 = wave_sum(d1); d2 = wave_sum(d2); }
    const float lam = __expf(d1) - __expf(d2) + LAM_INIT;
    const f32x4 gs = *(const f32x4*)((const float*)a.in[IN_GSUB] + F.lane * 4);
    const int gw = F.vcu * NWAVES + F.wave, NGW = F.G * NWAVES;
    v2u w0[12], w1[12], n0[12], n1[12];
    if (gw < SEQ) { const bf16* orow = op + (size_t)gw * OPW + F.lane * 4;
#pragma unroll
        for (int h = 0; h < 12; ++h) { w0[h] = *(const v2u*)(orow + (h * 2 + 0) * 256); w1[h] = *(const v2u*)(orow + (h * 2 + 1) * 256); } }
    for (int row = gw; row < SEQ; row += NGW) {
        { const int nr = (row + NGW < SEQ) ? row + NGW : row; const bf16* orow = op + (size_t)nr * OPW + F.lane * 4;
#pragma unroll
          for (int h = 0; h < 12; ++h) { n0[h] = *(const v2u*)(orow + (h * 2 + 0) * 256); n1[h] = *(const v2u*)(orow + (h * 2 + 1) * 256); } }
#pragma unroll
        for (int h = 0; h < 12; ++h) {
            float o[4] = {bf_lo(w0[h].x) - lam * bf_lo(w1[h].x), bf_hi(w0[h].x) - lam * bf_hi(w1[h].x), bf_lo(w0[h].y) - lam * bf_lo(w1[h].y), bf_hi(w0[h].y) - lam * bf_hi(w1[h].y)};
            float s = (o[0] * o[0] + o[1] * o[1]) + (o[2] * o[2] + o[3] * o[3]); s = wave_sum(s);
            const float rs = __builtin_amdgcn_rsqf(s * (1.0f / 256.0f) + SUBLN_EPS) * (1.0f - LAM_INIT);
            v2u r; r.x = cvt_pk_bf16(o[0] * rs * gs[0], o[1] * rs * gs[1]); r.y = cvt_pk_bf16(o[2] * rs * gs[2], o[3] * rs * gs[3]);
            *(v2u*)(att_o + (size_t)row * OPW + h * 256 + F.lane * 4) = r;
        }
#pragma unroll
        for (int h = 0; h < 12; ++h) { w0[h] = n0[h]; w1[h] = n1[h]; }
    }
}

constexpr int N_PHASES = 2 + 2 * 9;
__global__ void __launch_bounds__(NWAVES * 64, 2) hybrid_fwd(Args args) {
    extern __shared__ __attribute__((aligned(16))) unsigned char lds[];
    Frame F;
    F.lds = (LAS unsigned char*)lds; F.ldsg = (char*)lds; F.ws = args.ws;
    F.tid = threadIdx.x; F.lane = F.tid & 63; F.wave = __builtin_amdgcn_readfirstlane(F.tid >> 6);
    asm volatile("" : "+s"(F.wave));
    F.G = gridDim.x; { const int bx = blockIdx.x; F.vcu = (F.G % 8 == 0) ? (bx % 8) * (F.G / 8) + bx / 8 : bx; }
    volatile LAS unsigned* MISC = (volatile LAS unsigned*)(F.lds + MISC_OFF);
    for (int u = F.tid; u < 64; u += NWAVES * 64) MISC[u] = 0u;
    __syncthreads();
    const int lo = args.ph_lo, hi = args.ph_hi;
    const bool one = (hi - lo) > 1;
    gu32* ctl = (gu32*)(args.ws + WS_CTL);
    XcdBarrier bar; bar.bar = (unsigned*)(ctl + CW_BAR); bar.x = 0; bar.st = nullptr;
    if (one) bar = xcd_barrier_post((unsigned*)(ctl + CW_BAR), MISC + 8);
#ifndef PH_MASK
#define PH_MASK 0xffff
#endif
#define IN(k) (lo <= (k) && (k) < hi)
#define EN(b) ((PH_MASK >> (b)) & 1)
#ifndef PROBE_ATT
#define PROBE_ATT -1
#endif
#ifndef PROBE_OUT
#define PROBE_OUT 0
#endif
#ifndef PROBE_DUP
#define PROBE_DUP 0
#endif
#ifndef PROBE_ID
#define PROBE_ID 0
#endif
#define DUP(id) _Pragma("unroll") for (int rp_ = 0; rp_ < ((PROBE_ID == (id)) ? 2 : 1); ++rp_)
#define REP(b) _Pragma("unroll") for (int rep_ = 0; rep_ < (((PROBE_DUP >> (b)) & 1) ? 2 : 1); ++rep_)
#define SEAM0(k) do { if (IN(k) && IN((k) + 1)) { XcdBarrier b2_ = bar; size_t bz_ = 0; asm volatile("" : "+s"(bz_)); b2_.bar = bar.bar + bz_; xcd_barrier(b2_); } } while (0)
#define SEAM(k) do { if (IN(k) && IN((k) + 1)) xcd_barrier_slim((gu32*)bar.bar, bar.x, bar.st, F.wave == 0 && lane_id_now() == 0); } while (0)
    float* xout = args.out;
    PG8_LAS float* exch = (PG8_LAS float*)(F.lds + EXCH_OFF);
#define WSP(T, off) ((T*)(wsl + (off)))
#define WS_LOCAL() size_t wz_ = 0; asm volatile("" : "+s"(wz_)); unsigned char* wsl = args.ws + wz_

    if (EN(0) && IN(0)) { p0a_prologue(F, args); }
    SEAM0(0);
    if (EN(0) && IN(1)) {
        const int skip = F.G > 16 ? 8 : 0;
        { WS_LOCAL();
          pg8::Gemm g{WSP(bf16, WS_MEMB), WSP(const bf16, WS_WMK), MEML, 2 * MEM_W, DM, DM, DM, 0}; pg8::StaticOrder S; S.init(MEML, 2 * MEM_W, F.G, F.vcu);
          pg8::EpiMKV E{WSP(float, WS_MKV), 2 * MEM_W, WSP(const float, WS_RSM)};
          pg8::gemm_phase<pg8::EpiMKV, pg8::StaticOrder>(F.lds, g, S, E, F.wave); }
        __syncthreads();
        DUP(1) p0b_weights(F, args, skip);
    }
    SEAM(1);
#pragma unroll 1
    for (int l = 0; l < 2; ++l) {
        const int pb = 2 + 9 * l;
        if (EN(1) && IN(pb + 0)) DUP(2) {
            WS_LOCAL();
            pg8::Gemm g{WSP(bf16, WS_XB), WSP(const bf16, WS_WIN + l * SZ_WIN), SEQ, PW, DM, DM, DM, 0, 1}; pg8::StaticOrder S; S.init(SEQ, PW, F.G, (int)blockIdx.x);
            pg8::EpiProjN E{WSP(bf16, WS_PROJ), PW, WSP(float, WS_SSB), 1.0f / DM, NORM_EPS, exch, (PG8_LAS float*)(F.lds + MISC_OFF + 256), (const float*)args.in[IN_GQ] + l * HD, (const float*)args.in[IN_GK] + l * HD,
                            (const int*)args.in[IN_POS], l == 0 ? WSP(float, WS_KSUM) : nullptr, WSP(const float, WS_CS)};
            pg8::gemm_phase<pg8::EpiProjN, pg8::StaticOrder>(F.lds, g, S, E, F.wave);
        }
        SEAM(pb + 0);
        if (l == 0) {
            if (EN(3) && IN(pb + 2)) DUP(3) { memprep_phase(F, args, 0); memprep_phase(F, args, 1); gate_phase(F); }
            SEAM(pb + 2);
        }
        if (l == 0) { if (IN(pb + 3)) DUP(4) flatten_phase(F); SEAM(pb + 3); }
        if (IN(pb + 4)) {
            if (EN(4)) DUP(5) { WS_LOCAL();
              pg8::Gemm g{WSP(bf16, WS_PROJ) + 3 * SELF_W, WSP(const bf16, WS_KMN + l * 524288), SEQ, MEM_W, 256, PW, 256, 256}; pg8::StaticOrder S; S.init(SEQ, MEM_W, F.G, (int)blockIdx.x);
              pg8::EpiMemS E{WSP(bf16, WS_PM), WSP(float, WS_PS)};
              pg8::gemm_phase<pg8::EpiMemS, pg8::StaticOrder>(F.lds, g, S, E, F.wave); }
            __syncthreads();
            if (EN(5)) { if (l == 0) DUP(6) attn_phase_moba(F); else DUP(7) attn_phase_diff(F); }
        }
        SEAM(pb + 4);
        if (IN(pb + 5)) {
            if (EN(6)) DUP(8) { WS_LOCAL();
              pg8::Gemm g{WSP(bf16, WS_PM), WSP(const bf16, WS_VT), SEQ, MEM_W, 256, MEM_W, 256, 256}; pg8::StaticOrder S; S.init(SEQ, MEM_W, F.G, (int)blockIdx.x);
              pg8::EpiMemO E{WSP(bf16, WS_ATT), WSP(float, WS_PS)};
              pg8::gemm_phase<pg8::EpiMemO, pg8::StaticOrder>(F.lds, g, S, E, F.wave); }
            if (EN(7)) { if (l == 0) DUP(9) moba_merge_phase(F); else DUP(10) diff_combine_phase(F, args); }
        }
        SEAM(pb + 5);
        if (EN(8) && IN(pb + 6)) {
            WS_LOCAL();
            pg8::Gemm g{WSP(bf16, WS_ATT), WSP(const bf16, WS_WOUT + l * SZ_WOUT), SEQ, DM, DM, OPW, DM, 0, 1}; pg8::StaticOrder S; S.init(SEQ, DM, F.G, (int)blockIdx.x);
            pg8::EpiRes<false> E{nullptr, nullptr, WSP(bf16, WS_XB), WSP(float, WS_SSA), DM, exch};
            pg8::gemm_phase<pg8::EpiRes<false>, pg8::StaticOrder>(F.lds, g, S, E, F.wave);
        }
        SEAM(pb + 6);
        if (EN(9) && IN(pb + 7)) REP(9) {
            WS_LOCAL();
            pg8::Gemm g{WSP(bf16, WS_XB), WSP(const bf16, WS_WGU + l * SZ_WGU), SEQ, NGU, DM, DM, DM, 0, 1}; pg8::StaticOrder S; S.init(SEQ, NGU, F.G, (int)blockIdx.x);
            pg8::EpiGU E{WSP(bf16, WS_HID), DFF, WSP(float, WS_SSA), 1.0f / DM, NORM_EPS, (PG8_LAS float*)(F.lds + MISC_OFF + 256)};
            pg8::gemm_phase<pg8::EpiGU, pg8::StaticOrder>(F.lds, g, S, E, F.wave);
        }
        SEAM(pb + 7);
        if (EN(10) && IN(pb + 8)) {
            WS_LOCAL();
            pg8::Gemm g{WSP(bf16, WS_HID), WSP(const bf16, WS_WDN + l * SZ_WDN), SEQ, DM, DFF, DFF, DFF, 0, 1}; pg8::StaticOrder S; S.init(SEQ, DM, F.G, (int)blockIdx.x);
            pg8::EpiRes<true> E{nullptr, l == 1 ? xout : (float*)nullptr, WSP(bf16, WS_XB), WSP(float, WS_SSB), DM, exch};
            pg8::gemm_phase<pg8::EpiRes<true>, pg8::StaticOrder>(F.lds, g, S, E, F.wave);
        }
        SEAM(pb + 8);
    }
#undef IN
#undef SEAM
#undef SEAM0
}

extern "C" void kernel_launch(void* const* d_in, const int* in_sizes, int n_in, void* d_out, int out_size, void* d_ws, size_t ws_size, hipStream_t stream) {
    static int grid = 0;
    if (grid == 0) {
        if (n_in != N_IN || in_sizes[0] != SEQ * DM || out_size != SEQ * DM || ws_size < WS_END) {
            fprintf(stderr, "kernel_launch: unexpected shapes (n_in %d, in0 %d, out %d, ws %zu < %zu); nothing launched\n", n_in, n_in > 0 ? in_sizes[0] : -1, out_size, ws_size, (size_t)WS_END); grid = -1; return; }
        int dev = 0, cus = 0, per_cu = 0;
        if (hipGetDevice(&dev) != hipSuccess || hipDeviceGetAttribute(&cus, hipDeviceAttributeMultiprocessorCount, dev) != hipSuccess) { grid = -1; return; }
        if (hipFuncSetAttribute((const void*)hybrid_fwd, hipFuncAttributeMaxDynamicSharedMemorySize, LDS_BYTES) != hipSuccess) { fprintf(stderr, "kernel_launch: hipFuncSetAttribute failed\n"); grid = -1; return; }
        if (hipOccupancyMaxActiveBlocksPerMultiprocessor(&per_cu, (const void*)hybrid_fwd, NWAVES * 64, LDS_BYTES) != hipSuccess || per_cu < 1)
            fprintf(stderr, "kernel_launch: note: occupancy query reports %d workgroups per CU\n", per_cu);
        (void)hipGetLastError();
        grid = cus;
        if (grid != 256) fprintf(stderr, "kernel_launch: %d CUs; the attention phase is dealt for 256\n", grid);
    }
    if (grid < 0) return;
    if (hipMemsetAsync((char*)d_ws + WS_CTL, 0, CTL_ZERO_BYTES, stream) != hipSuccess) return;
    Args a{};
    for (int i = 0; i < N_IN; ++i) a.in[i] = d_in[i];
    a.out = (float*)d_out; a.ws = (unsigned char*)d_ws;
#if MK_ONE_LAUNCH
    a.ph_lo = 0; a.ph_hi = N_PHASES;
    hipLaunchKernelGGL(hybrid_fwd, dim3(grid), dim3(NWAVES * 64), LDS_BYTES, stream, a);
#else
    for (int p = 0; p < N_PHASES; ++p) {
        if (p == 2 + 1 || p == 2 + 9 + 1 || p == 2 + 9 + 3) continue;
        a.ph_lo = p; a.ph_hi = p + 1;
        hipLaunchKernelGGL(hybrid_fwd, dim3(grid), dim3(NWAVES * 64), LDS_BYTES, stream, a);
    }
#endif
}
```
